# Optimizing an MI355X kernel written in HIP

```python
import math
import jax, jax.numpy as jnp
from jax import lax
import numpy as np

D_MODEL = 1024
BATCH = 8
SEQ = 4096
DEPTH = 2

CTX_LEN = 256
GRID_W = 64
EPS = 1e-6
ROPE_BASE = 10000.0
D_FF = 4 * D_MODEL
GDN_HEADS = 4
GDN_DK = 128
GDN_DV = 128
GDN_CHUNK = 64
CONV_W = 5
MLA_HEADS = 4
MLA_Q_RANK = 256
MLA_KV_RANK = 128
MLA_NOPE = 64
MLA_ROPE = 32
MLA_DV = 64
Q_BLOCK = 128
HG_HEADS = 4
HG_DK = 128
HG_DV = 64
HG_CHUNK = 32
D_MIX = GDN_HEADS * GDN_DV + MLA_HEADS * MLA_DV + HG_HEADS * HG_DV
IN_SIZES = (GDN_HEADS * GDN_DK, GDN_HEADS * GDN_DK, GDN_HEADS * GDN_DV, GDN_HEADS * GDN_DV, 2 * GDN_HEADS, 2 * GDN_HEADS,
            MLA_Q_RANK, MLA_KV_RANK, MLA_ROPE,
            HG_HEADS * HG_DK, HG_HEADS * HG_DK, HG_HEADS * HG_DK, HG_HEADS * HG_DV, HG_HEADS * HG_DV)
D_IN = sum(IN_SIZES)

kernel_name = "hybrid_gdn_mla_hgrn2_dit_block"

F32 = jnp.float32


def split_cols(z, sizes):
    return jnp.split(z, np.cumsum(np.array(sizes))[:-1].tolist(), axis=-1)


def rms_norm(x, g):
    xf = x.astype(F32)
    y = xf * lax.rsqrt(jnp.mean(xf * xf, axis=-1, keepdims=True) + EPS)
    return (y * g.astype(F32)).astype(x.dtype)


def l2_norm(x):
    xf = x.astype(F32)
    return xf * lax.rsqrt(jnp.sum(xf * xf, axis=-1, keepdims=True) + EPS)


def modulate(h, shift, scale):
    return h * (1.0 + scale) + shift


def short_conv(u, w):
    y = lax.conv_general_dilated(u, w[:, None, :].astype(u.dtype), window_strides=(1,),
                                 padding=[(CONV_W // 2, CONV_W // 2)],
                                 dimension_numbers=("NWC", "WIO", "NWC"),
                                 feature_group_count=u.shape[-1])
    return jax.nn.silu(y)


def axial_rope(rows, dim):
    per_axis = dim // 2
    inv = ROPE_BASE ** (-jnp.arange(0, per_axis, 2, dtype=F32) / per_axis)
    row = jnp.repeat(jnp.arange(rows, dtype=F32), GRID_W)
    col = jnp.tile(jnp.arange(GRID_W, dtype=F32), rows)
    ang = jnp.concatenate([row[:, None] * inv, col[:, None] * inv], axis=-1)
    return jnp.cos(ang), jnp.sin(ang)


def apply_rope(t, cos, sin):
    half = t.shape[-1] // 2
    t1 = t[..., :half].astype(F32)
    t2 = t[..., half:].astype(F32)
    return jnp.concatenate([t1 * cos - t2 * sin, t1 * sin + t2 * cos], axis=-1).astype(t.dtype)


def to_chunks(t, chunk):
    b, l, h = t.shape[:3]
    t = t.reshape((b, l // chunk, chunk, h) + t.shape[3:])
    return jnp.swapaxes(jnp.moveaxis(t, 1, 0), 2, 3)


def from_chunks(t):
    n, b, h, c = t.shape[:4]
    t = jnp.moveaxis(jnp.swapaxes(t, 2, 3), 0, 1)
    return t.reshape((b, n * c, h) + t.shape[4:])


def gdn_scan(q, k, v, log_a, beta, s0, want_out):
    kc = to_chunks(k.astype(F32), GDN_CHUNK)
    vc = to_chunks(v.astype(F32), GDN_CHUNK)
    bc = to_chunks(beta.astype(F32), GDN_CHUNK)
    gcum = jnp.cumsum(to_chunks(log_a.astype(F32), GDN_CHUNK), axis=-1)
    idx = jnp.arange(GDN_CHUNK)
    incl = idx[:, None] >= idx[None, :]
    strict = idx[:, None] > idx[None, :]
    decay = jnp.exp(jnp.where(incl, gcum[..., :, None] - gcum[..., None, :], -jnp.inf))
    kb = kc * bc[..., None]
    lower = jnp.where(strict, jnp.einsum("nbhid,nbhjd->nbhij", kb, kc) * decay, 0.0)
    eye = jnp.eye(GDN_CHUNK, dtype=F32)
    t_inv = lax.linalg.triangular_solve(eye + lower, jnp.broadcast_to(eye, lower.shape),
                                        left_side=True, lower=True, unit_diagonal=True)
    u = jnp.einsum("nbhij,nbhjd->nbhid", t_inv, vc * bc[..., None])
    w = jnp.einsum("nbhij,nbhjd->nbhid", t_inv, kb * jnp.exp(gcum)[..., None])
    g_last = gcum[..., -1]
    k_end = kc * jnp.exp(g_last[..., None] - gcum)[..., None]
    if want_out:
        qc = to_chunks(q.astype(F32), GDN_CHUNK)
        q_att = jnp.einsum("nbhid,nbhjd->nbhij", qc, kc) * decay
        q_dec = qc * jnp.exp(gcum)[..., None]
        xs = (u, w, k_end, g_last, q_att, q_dec)
    else:
        xs = (u, w, k_end, g_last)

    def step(s, inp):
        v_new = inp[0] - jnp.einsum("bhcd,bhde->bhce", inp[1], s)
        s_next = s * jnp.exp(inp[3])[..., None, None] + jnp.einsum("bhcd,bhce->bhde", inp[2], v_new)
        if want_out:
            o = jnp.einsum("bhcd,bhde->bhce", inp[5], s) + jnp.einsum("bhij,bhje->bhie", inp[4], v_new)
            return s_next, o
        return s_next, None

    s_fin, o = lax.scan(step, s0, xs)
    return (from_chunks(o) if want_out else None), s_fin


def gdn_mixer(pc, px, conv_w, a_log, dt_bias, norm_g, want_ctx):
    def prep(q, k, v, b_raw, a_raw):
        b, l = q.shape[:2]
        qkv = short_conv(jnp.concatenate([q, k, v], axis=-1), conv_w)
        q, k, v = split_cols(qkv, (GDN_HEADS * GDN_DK, GDN_HEADS * GDN_DK, GDN_HEADS * GDN_DV))
        q = l2_norm(q.reshape(b, l, GDN_HEADS, GDN_DK)) * GDN_DK ** -0.5
        k = l2_norm(k.reshape(b, l, GDN_HEADS, GDN_DK))
        v = v.reshape(b, l, GDN_HEADS, GDN_DV)
        beta = jax.nn.sigmoid(b_raw.astype(F32)).reshape(b, l, 2, GDN_HEADS)
        log_a = -jnp.exp(a_log.astype(F32)) * jax.nn.softplus(
            a_raw.astype(F32).reshape(b, l, 2, GDN_HEADS) + dt_bias.astype(F32))
        return q, k, v, beta, log_a

    cq, ck, cv, cbeta, cla = prep(pc[0], pc[1], pc[2], pc[4], pc[5])
    xq, xk, xv, xbeta, xla = prep(px[0], px[1], px[2], px[4], px[5])
    bsz = xq.shape[0]
    outs_x, outs_c = [], []
    for d in range(2):
        fl = (lambda t: jnp.flip(t, axis=1)) if d == 1 else (lambda t: t)
        s0 = jnp.zeros((bsz, GDN_HEADS, GDN_DK, GDN_DV), F32)
        oc, s_ctx = gdn_scan(fl(cq), fl(ck), fl(cv), fl(cla[:, :, d]), fl(cbeta[:, :, d]), s0, want_ctx)
        ox, _ = gdn_scan(fl(xq), fl(xk), fl(xv), fl(xla[:, :, d]), fl(xbeta[:, :, d]), s_ctx, True)
        outs_x.append(fl(ox))
        if want_ctx:
            outs_c.append(fl(oc))

    def readout(o, gate):
        b, l = gate.shape[:2]
        y = rms_norm(o, norm_g) * jax.nn.silu(gate.astype(F32).reshape(b, l, GDN_HEADS, GDN_DV))
        return y.reshape(b, l, GDN_HEADS * GDN_DV).astype(gate.dtype)

    y_x = readout(outs_x[0] + outs_x[1], px[3])
    y_c = readout(outs_c[0] + outs_c[1], pc[3]) if want_ctx else None
    return y_x, y_c


def mla_kv(ckv, kr, kv_norm_g, w_ukv, cos, sin):
    b, l = ckv.shape[:2]
    kv = (rms_norm(ckv, kv_norm_g) @ w_ukv).reshape(b, l, MLA_HEADS, MLA_NOPE + MLA_DV)
    if cos is not None:
        kr = apply_rope(kr, cos, sin)
    k_rope = jnp.broadcast_to(kr[:, :, None, :], (b, l, MLA_HEADS, MLA_ROPE))
    return jnp.concatenate([kv[..., :MLA_NOPE], k_rope], axis=-1), kv[..., MLA_NOPE:]


def mla_q(cq, q_norm_g, w_uq, cos, sin):
    b, l = cq.shape[:2]
    q = (rms_norm(cq, q_norm_g) @ w_uq).reshape(b, l, MLA_HEADS, MLA_NOPE + MLA_ROPE)
    if cos is not None:
        q = jnp.concatenate([q[..., :MLA_NOPE], apply_rope(q[..., MLA_NOPE:], cos[:, None], sin[:, None])], axis=-1)
    return q


def block_attention(q, k, v):
    b, lq, h, dq = q.shape
    qb = jnp.moveaxis(q.reshape(b, lq // Q_BLOCK, Q_BLOCK, h, dq), 1, 0)
    scale = dq ** -0.5

    def one(qblk):
        s = jnp.einsum("bqhd,bkhd->bhqk", qblk, k).astype(F32) * scale
        p = jax.nn.softmax(s, axis=-1).astype(v.dtype)
        return jnp.einsum("bhqk,bkhd->bqhd", p, v)

    o = lax.map(one, qb)
    return jnp.moveaxis(o, 0, 1).reshape(b, lq, h * v.shape[-1])


def mla_mixer(pc, px, q_norm_g, kv_norm_g, w_uq, w_ukv, cos, sin, want_ctx):
    kc, vc = mla_kv(pc[1], pc[2], kv_norm_g, w_ukv, None, None)
    kx, vx = mla_kv(px[1], px[2], kv_norm_g, w_ukv, cos, sin)
    qx = mla_q(px[0], q_norm_g, w_uq, cos, sin)
    y_x = block_attention(qx, jnp.concatenate([kc, kx], axis=1), jnp.concatenate([vc, vx], axis=1))
    y_c = block_attention(mla_q(pc[0], q_norm_g, w_uq, None, None), kc, vc) if want_ctx else None
    return y_x, y_c


def hgrn_scan(q, k, v, log_f, s0, want_out):
    if want_out:
        xs = (to_chunks(k, HG_CHUNK), to_chunks(v, HG_CHUNK), to_chunks(log_f, HG_CHUNK), to_chunks(q, HG_CHUNK))
    else:
        xs = (to_chunks(k, HG_CHUNK), to_chunks(v, HG_CHUNK), to_chunks(log_f, HG_CHUNK))
    idx = jnp.arange(HG_CHUNK)
    incl = idx[:, None] >= idx[None, :]

    def step(s, inp):
        k_n, v_n, lf_n = inp[0], inp[1], inp[2]
        bcum = jnp.cumsum(lf_n, axis=2)
        b_last = bcum[:, :, -1]
        s_next = s * jnp.exp(b_last)[..., None] + jnp.einsum(
            "bhcd,bhce->bhde", k_n * jnp.exp(b_last[:, :, None] - bcum), v_n)
        if want_out:
            q_n = inp[3]
            dec = jnp.exp(jnp.where(incl[:, :, None], bcum[:, :, :, None, :] - bcum[:, :, None, :, :], -jnp.inf))
            att = jnp.einsum("bhid,bhjd,bhijd->bhij", q_n, k_n, dec)
            o = jnp.einsum("bhcd,bhde->bhce", q_n * jnp.exp(bcum), s) + jnp.einsum("bhij,bhje->bhie", att, v_n)
            return s_next, o
        return s_next, None

    s_fin, o = lax.scan(step, s0, xs)
    return (from_chunks(o) if want_out else None), s_fin


def hgrn_mixer(pc, px, lb, norm_g, want_ctx):
    lbf = lb.astype(F32).reshape(2, HG_HEADS, HG_DK)

    def prep(q, f_fwd, f_bwd, i):
        b, l = q.shape[:2]
        q = q.astype(F32).reshape(b, l, HG_HEADS, HG_DK) * HG_DK ** -0.5
        i = i.astype(F32).reshape(b, l, HG_HEADS, HG_DV)
        log_fs = [jnp.logaddexp(jnp.log(lbf[d]), jnp.log1p(-lbf[d]) +
                                jax.nn.log_sigmoid(fr.astype(F32).reshape(b, l, HG_HEADS, HG_DK)))
                  for d, fr in enumerate((f_fwd, f_bwd))]
        return q, i, log_fs

    cq, ci, clf = prep(pc[0], pc[1], pc[2], pc[3])
    xq, xi, xlf = prep(px[0], px[1], px[2], px[3])
    bsz = xq.shape[0]
    outs_x, outs_c = [], []
    for d in range(2):
        fl = (lambda t: jnp.flip(t, axis=1)) if d == 1 else (lambda t: t)
        s0 = jnp.zeros((bsz, HG_HEADS, HG_DK, HG_DV), F32)
        oc, s_ctx = hgrn_scan(fl(cq), fl(-jnp.expm1(clf[d])), fl(ci), fl(clf[d]), s0, want_ctx)
        ox, _ = hgrn_scan(fl(xq), fl(-jnp.expm1(xlf[d])), fl(xi), fl(xlf[d]), s_ctx, True)
        outs_x.append(fl(ox))
        if want_ctx:
            outs_c.append(fl(oc))

    def readout(o, gate):
        b, l = gate.shape[:2]
        y = rms_norm(o, norm_g) * jax.nn.silu(gate.astype(F32).reshape(b, l, HG_HEADS, HG_DV))
        return y.reshape(b, l, HG_HEADS * HG_DV).astype(gate.dtype)

    y_x = readout(outs_x[0] + outs_x[1], px[4])
    y_c = readout(outs_c[0] + outs_c[1], pc[4]) if want_ctx else None
    return y_x, y_c


def mixing_layer(hx, hc, w_in_l, w_out_l, gdn_conv_l, gdn_a_log_l, gdn_dt_bias_l, gdn_norm_l,
                 mla_q_norm_l, mla_kv_norm_l, mla_w_uq_l, mla_w_ukv_l, lb_l, hgrn_norm_l, cos, sin, want_ctx):
    zx = split_cols(hx @ w_in_l, IN_SIZES)
    zc = split_cols(hc @ w_in_l, IN_SIZES)
    gdn_x, gdn_c = gdn_mixer(zc[0:6], zx[0:6], gdn_conv_l, gdn_a_log_l, gdn_dt_bias_l, gdn_norm_l, want_ctx)
    mla_x, mla_c = mla_mixer(zc[6:9], zx[6:9], mla_q_norm_l, mla_kv_norm_l, mla_w_uq_l, mla_w_ukv_l, cos, sin, want_ctx)
    hg_x, hg_c = hgrn_mixer(zc[9:14], zx[9:14], lb_l, hgrn_norm_l, want_ctx)
    y_x = jnp.concatenate([gdn_x, mla_x, hg_x], axis=-1) @ w_out_l
    y_c = jnp.concatenate([gdn_c, mla_c, hg_c], axis=-1) @ w_out_l if want_ctx else None
    return y_x, y_c


def sq_relu_mlp(h, w1, w2):
    return jnp.square(jax.nn.relu(h @ w1)) @ w2


def setup_inputs(seed: int = 0) -> dict:
    key = jax.random.key(seed)
    ks = jax.random.split(key, 24)

    def nrm(k, shape, scale):
        return jax.random.normal(k, shape, F32) * scale

    def gain(k, shape):
        return 1.0 + 0.02 * jax.random.normal(k, shape, F32)

    dt = jnp.exp(jax.random.uniform(ks[13], (DEPTH, 2, GDN_HEADS), F32, math.log(1e-3), math.log(1e-1)))
    return {
        "x": nrm(ks[0], (BATCH, SEQ, D_MODEL), 1.0),
        "c": nrm(ks[1], (BATCH, D_MODEL), 1.0),
        "ctx": nrm(ks[2], (BATCH, CTX_LEN, D_MODEL), 1.0),
        "c_ctx": nrm(ks[3], (D_MODEL,), 1.0),
        "w_ada": nrm(ks[4], (DEPTH, D_MODEL, 6 * D_MODEL), 0.5 * D_MODEL ** -0.5),
        "b_ada": nrm(ks[5], (DEPTH, 6 * D_MODEL), 0.02),
        "norm_mix_pre": gain(ks[6], (DEPTH, D_MODEL)),
        "norm_mix_post": gain(ks[7], (DEPTH, D_MODEL)),
        "norm_mlp_pre": gain(ks[8], (DEPTH, D_MODEL)),
        "norm_mlp_post": gain(ks[9], (DEPTH, D_MODEL)),
        "w_in": nrm(ks[10], (DEPTH, D_MODEL, D_IN), D_MODEL ** -0.5),
        "w_out": nrm(ks[11], (DEPTH, D_MIX, D_MODEL), D_MIX ** -0.5),
        "gdn_conv": nrm(ks[12], (DEPTH, CONV_W, GDN_HEADS * (2 * GDN_DK + GDN_DV)), CONV_W ** -0.5),
        "gdn_a_log": jnp.log(jax.random.uniform(ks[14], (DEPTH, 2, GDN_HEADS), F32, 1.0, 16.0)),
        "gdn_dt_bias": dt + jnp.log(-jnp.expm1(-dt)),
        "gdn_norm": gain(ks[15], (DEPTH, GDN_DV)),
        "mla_q_norm": gain(ks[16], (DEPTH, MLA_Q_RANK)),
        "mla_kv_norm": gain(ks[17], (DEPTH, MLA_KV_RANK)),
        "mla_w_uq": nrm(ks[18], (DEPTH, MLA_Q_RANK, MLA_HEADS * (MLA_NOPE + MLA_ROPE)), MLA_Q_RANK ** -0.5),
        "mla_w_ukv": nrm(ks[19], (DEPTH, MLA_KV_RANK, MLA_HEADS * (MLA_NOPE + MLA_DV)), MLA_KV_RANK ** -0.5),
        "hgrn_lb_logits": nrm(ks[20], (DEPTH, 2, HG_HEADS * HG_DK), 0.1),
        "hgrn_norm": gain(ks[21], (DEPTH, HG_DV)),
        "w_mlp1": nrm(ks[22], (DEPTH, D_MODEL, D_FF), D_MODEL ** -0.5),
        "w_mlp2": nrm(ks[23], (DEPTH, D_FF, D_MODEL), D_FF ** -0.5),
    }


def reference(x, c, ctx, c_ctx, w_ada, b_ada, norm_mix_pre, norm_mix_post, norm_mlp_pre, norm_mlp_post,
              w_in, w_out, gdn_conv, gdn_a_log, gdn_dt_bias, gdn_norm, mla_q_norm, mla_kv_norm,
              mla_w_uq, mla_w_ukv, hgrn_lb_logits, hgrn_norm, w_mlp1, w_mlp2):
    rows = x.shape[1] // GRID_W
    cos, sin = axial_rope(rows, MLA_ROPE)
    lb_cum = jnp.cumsum(jax.nn.softmax(hgrn_lb_logits.astype(F32), axis=0), axis=0)
    lower_bounds = lb_cum - lb_cum[0]
    h_ctx = ctx
    for l in range(DEPTH):
        want_ctx = l < DEPTH - 1
        sh1x, sc1x, g1x, sh2x, sc2x, g2x = [m[:, None, :] for m in
                                            split_cols(jax.nn.silu(c) @ w_ada[l] + b_ada[l], (D_MODEL,) * 6)]
        sh1c, sc1c, g1c, sh2c, sc2c, g2c = split_cols(jax.nn.silu(c_ctx) @ w_ada[l] + b_ada[l], (D_MODEL,) * 6)
        hx = modulate(rms_norm(x, norm_mix_pre[l]), sh1x, sc1x)
        hc = modulate(rms_norm(h_ctx, norm_mix_pre[l]), sh1c, sc1c)
        y_x, y_c = mixing_layer(hx, hc, w_in[l], w_out[l], gdn_conv[l], gdn_a_log[l], gdn_dt_bias[l], gdn_norm[l],
                                mla_q_norm[l], mla_kv_norm[l], mla_w_uq[l], mla_w_ukv[l], lower_bounds[l],
                                hgrn_norm[l], cos, sin, want_ctx)
        x = x + g1x * rms_norm(y_x, norm_mix_post[l])
        hx = modulate(rms_norm(x, norm_mlp_pre[l]), sh2x, sc2x)
        x = x + g2x * rms_norm(sq_relu_mlp(hx, w_mlp1[l], w_mlp2[l]), norm_mlp_post[l])
        if want_ctx:
            h_ctx = h_ctx + g1c * rms_norm(y_c, norm_mix_post[l])
            hc = modulate(rms_norm(h_ctx, norm_mlp_pre[l]), sh2c, sc2c)
            h_ctx = h_ctx + g2c * rms_norm(sq_relu_mlp(hc, w_mlp1[l], w_mlp2[l]), norm_mlp_post[l])
    return x
```

```cpp
#include <hip/hip_runtime.h>
#include <hip/hip_bf16.h>
#include <cstdio>
#include <cstdint>
#include <cmath>

#ifndef MK_ONE_LAUNCH
#define MK_ONE_LAUNCH 1
#endif

constexpr int NB = 8, SEQ = 4096, CTXL = 256, TPB = SEQ + CTXL  , MT = NB * TPB  ;
constexpr int DM = 1024, DFF = 4096, DEPTH = 2, DIN = 4528, ZLD = 4608;
constexpr float EPS = 1e-6f;
constexpr int ZC_GQ = 0, ZC_GK = 512, ZC_GV = 1024, ZC_GG = 1536, ZC_CQ = 2048, ZC_HG = 2304, ZC_CKV = 2560, ZC_KR = 2688,
              ZC_GB = 2720, ZC_GA = 2728, ZC_HQ = 2752, ZC_HFF = 3264, ZC_HFB = 3776, ZC_HI = 4288, ZC_END = 4544;
__host__ __device__ __forceinline__ int zcol_src(int n) {
    if (n < 2048) return n;
    if (n < 2304) return 2064 + (n - 2048);
    if (n < 2560) return 4272 + (n - 2304);
    if (n < 2688) return 2320 + (n - 2560);
    if (n < 2720) return 2448 + (n - 2688);
    if (n < 2728) return 2048 + (n - 2720);
    if (n < 2736) return 2056 + (n - 2728);
    if (n < 2752) return -1;
    if (n < 3264) return 2480 + (n - 2752);
    if (n < 3776) return 2992 + (n - 3264);
    if (n < 4288) return 3504 + (n - 3776);
    if (n < 4544) return 4016 + (n - 4288);
    return -1;
}
constexpr int HB_Q = 0, HB_K = 384, HB_V = 768;
constexpr float ATT_C2 = 0.10206207261596577f * 1.4426950408889634f;

constexpr size_t MiB = 1u << 20;
constexpr size_t WS_CTL = 0, CTL_ZERO_BYTES = 1 * MiB;
constexpr size_t WS_MODS = 1 * MiB;
constexpr size_t WS_ROPE = WS_MODS + 512 * 1024;
constexpr size_t WS_LB = WS_ROPE + 512 * 1024 + 0;
constexpr size_t WS_W = 3 * MiB;
constexpr size_t W_IN = 0, W_OUT = W_IN + (size_t)ZLD * DM * 2, W_1 = W_OUT + (size_t)DM * DM * 2, W_2 = W_1 + (size_t)DFF * DM * 2,
                 W_UQ = W_2 + (size_t)DM * DFF * 2, W_UKV = W_UQ + 512 * 256 * 2, W_LAYER = W_UKV + 512 * 128 * 2;
constexpr size_t WS_XC = 58 * MiB;
constexpr size_t WS_HB = 66 * MiB;
constexpr size_t WS_OSG = 134 * MiB;
constexpr size_t WS_OSH = 168 * MiB;
constexpr size_t WS_Z = 185 * MiB;
constexpr size_t WS_END = WS_Z + (size_t)MT * ZLD * 2;
static_assert(WS_LB + 8192 <= WS_W && WS_W + 2 * W_LAYER <= WS_XC && WS_XC + (size_t)NB * CTXL * DM * 4 <= WS_HB && WS_HB + (size_t)MT * DM * 2 <= WS_OSG &&
              WS_OSG + (size_t)MT * 512 * 2 <= WS_OSH && WS_OSH + (size_t)MT * 256 * 2 <= WS_Z && WS_END <= 512 * MiB, "d_ws map");
constexpr int CW_BAR = 4096;
constexpr int CW_ATTQ = 16384;

constexpr int RING_BYTES = 131072, LDSCTL_OFF = RING_BYTES, MISC_OFF = LDSCTL_OFF + 320, LDS_BYTES = 147456;
constexpr int NWAVES = 8;

#define GAS __attribute__((address_space(1)))
#define LAS __attribute__((address_space(3)))
typedef unsigned short bf16;
typedef unsigned v4u __attribute__((ext_vector_type(4)));
typedef unsigned v2u __attribute__((ext_vector_type(2)));
typedef float f32x4 __attribute__((ext_vector_type(4)));
typedef float f32x16 __attribute__((ext_vector_type(16)));
typedef short bf16x8 __attribute__((ext_vector_type(8)));
typedef short s16x4 __attribute__((ext_vector_type(4)));
typedef GAS unsigned gu32;
#define RLX_AGENT __ATOMIC_RELAXED, __HIP_MEMORY_SCOPE_AGENT
#define LDS_WAIT() asm volatile("s_waitcnt lgkmcnt(0)" ::: "memory")
#define VM_WAIT() asm volatile("s_waitcnt vmcnt(0)" ::: "memory")
__device__ __forceinline__ unsigned f2bf(float f) { unsigned u = __builtin_bit_cast(unsigned, f); return (u + 0x7fffu + ((u >> 16) & 1u)) >> 16; }
__device__ __forceinline__ unsigned pk2(float lo, float hi) { return f2bf(lo) | (f2bf(hi) << 16); }
__device__ __forceinline__ float bf2f(unsigned b) { return __builtin_bit_cast(float, b << 16); }
__device__ __forceinline__ float bflo(unsigned w) { return __builtin_bit_cast(float, w << 16); }
__device__ __forceinline__ float bfhi(unsigned w) { return __builtin_bit_cast(float, w & 0xffff0000u); }
__device__ __forceinline__ float wave_sum(float v) {
#pragma unroll
    for (int o = 1; o < 64; o <<= 1) v += __shfl_xor(v, o);
    return v;
}
__device__ __forceinline__ float sigmoidf_(float x) { return 1.0f / (1.0f + __expf(-x)); }
__device__ __forceinline__ float siluf_(float x) { return x / (1.0f + __expf(-x)); }

namespace pg8 {
#define PG8_LAS __attribute__((address_space(3)))
typedef unsigned short bf16_t;
typedef short bf16x8 __attribute__((ext_vector_type(8)));
typedef float f32x4 __attribute__((ext_vector_type(4)));
typedef unsigned u32x4 __attribute__((ext_vector_type(4)));
constexpr int BM = 256, BK = 64, HALF = 128, HTB = HALF * BK * 2  , STAGE_BYTES = 8 * HTB, NXCD = 8, WGM = 8;

__host__ __device__ __forceinline__ int lds_byte(int r, int c) { const int st = (r >> 4) * 2 + (c >> 5), rr = r & 15, cc = c & 31, ob = rr * 64 + cc * 2; return st * 1024 + (ob ^ (((ob >> 9) & 1) << 5)); }
__host__ __device__ __forceinline__ void stage_rc(int b, int& R, int& C) { const int st = b / 1024, sb = b % 1024, swz = sb ^ (((sb >> 9) & 1) << 5); R = (st >> 1) * 16 + swz / 64; C = (st & 1) * 32 + (swz % 64) / 2; }
__host__ __device__ __forceinline__ int perm32(int rho) { const int n = rho >> 4, i = rho & 15; return 8 * (i >> 2) + 4 * n + (i & 3); }

struct Unit { int pm, pn; };
struct Gemm { const bf16_t* A; const bf16_t* Bt; int M, N, K, lda; };

struct StaticOrder {
    int nM, nN, nwg, G, c;
    __host__ __device__ void init(int M, int N, int G_, int c_) { nM = M / BM; nN = N / BM; nwg = nM * nN; G = G_; c = c_; }
    __host__ __device__ bool next(int i, Unit& u) const {
        const long L = (long)i * G + c; if (L >= nwg) return false;
        int wgid = (int)L; { const int q = nwg / NXCD, r = nwg % NXCD, xcd = wgid % NXCD, off = wgid / NXCD; wgid = (xcd < r ? xcd * (q + 1) : r * (q + 1) + (xcd - r) * q) + off; }
        const int nig = WGM * nN, gid = wgid / nig, fm = gid * WGM, gsz = (nM - fm) < WGM ? (nM - fm) : WGM;
        u.pm = fm + ((wgid % nig) % gsz); u.pn = (wgid % nig) / gsz; return true;
    }
    __device__ __forceinline__ void a_ready(const Unit&) const {}
    __device__ __forceinline__ void done(const Unit&) const {}
};

__device__ __forceinline__ unsigned cvt_pk_bf16(float lo, float hi) { unsigned r; asm volatile("v_cvt_pk_bf16_f32 %0, %1, %2" : "=v"(r) : "v"(lo), "v"(hi)); return r; }
typedef float f32x2 __attribute__((ext_vector_type(2)));
struct EpiBf16 {
    static constexpr bool PERM = true, AFTER_DRAIN = false;
    bf16_t* O; int ldc; int act;
    __device__ __forceinline__ void operator()(const f32x4 (&acc)[2][2][4][2], const Unit& u, int wr, int wc, int fr, int fq) const {
        const int row0 = u.pm * BM + wr * 64 + fr; const int col0 = u.pn * BM + wc * 32 + 8 * fq;
        const bool sq = act == 2;
#pragma unroll
        for (int ai = 0; ai < 2; ++ai)
#pragma unroll
            for (int m = 0; m < 4; ++m) { bf16_t* rowp = O + (size_t)(row0 + ai * HALF + m * 16) * ldc + col0;
#pragma unroll
                for (int bj = 0; bj < 2; ++bj) { f32x4 v0 = acc[ai][bj][m][0], v1 = acc[ai][bj][m][1];
                    if (sq) {
#pragma unroll
                        for (int q = 0; q < 4; ++q) { const float a = v0[q] > 0.f ? v0[q] : 0.f, b = v1[q] > 0.f ? v1[q] : 0.f; v0[q] = a * a; v1[q] = b * b; } }
                    u32x4 w; w.x = cvt_pk_bf16(v0[0], v0[1]); w.y = cvt_pk_bf16(v0[2], v0[3]); w.z = cvt_pk_bf16(v1[0], v1[1]); w.w = cvt_pk_bf16(v1[2], v1[3]);
                    *(u32x4*)(rowp + bj * HALF) = w; } }
    }
};

template <class Epi, class Sched, bool ALIGN_EPI = false, bool SP2 = false>
__device__ __forceinline__ void gemm_phase(PG8_LAS unsigned char* lds, const Gemm g, const Sched& S, const Epi& E) {
    int tid_ = threadIdx.x; asm volatile("" : "+v"(tid_));
    const int tid = tid_, wid = __builtin_amdgcn_readfirstlane(tid >> 6), lane = tid & 63, wr = wid >> 2, wc = wid & 3, fr = lane & 15, fq = lane >> 4;
    const int K = g.K, nt = K / BK;
    unsigned voffA[2], voffB[2];
#pragma unroll
    for (int i = 0; i < 2; ++i) { int R, C; stage_rc(tid * 16 + i * 8192, R, C); const int Rb = Epi::PERM ? ((R & ~31) + perm32(R & 31)) : R;
        voffA[i] = (unsigned)(R * g.lda + C) * 2u; voffB[i] = (unsigned)(Rb * K + C) * 2u; }
    const size_t kstep = (size_t)(BK * 2);
    const size_t hstepA = (size_t)HALF * g.lda * 2, hstepB = (size_t)HALF * K * 2;
    const size_t tstepA = 2 * hstepA, tstepB = 2 * hstepB;
    const unsigned ldsw = (unsigned)wid * 1024u;
    const int aoff = lds_byte(wr * 64 + fr, fq * 8), boff = lds_byte(wc * 32 + fr, fq * 8);
#define PG8_SA(b, h) (((b) * 2 + (h)) * HTB)
#define PG8_SB(b, h) ((4 + (b) * 2 + (h)) * HTB)
#define PG8_STAGE(bufoff, gbase, voff) do { _Pragma("unroll") for (int _i = 0; _i < 2; ++_i) \
        __builtin_amdgcn_global_load_lds((const unsigned*)((const char*)(gbase) + (voff)[_i]), (PG8_LAS unsigned*)(lds + (bufoff) + ldsw + _i * 8192), 16, 0, 0); } while (0)
#define PG8_LDA(dst, b, h) do { _Pragma("unroll") for (int m = 0; m < 4; ++m) _Pragma("unroll") for (int k = 0; k < 2; ++k) dst[m][k] = *(const PG8_LAS bf16x8*)(lds + PG8_SA(b, h) + aoff + m * 2048 + k * 1024); } while (0)
#define PG8_LDB(dst, b, h) do { _Pragma("unroll") for (int n = 0; n < 2; ++n) _Pragma("unroll") for (int k = 0; k < 2; ++k) dst[n][k] = *(const PG8_LAS bf16x8*)(lds + PG8_SB(b, h) + boff + n * 2048 + k * 1024); } while (0)
#define PG8_MMA(ai, bj, At, Bt) do { __builtin_amdgcn_s_setprio(1); _Pragma("unroll") for (int m = 0; m < 4; ++m) _Pragma("unroll") for (int n = 0; n < 2; ++n) _Pragma("unroll") for (int k = 0; k < 2; ++k) \
        acc[ai][bj][m][n] = __builtin_amdgcn_mfma_f32_16x16x32_bf16(Bt[n][k], At[m][k], acc[ai][bj][m][n], 0, 0, 0); __builtin_amdgcn_s_setprio(0); } while (0)
#define PG8_WAIT_V(n) asm volatile("s_waitcnt vmcnt(" #n ")" ::: "memory")
#define PG8_WAIT_L(n) asm volatile("s_waitcnt lgkmcnt(" #n ")" ::: "memory")
#define PG8_BAR __builtin_amdgcn_s_barrier()
#define PG8_SCHED __builtin_amdgcn_sched_barrier(0)
    Unit cur, nxt; int ui = 0;
    if (!S.next(0, cur)) return;
    f32x4 acc[2][2][4][2];
#pragma unroll
    for (int a = 0; a < 2; ++a)
#pragma unroll
        for (int b = 0; b < 2; ++b)
#pragma unroll
            for (int m = 0; m < 4; ++m)
#pragma unroll
                for (int n = 0; n < 2; ++n) acc[a][b][m][n] = (f32x4){0.f, 0.f, 0.f, 0.f};
    bf16x8 At[4][2], B0[2][2], B1[2][2];
    const char* cA = (const char*)g.A + (size_t)cur.pm * tstepA; const char* cB = (const char*)g.Bt + (size_t)cur.pn * tstepB;
    S.a_ready(cur);
    if constexpr (SP2) {
        PG8_STAGE(PG8_SB(0, 0), cB, voffB); PG8_STAGE(PG8_SB(0, 1), cB + hstepB, voffB); PG8_STAGE(PG8_SA(0, 0), cA, voffA); PG8_STAGE(PG8_SA(0, 1), cA + hstepA, voffA);
        if (wr == 1) PG8_BAR;
        PG8_WAIT_V(2); PG8_BAR;
        PG8_STAGE(PG8_SB(1, 0), cB + kstep, voffB); PG8_STAGE(PG8_SA(1, 0), cA + kstep, voffA); PG8_STAGE(PG8_SB(1, 1), cB + hstepB + kstep, voffB);
        PG8_WAIT_V(6); PG8_BAR;
    } else {
        PG8_STAGE(PG8_SB(0, 0), cB, voffB); PG8_STAGE(PG8_SA(0, 0), cA, voffA); PG8_STAGE(PG8_SB(0, 1), cB + hstepB, voffB); PG8_STAGE(PG8_SA(0, 1), cA + hstepA, voffA);
        if (wr == 1) PG8_BAR;
        PG8_WAIT_V(4); PG8_BAR;
        PG8_STAGE(PG8_SB(1, 0), cB + kstep, voffB); PG8_STAGE(PG8_SA(1, 0), cA + kstep, voffA); PG8_STAGE(PG8_SB(1, 1), cB + hstepB + kstep, voffB);
        PG8_WAIT_V(6); PG8_BAR;
    }
    for (;;) {
        const bool has_next = S.next(ui + 1, nxt);
        const char* nA = has_next ? (const char*)g.A + (size_t)nxt.pm * tstepA : cA; const char* nB = has_next ? (const char*)g.Bt + (size_t)nxt.pn * tstepB : cB;

#pragma nounroll
        for (int t = 0; t < nt; t += 2) {
            const bool last = (t == nt - 2);
            const char* a1 = cA + (size_t)(t + 1) * kstep;
            const char* a2 = last ? nA : cA + (size_t)(t + 2) * kstep; const char* b2 = last ? nB : cB + (size_t)(t + 2) * kstep;
            const char* a3 = a2 + kstep; const char* b3 = b2 + kstep;
            if (last && has_next) S.a_ready(nxt);
            if constexpr (SP2) {
            PG8_LDB(B0, 0, 0); PG8_LDB(B1, 0, 1); PG8_SCHED; PG8_LDA(At, 0, 0); PG8_STAGE(PG8_SA(1, 1), a1 + hstepA, voffA);
            PG8_WAIT_V(8); PG8_WAIT_L(0); PG8_BAR; PG8_MMA(0, 0, At, B0); PG8_MMA(0, 1, At, B1); PG8_BAR; PG8_SCHED;
            PG8_LDA(At, 0, 1); PG8_STAGE(PG8_SB(0, 0), b2, voffB); PG8_STAGE(PG8_SB(0, 1), b2 + hstepB, voffB); PG8_STAGE(PG8_SA(0, 0), a2, voffA);
            PG8_WAIT_V(8); PG8_WAIT_L(0); PG8_BAR; PG8_MMA(1, 0, At, B0); PG8_MMA(1, 1, At, B1); PG8_BAR; PG8_SCHED;
            PG8_LDB(B0, 1, 0); PG8_LDB(B1, 1, 1); PG8_SCHED; PG8_LDA(At, 1, 0); PG8_STAGE(PG8_SA(0, 1), a2 + hstepA, voffA);
            PG8_WAIT_V(8); PG8_WAIT_L(0); PG8_BAR; PG8_MMA(0, 0, At, B0); PG8_MMA(0, 1, At, B1); PG8_BAR; PG8_SCHED;
            PG8_LDA(At, 1, 1); PG8_STAGE(PG8_SB(1, 0), b3, voffB); PG8_STAGE(PG8_SB(1, 1), b3 + hstepB, voffB); PG8_STAGE(PG8_SA(1, 0), a3, voffA);
            PG8_WAIT_V(8); PG8_WAIT_L(0); PG8_BAR; PG8_MMA(1, 0, At, B0); PG8_MMA(1, 1, At, B1); PG8_BAR; PG8_SCHED;
            } else {
            PG8_LDB(B0, 0, 0); PG8_SCHED; PG8_LDA(At, 0, 0); PG8_STAGE(PG8_SA(1, 1), a1 + hstepA, voffA);
            PG8_WAIT_L(8); PG8_BAR; PG8_WAIT_L(0); PG8_MMA(0, 0, At, B0); PG8_BAR; PG8_SCHED;
            PG8_LDB(B1, 0, 1); PG8_STAGE(PG8_SB(0, 0), b2, voffB);
            PG8_BAR; PG8_WAIT_L(0); PG8_MMA(0, 1, At, B1); PG8_BAR;
            PG8_LDA(At, 0, 1); PG8_STAGE(PG8_SA(0, 0), a2, voffA);
            PG8_BAR; PG8_WAIT_L(0); PG8_MMA(1, 0, At, B0); PG8_BAR; PG8_SCHED;
            PG8_STAGE(PG8_SB(0, 1), b2 + hstepB, voffB);
            PG8_WAIT_V(6); PG8_BAR; PG8_MMA(1, 1, At, B1); PG8_BAR;
            PG8_LDB(B0, 1, 0); PG8_SCHED; PG8_LDA(At, 1, 0); PG8_STAGE(PG8_SA(0, 1), a2 + hstepA, voffA);
            PG8_WAIT_L(8); PG8_BAR; PG8_WAIT_L(0); PG8_MMA(0, 0, At, B0); PG8_BAR; PG8_SCHED;
            PG8_LDB(B1, 1, 1); PG8_STAGE(PG8_SB(1, 0), b3, voffB);
            PG8_BAR; PG8_WAIT_L(0); PG8_MMA(0, 1, At, B1); PG8_BAR;
            PG8_LDA(At, 1, 1); PG8_STAGE(PG8_SA(1, 0), a3, voffA);
            PG8_BAR; PG8_WAIT_L(0); PG8_MMA(1, 0, At, B0); PG8_BAR; PG8_SCHED;
            PG8_STAGE(PG8_SB(1, 1), b3 + hstepB, voffB);
            PG8_WAIT_V(6); PG8_BAR; PG8_MMA(1, 1, At, B1); PG8_BAR;
            }
        }
        if constexpr (ALIGN_EPI) { if (wr == 0) PG8_BAR; }
        if constexpr (!Epi::AFTER_DRAIN) { E(acc, cur, wr, wc, fr, fq); S.done(cur); }
        if (!has_next) break;
#pragma unroll
        for (int a = 0; a < 2; ++a)
#pragma unroll
            for (int b = 0; b < 2; ++b)
#pragma unroll
                for (int m = 0; m < 4; ++m)
#pragma unroll
                    for (int n = 0; n < 2; ++n) acc[a][b][m][n] = (f32x4){0.f, 0.f, 0.f, 0.f};
        cur = nxt; cA = nA; cB = nB; ++ui;
        if constexpr (ALIGN_EPI) { if (wr == 1) PG8_BAR; }
    }
    PG8_WAIT_V(0);
    if constexpr (!ALIGN_EPI) { if (wr == 0) PG8_BAR; }
    PG8_BAR;
    if constexpr (Epi::AFTER_DRAIN) { E.fused(acc, cur, wr, wc, fr, fq, lds, wid, lane); S.done(cur); }
#undef PG8_SA
#undef PG8_SB
#undef PG8_STAGE
#undef PG8_LDA
#undef PG8_LDB
#undef PG8_MMA
#undef PG8_WAIT_V
#undef PG8_WAIT_L
#undef PG8_BAR
#undef PG8_SCHED
}
}
__device__ __forceinline__ unsigned long long rt() { return __builtin_amdgcn_s_memrealtime(); }
#define XB_TMO      128
#define XB_XCNT(j)  (256  + 64 * (j))
#define XB_XSUB(j)  (1280 + 64 * (j))
#define XB_XGEN(j)  (2304 + 64 * (j))
#define XB_TOP      3328
#define XB_TOPGEN   3392
#define XCD_BAR_WORDS 3456
#define XB_SPIN_CAP (1u << 22)

__device__ __forceinline__ unsigned xb_ld(unsigned* p)              { return __hip_atomic_load(p, __ATOMIC_RELAXED, __HIP_MEMORY_SCOPE_AGENT); }
__device__ __forceinline__ unsigned xb_add(unsigned* p, unsigned v) { return __hip_atomic_fetch_add(p, v, __ATOMIC_RELAXED, __HIP_MEMORY_SCOPE_AGENT); }
__device__ __forceinline__ unsigned xb_xcc_id() { return (unsigned)__builtin_amdgcn_s_getreg((3 << 11) | 20) & 0xFu; }
#define XB_SPIN(cond, bar) do { unsigned _sp = 0; while (cond) { __builtin_amdgcn_s_sleep(1); \
    if ((++_sp & 255u) == 0u) { if (xb_ld(&(bar)[XB_TMO])) break; if (_sp > XB_SPIN_CAP) { atomicAdd(&(bar)[XB_TMO], 1u); break; } } } } while (0)

struct XcdBarrier {
    unsigned* bar; unsigned x;
    volatile LAS unsigned* st;
};

__device__ __forceinline__ XcdBarrier xcd_barrier_post(unsigned* bar, volatile LAS unsigned* st) {
    XcdBarrier b; b.bar = bar; b.x = xb_xcc_id(); b.st = st;
    if (threadIdx.x == 0) (void)xb_add(&bar[XB_XCNT(b.x)], 1u);
    return b;
}
__device__ __forceinline__ void xcd_barrier_complete(unsigned* bar, unsigned x, unsigned& nloc, unsigned& nx) {
    const unsigned G = gridDim.x * gridDim.y * gridDim.z;
    unsigned sum, cnt, mine, sp = 0u;
    for (;;) {
        sum = 0u; cnt = 0u; mine = 0u;
#pragma unroll
        for (unsigned j = 0; j < 16; ++j) { const unsigned c = xb_ld(&bar[XB_XCNT(j)]); sum += c; cnt += (c > 0u) ? 1u : 0u; mine = (j == x) ? c : mine; }
        if (sum == G) break;
        __builtin_amdgcn_s_sleep(1);
        if ((++sp & 255u) == 0u) { if (xb_ld(&bar[XB_TMO])) break; if (sp > XB_SPIN_CAP) { atomicAdd(&bar[XB_TMO], 1u); break; } }
    }
    nloc = mine > 0u ? mine : 1u; nx = cnt > 0u ? cnt : 1u;
}

__device__ __forceinline__ void xcd_barrier(const XcdBarrier& b) {
    asm volatile("s_waitcnt vmcnt(0)" ::: "memory");
    __syncthreads();
    if (threadIdx.x == 0) {
        unsigned* bar = b.bar;
        __builtin_amdgcn_s_waitcnt(0);
        unsigned nloc = b.st[0], nx = b.st[1];
        if (nloc == 0u) { xcd_barrier_complete(bar, b.x, nloc, nx); b.st[0] = nloc; b.st[1] = nx; }
        const unsigned old = xb_add(&bar[XB_XSUB(b.x)], 1u);
        const unsigned gen = old / nloc;
        if (old + 1u == (gen + 1u) * nloc) {
            __builtin_amdgcn_fence(__ATOMIC_RELEASE, "agent");
            asm volatile("s_waitcnt vmcnt(0)" ::: "memory");
            const unsigned og = xb_add(&bar[XB_TOP], 1u);
            const unsigned tg = og / nx;
            if (og + 1u == (tg + 1u) * nx) xb_add(&bar[XB_TOPGEN], 1u);
            else XB_SPIN(xb_ld(&bar[XB_TOPGEN]) == tg, bar);
            __builtin_amdgcn_fence(__ATOMIC_ACQUIRE, "agent");
            xb_add(&bar[XB_XGEN(b.x)], 1u);
            asm volatile("s_waitcnt vmcnt(0)" ::: "memory");
        } else {
            XB_SPIN(xb_ld(&bar[XB_XGEN(b.x)]) == gen, bar);
            __builtin_amdgcn_fence(__ATOMIC_ACQUIRE, "agent");
            asm volatile("s_waitcnt vmcnt(0)" ::: "memory");
        }
    }
    __syncthreads();
}

struct Args {
    const float* in[24];
    float* out; unsigned char* ws;
    int ph_lo, ph_hi;
};
typedef const __attribute__((address_space(4))) Args CArgs;
enum InIdx { I_X = 0, I_C, I_CTX, I_CCTX, I_WADA, I_BADA, I_NMIXPRE, I_NMIXPOST, I_NMLPPRE, I_NMLPPOST, I_WIN, I_WOUT, I_GCONV, I_GALOG, I_GDT, I_GNORM,
             I_QNORM, I_KVNORM, I_WUQ, I_WUKV, I_LBLOG, I_HNORM, I_W1, I_W2 };

__device__ __forceinline__ const float* resid_in0(const float* x, const float* ctx, int row) {
    const int b = row / TPB, t = row - b * TPB;
    return t < CTXL ? ctx + ((size_t)b * CTXL + t) * DM : x + ((size_t)b * SEQ + (t - CTXL)) * DM;
}
__device__ __forceinline__ float* resid_ptr(float* out, float* xc, int row) {
    const int b = row / TPB, t = row - b * TPB;
    return t < CTXL ? xc + ((size_t)b * CTXL + t) * DM : out + ((size_t)b * SEQ + (t - CTXL)) * DM;
}
__device__ __forceinline__ int mod_row(int row) { const int b = row / TPB, t = row - b * TPB; return t < CTXL ? 8 : b; }

__device__ __forceinline__ void transpose_item(const float* W, int K, int ldsrc, int nsrc, bool zmap, const float* gain, bf16* WT, LAS float* scr, int item, int nblk, int lane) {
    const int kb = item / nblk, nb = item % nblk, k0 = 32 * kb, n0 = 64 * nb;
    const int np = n0 + lane; int src = zmap ? zcol_src(np) : np; if (src >= nsrc) src = -1;
#pragma unroll 8
    for (int kk = 0; kk < 32; ++kk) { float v = 0.f; if (src >= 0) { v = W[(size_t)(k0 + kk) * ldsrc + src]; if (gain) v *= gain[k0 + kk]; } scr[kk * 65 + lane] = v; }
    LDS_WAIT(); asm volatile("" ::: "memory");
    const int c = lane & 3;
#pragma unroll
    for (int j = 0; j < 4; ++j) { const int n = (lane >> 2) + 16 * j; const LAS float* s = scr + (8 * c) * 65 + n;
        v4u o; o.x = pk2(s[0 * 65], s[1 * 65]); o.y = pk2(s[2 * 65], s[3 * 65]); o.z = pk2(s[4 * 65], s[5 * 65]); o.w = pk2(s[6 * 65], s[7 * 65]);
        *(GAS v4u*)(WT + (size_t)(n0 + n) * K + k0 + 8 * c) = o; }
    LDS_WAIT(); asm volatile("" ::: "memory");
}
__device__ __forceinline__ void p0a_prologue(CArgs& a, LAS unsigned char* lds, int vcu, int G, int wave, int lane, int tid) {
    LAS float* scr = (LAS float*)(lds + wave * 8320);
    const int gw = vcu * NWAVES + wave, NGW = G * NWAVES;
    constexpr int I_IN = (DM / 32) * (ZLD / 64), I_OUT = (DM / 32) * (DM / 64), I_1 = (DM / 32) * (DFF / 64), I_2 = (DFF / 32) * (DM / 64), I_UQ = (256 / 32) * (512 / 64), I_UKV = (128 / 32) * (512 / 64);
    constexpr int PER_LAYER = I_IN + I_OUT + I_1 + I_2 + I_UQ + I_UKV;
    for (int it = gw; it < DEPTH * PER_LAYER; it += NGW) {
        const int l = it / PER_LAYER; int r = it - l * PER_LAYER;
        unsigned char* wb = a.ws + WS_W + (size_t)l * W_LAYER;
        if (r < I_IN) { transpose_item(a.in[I_WIN] + (size_t)l * DM * DIN, DM, DIN, DIN, true, nullptr, (bf16*)(wb + W_IN), scr, r, ZLD / 64, lane); continue; } r -= I_IN;
        if (r < I_OUT) { transpose_item(a.in[I_WOUT] + (size_t)l * DM * DM, DM, DM, DM, false, nullptr, (bf16*)(wb + W_OUT), scr, r, DM / 64, lane); continue; } r -= I_OUT;
        if (r < I_1) { transpose_item(a.in[I_W1] + (size_t)l * DM * DFF, DM, DFF, DFF, false, nullptr, (bf16*)(wb + W_1), scr, r, DFF / 64, lane); continue; } r -= I_1;
        if (r < I_2) { transpose_item(a.in[I_W2] + (size_t)l * DFF * DM, DFF, DM, DM, false, nullptr, (bf16*)(wb + W_2), scr, r, DM / 64, lane); continue; } r -= I_2;
        if (r < I_UQ) { transpose_item(a.in[I_WUQ] + (size_t)l * 256 * 384, 256, 384, 384, false, a.in[I_QNORM] + l * 256, (bf16*)(wb + W_UQ), scr, r, 512 / 64, lane); continue; } r -= I_UQ;
        transpose_item(a.in[I_WUKV] + (size_t)l * 128 * 512, 128, 512, 512, false, a.in[I_KVNORM] + l * 128, (bf16*)(wb + W_UKV), scr, r, 512 / 64, lane);
    }
    {
        const int gt = vcu * (NWAVES * 64) + tid, NGT = G * NWAVES * 64;
        float* rc = (float*)(a.ws + WS_ROPE); float* rs = rc + SEQ * 16;
        for (int i = gt; i < SEQ * 16; i += NGT) { const int t = i >> 4, j = i & 15, f = j & 7;
            const float inv = exp2f(-(float)f * 0.125f * 13.287712379549449f);
            const float pos = (float)(j < 8 ? (t >> 6) : (t & 63)); const float ang = pos * inv;
            rc[i] = cosf(ang); rs[i] = sinf(ang); }
        float* lb = (float*)(a.ws + WS_LB);
        for (int i = gt; i < 2 * 1024; i += NGT) { const int l = i >> 10, j = i & 1023;
            const float l0 = a.in[I_LBLOG][j], l1 = a.in[I_LBLOG][1024 + j];
            lb[i] = l == 0 ? 0.f : 1.0f / (1.0f + expf(l0 - l1)); }
    }
    if (wave == 0 && vcu < 192) {
        LAS float* sc = (LAS float*)(lds + 69632);
        for (int i = lane; i < 9 * 1024; i += 64) { const int r = i >> 10, k = i & 1023; const float v = r < 8 ? a.in[I_C][r * 1024 + k] : a.in[I_CCTX][k]; sc[i] = siluf_(v); }
        LDS_WAIT(); asm volatile("" ::: "memory");
        const int l = vcu / 96, n = (vcu % 96) * 64 + lane;
        const float* w = a.in[I_WADA] + (size_t)l * DM * 6 * DM + n;
        float acc[9];
#pragma unroll
        for (int r = 0; r < 9; ++r) acc[r] = 0.f;
#pragma unroll 8
        for (int k = 0; k < DM; ++k) { const float wv = w[(size_t)k * 6 * DM];
#pragma unroll
            for (int r = 0; r < 9; ++r) acc[r] += sc[r * 1024 + k] * wv; }
        const float bv = a.in[I_BADA][l * 6 * DM + n];
        float* mods = (float*)(a.ws + WS_MODS) + (size_t)l * 9 * 6 * DM;
#pragma unroll
        for (int r = 0; r < 9; ++r) mods[(size_t)r * 6 * DM + n] = acc[r] + bv;
    }
}

__device__ __forceinline__ void norm_mod_store(const f32x4 (&v)[4], const float* gain, const float* sh, const float* sc, bf16* orow, int lane) {
    float ss = 0.f;
#pragma unroll
    for (int j = 0; j < 4; ++j) ss += (v[j].x * v[j].x + v[j].y * v[j].y) + (v[j].z * v[j].z + v[j].w * v[j].w);
    const float rstd = rsqrtf(wave_sum(ss) * (1.f / DM) + EPS);
    GAS v2u* o8 = (GAS v2u*)orow + lane;
#pragma unroll
    for (int j = 0; j < 4; ++j) { const int c = 4 * lane + 256 * j;
        const f32x4 g = *(const f32x4*)(gain + c), s1 = *(const f32x4*)(sh + c), s2 = *(const f32x4*)(sc + c);
        f32x4 h; h.x = v[j].x * rstd * g.x * (1.f + s2.x) + s1.x; h.y = v[j].y * rstd * g.y * (1.f + s2.y) + s1.y; h.z = v[j].z * rstd * g.z * (1.f + s2.z) + s1.z; h.w = v[j].w * rstd * g.w * (1.f + s2.w) + s1.w;
        v2u w; w.x = pk2(h.x, h.y); w.y = pk2(h.z, h.w); o8[64 * j] = w; }
}
__device__ __forceinline__ void p0b_prenorm(CArgs& a, int gw, int NGW, int lane) {
    const float* mods = (const float*)(a.ws + WS_MODS);
    bf16* HB = (bf16*)(a.ws + WS_HB);
    for (int row = gw; row < MT; row += NGW) {
        const GAS f32x4* xr = (const GAS f32x4*)resid_in0(a.in[I_X], a.in[I_CTX], row) + lane;
        f32x4 v[4];
#pragma unroll
        for (int j = 0; j < 4; ++j) v[j] = xr[64 * j];
        const float* m = mods + (size_t)mod_row(row) * 6 * DM;
        norm_mod_store(v, a.in[I_NMIXPRE], m, m + DM, HB + (size_t)row * DM, lane);
    }
}
__device__ __forceinline__ void post_pass(CArgs& a, int layer, int which, int gw, int NGW, int lane) {
    const float* mods = (const float*)(a.ws + WS_MODS) + (size_t)layer * 9 * 6 * DM;
    bf16* HB = (bf16*)(a.ws + WS_HB); float* xc = (float*)(a.ws + WS_XC);
    const float* gpost = (which == 0 ? a.in[I_NMIXPOST] : a.in[I_NMLPPOST]) + layer * DM;
    const bool has_next = (which == 0) || (layer + 1 < DEPTH);
    const float* gnext = which == 0 ? a.in[I_NMLPPRE] + layer * DM : a.in[I_NMIXPRE] + (layer + 1) * DM;
    for (int row = gw; row < MT; row += NGW) {
        const int mr = mod_row(row);
        if (layer == DEPTH - 1 && mr == 8) continue;
        const float* m = mods + (size_t)mr * 6 * DM;
        const float* gate = m + (which == 0 ? 2 : 5) * DM;
        const GAS v2u* yr = (const GAS v2u*)(HB + (size_t)row * DM) + lane;
        const float* xin = (layer == 0 && which == 0) ? resid_in0(a.in[I_X], a.in[I_CTX], row) : resid_ptr(a.out, xc, row);
        float* xout = resid_ptr(a.out, xc, row);
        f32x4 y[4], x[4]; float ss = 0.f;
#pragma unroll
        for (int j = 0; j < 4; ++j) { const v2u w = yr[64 * j]; y[j] = (f32x4){bflo(w.x), bfhi(w.x), bflo(w.y), bfhi(w.y)}; x[j] = *((const GAS f32x4*)xin + lane + 64 * j);
            ss += (y[j].x * y[j].x + y[j].y * y[j].y) + (y[j].z * y[j].z + y[j].w * y[j].w); }
        const float rstd = rsqrtf(wave_sum(ss) * (1.f / DM) + EPS);
#pragma unroll
        for (int j = 0; j < 4; ++j) { const int c = 4 * lane + 256 * j; const f32x4 gp = *(const f32x4*)(gpost + c), gt = *(const f32x4*)(gate + c);
            x[j].x += gt.x * (y[j].x * rstd * gp.x); x[j].y += gt.y * (y[j].y * rstd * gp.y); x[j].z += gt.z * (y[j].z * rstd * gp.z); x[j].w += gt.w * (y[j].w * rstd * gp.w);
            *((GAS f32x4*)xout + lane + 64 * j) = x[j]; }
        if (has_next) {
            const float* mn = which == 0 ? m : (const float*)(a.ws + WS_MODS) + ((size_t)(layer + 1) * 9 + mr) * 6 * DM;
            const float* sh = mn + (which == 0 ? 3 : 0) * DM; const float* sc = mn + (which == 0 ? 4 : 1) * DM;
            norm_mod_store(x, gnext, sh, sc, HB + (size_t)row * DM, lane);
        }
    }
}
__device__ __forceinline__ void mla_rope_pass(CArgs& a, LAS unsigned char* lds, int wave, int gw, int NGW, int lane) {
    bf16* HB = (bf16*)(a.ws + WS_HB); const bf16* Z = (const bf16*)(a.ws + WS_Z);
    const float* rc = (const float*)(a.ws + WS_ROPE); const float* rs = rc + SEQ * 16;
    LAS bf16* raw = (LAS bf16*)(lds + wave * 2304);
    for (int row = gw; row < MT; row += NGW) {
        const int b = row / TPB, t = row - b * TPB; const bool lat = t >= CTXL; const int tp = t - CTXL;
        const GAS v4u* hr = (const GAS v4u*)(HB + (size_t)row * DM);
        const v4u r0 = hr[lane], r1 = hr[64 + lane];
        const bf16* zr = Z + (size_t)row * ZLD;
        const v2u cq = *((const GAS v2u*)(zr + ZC_CQ) + lane); const unsigned ckv = *((const GAS unsigned*)(zr + ZC_CKV) + lane);
        float s1 = bflo(cq.x) * bflo(cq.x) + bfhi(cq.x) * bfhi(cq.x) + bflo(cq.y) * bflo(cq.y) + bfhi(cq.y) * bfhi(cq.y);
        float s2 = bflo(ckv) * bflo(ckv) + bfhi(ckv) * bfhi(ckv);
        const float sq = rsqrtf(wave_sum(s1) * (1.f / 256.f) + EPS) * ATT_C2, skv = rsqrtf(wave_sum(s2) * (1.f / 128.f) + EPS);
        *((LAS v4u*)raw + lane) = r0; *((LAS v4u*)raw + 64 + lane) = r1;
        if (lane < 16) *((LAS unsigned*)(raw + 1024) + lane) = *((const GAS unsigned*)(zr + ZC_KR) + lane);
        VM_WAIT(); LDS_WAIT(); asm volatile("" ::: "memory");
        unsigned ow[8];
#pragma unroll
        for (int e2 = 0; e2 < 8; ++e2) { float o2[2];
#pragma unroll
            for (int q = 0; q < 2; ++q) { const int c = lane * 16 + e2 * 2 + q; float val;
                if (c < 384) { const int h = c / 96, d = c - h * 96;
                    if (d < 64 || !lat) val = bf2f(raw[c]) * sq;
                    else { const int i = (d - 64) & 15, hf = (d - 64) >> 4; const float t1 = bf2f(raw[h * 96 + 64 + i]), t2 = bf2f(raw[h * 96 + 80 + i]), cs = rc[tp * 16 + i], sn = rs[tp * 16 + i];
                           val = (hf == 0 ? t1 * cs - t2 * sn : t1 * sn + t2 * cs) * sq; } }
                else if (c < 768) { const int cc = c - 384, h = cc / 96, d = cc - h * 96;
                    if (d < 64) val = bf2f(raw[512 + h * 128 + d]) * skv;
                    else if (!lat) val = bf2f(raw[1024 + d - 64]);
                    else { const int i = (d - 64) & 15, hf = (d - 64) >> 4; const float t1 = bf2f(raw[1024 + i]), t2 = bf2f(raw[1040 + i]), cs = rc[tp * 16 + i], sn = rs[tp * 16 + i];
                           val = hf == 0 ? t1 * cs - t2 * sn : t1 * sn + t2 * cs; } }
                else { const int cc = c - 768, h = cc >> 6, dv = cc & 63; val = bf2f(raw[512 + h * 128 + 64 + dv]) * skv; }
                o2[q] = val; }
            ow[e2] = pk2(o2[0], o2[1]); }
        GAS v4u* orow = (GAS v4u*)(HB + (size_t)row * DM) + 2 * lane;
        orow[0] = (v4u){ow[0], ow[1], ow[2], ow[3]}; orow[1] = (v4u){ow[4], ow[5], ow[6], ow[7]};
        LDS_WAIT(); asm volatile("" ::: "memory");
    }
}

namespace att {
constexpr int KT_BYTES = 12288, VT_BYTES = 8192, SLOT = KT_BYTES + VT_BYTES, WS_OFF = 2 * SLOT;
__device__ __forceinline__ int crow(int r, int hi) { return (r & 3) + 8 * (r >> 2) + 4 * hi; }
#define ATT_WAIT_BAR() asm volatile("s_waitcnt vmcnt(0) lgkmcnt(0)\n\ts_barrier" ::: "memory")
__device__ __forceinline__ float rowmax32(const f32x16& p0, const f32x16& p1) {
    float m = fmaxf(p0[0], p1[0]);
#pragma unroll
    for (int r = 1; r < 16; ++r) m = fmaxf(m, fmaxf(p0[r], p1[r]));
    return fmaxf(m, __shfl_xor(m, 32));
}
__device__ __forceinline__ unsigned cvtpk(float lo, float hi) { unsigned r; asm volatile("v_cvt_pk_bf16_f32 %0, %1, %2" : "=v"(r) : "v"(lo), "v"(hi)); return r; }
__device__ __forceinline__ void att_dma(const bf16* HB, LAS unsigned char* lds, int rowb, int h, int t, int slot, int wid, int lane) {
    const bf16* kv = HB + (size_t)(rowb + 64 * t) * DM;
#pragma unroll
    for (int i = 0; i < 3; ++i) { const int p = wid + 8 * i;
        if (p < 12) __builtin_amdgcn_global_load_lds((const unsigned*)(kv + (size_t)lane * DM + HB_K + h * 96 + p * 8), (LAS unsigned*)(lds + slot * SLOT + p * 1024), 16, 0, 0);
        else if (p < 20) { const int pv_ = p - 12, dh = pv_ >> 2, rg = pv_ & 3;
            __builtin_amdgcn_global_load_lds((const unsigned*)(kv + (size_t)(16 * rg + (lane >> 2)) * DM + HB_V + h * 64 + dh * 32 + (lane & 3) * 8), (LAS unsigned*)(lds + slot * SLOT + KT_BYTES + pv_ * 1024), 16, 0, 0); } }
}
__device__ __forceinline__ void attn_unit(int b, int h, int qb, const bf16* HB, bf16* Z, LAS unsigned char* lds) {
    int tid_ = threadIdx.x; asm volatile("" : "+v"(tid_)); const int tid = tid_, lane = tid & 63, r32 = lane & 31, hi = lane >> 5; const int wid = __builtin_amdgcn_readfirstlane(tid >> 6);
    const int rowb = b * TPB; const int row0 = rowb + 256 * qb + 32 * wid;
    const int NT = qb == 0 ? CTXL / 64 : TPB / 64;
    LAS float* wsf = (LAS float*)(lds + WS_OFF + wid * 256);
    const unsigned lds0 = (unsigned)(uintptr_t)lds;
    att_dma(HB, lds, rowb, h, 0, 0, wid, lane);
    bf16x8 qr[6];
#pragma unroll
    for (int d0 = 0; d0 < 6; ++d0) qr[d0] = *(const bf16x8*)(HB + (size_t)(row0 + r32) * DM + HB_Q + h * 96 + d0 * 16 + hi * 8);
    float mref = -1e30f, lsum = 0.f; f32x16 o[2]; o[0] = f32x16{}; o[1] = f32x16{};
    ATT_WAIT_BAR();
    for (int t = 0; t < NT; ++t) {
        const int slot = t & 1;
        if (t + 1 < NT) att_dma(HB, lds, rowb, h, t + 1, slot ^ 1, wid, lane);
        f32x16 p0 = f32x16{}, p1 = f32x16{};
        { const LAS unsigned char* kb = lds + slot * SLOT + hi * 1024 + r32 * 16;
#pragma unroll
          for (int d0 = 0; d0 < 6; ++d0) { const bf16x8 k0 = *(const LAS bf16x8*)(kb + d0 * 2048), k1 = *(const LAS bf16x8*)(kb + d0 * 2048 + 512);
              p0 = __builtin_amdgcn_mfma_f32_32x32x16_bf16(k0, qr[d0], p0, 0, 0, 0); p1 = __builtin_amdgcn_mfma_f32_32x32x16_bf16(k1, qr[d0], p1, 0, 0, 0); } }
        const float rm = rowmax32(p0, p1);
        if (__any(rm > mref + 8.0f)) {
            const float mn = fmaxf(mref, rm), al = __builtin_amdgcn_exp2f(mref - mn); mref = mn; lsum *= al;
            if (hi == 0) wsf[r32] = al;
            LDS_WAIT(); asm volatile("" ::: "memory");
#pragma unroll
            for (int r = 0; r < 16; ++r) { const float f = wsf[crow(r, hi)]; o[0][r] *= f; o[1][r] *= f; }
            LDS_WAIT(); asm volatile("" ::: "memory");
        }
        float sacc = 0.f;
#pragma unroll
        for (int r = 0; r < 16; ++r) { p0[r] = __builtin_amdgcn_exp2f(p0[r] - mref); p1[r] = __builtin_amdgcn_exp2f(p1[r] - mref); sacc += p0[r] + p1[r]; }
        lsum += sacc;
        v4u pw[4];
#pragma unroll
        for (int k = 0; k < 2; ++k) { pw[k] = (v4u){cvtpk(p0[8 * k], p0[8 * k + 1]), cvtpk(p0[8 * k + 2], p0[8 * k + 3]), cvtpk(p0[8 * k + 4], p0[8 * k + 5]), cvtpk(p0[8 * k + 6], p0[8 * k + 7])};
            pw[2 + k] = (v4u){cvtpk(p1[8 * k], p1[8 * k + 1]), cvtpk(p1[8 * k + 2], p1[8 * k + 3]), cvtpk(p1[8 * k + 4], p1[8 * k + 5]), cvtpk(p1[8 * k + 6], p1[8 * k + 7])}; }
        { const int vb = (int)(lds0 + slot * SLOT + KT_BYTES) + ((lane >> 4) & 1) * 32 + (lane & 3) * 8 + (4 * hi + ((lane & 15) >> 2)) * 64;
#pragma unroll
          for (int d0 = 0; d0 < 2; ++d0) { s16x4 lo[4], hh[4];
#pragma unroll
              for (int ks = 0; ks < 4; ++ks) {
                  asm volatile("ds_read_b64_tr_b16 %0,%1 offset:%c2" : "=&v"(lo[ks]) : "v"(vb), "i"(d0 * 4096 + ks * 1024) : "memory");
                  asm volatile("ds_read_b64_tr_b16 %0,%1 offset:%c2" : "=&v"(hh[ks]) : "v"(vb), "i"(d0 * 4096 + ks * 1024 + 512) : "memory"); }
              asm volatile("s_waitcnt lgkmcnt(0)" ::: "memory"); __builtin_amdgcn_sched_barrier(0);
#pragma unroll
              for (int ks = 0; ks < 4; ++ks) { const bf16x8 vf = (bf16x8){lo[ks][0], lo[ks][1], lo[ks][2], lo[ks][3], hh[ks][0], hh[ks][1], hh[ks][2], hh[ks][3]};
                  o[d0] = __builtin_amdgcn_mfma_f32_32x32x16_bf16(__builtin_bit_cast(bf16x8, pw[ks]), vf, o[d0], 0, 0, 0); } } }
        ATT_WAIT_BAR();
    }
    lsum += __shfl_xor(lsum, 32);
    if (hi == 0) wsf[32 + r32] = lsum;
    LDS_WAIT(); asm volatile("" ::: "memory");
#pragma unroll
    for (int r = 0; r < 16; ++r) { const int q = crow(r, hi); const float inv = 1.0f / wsf[32 + q];
        bf16* op = Z + (size_t)(row0 + q) * ZLD + ZC_CQ + h * 64 + r32;
        op[0] = (bf16)f2bf(o[0][r] * inv); op[32] = (bf16)f2bf(o[1][r] * inv); }
    ATT_WAIT_BAR();
}
}

__device__ __forceinline__ float softplusf_(float x) { return x > 20.f ? x : log1pf(__expf(x)); }
__device__ __forceinline__ int chunk32_t0(int step, int dir, int& lo, int& hi) {
    if (step < 8) { lo = 0; hi = CTXL; return 32 * (dir ? 7 - step : step); }
    lo = CTXL; hi = TPB; return CTXL + 32 * (dir ? 127 - (step - 8) : step - 8);
}
namespace gdn0 {
constexpr int RAW_OFF = 0, QF_OFF = 28672, KF_OFF = QF_OFF + 16384, VF_OFF = KF_OFF + 16384, CW_OFF = 77824, RED_OFF = 86016, RED2_OFF = 90112, OSUM_OFF = 94208, SCA_OFF = 110592;
__device__ __forceinline__ void chain(CArgs& a, LAS unsigned char* lds, int layer, int b, int h) {
    int tid_ = threadIdx.x; asm volatile("" : "+v"(tid_)); const int tid = tid_, lane = tid & 63, wave = tid >> 6;
    bf16* Z = (bf16*)(a.ws + WS_Z); bf16* OS = (bf16*)(a.ws + WS_OSG);
    LAS bf16* RAW = (LAS bf16*)(lds + RAW_OFF); LAS float* QF = (LAS float*)(lds + QF_OFF); LAS float* KF = (LAS float*)(lds + KF_OFF); LAS float* VF = (LAS float*)(lds + VF_OFF);
    LAS float* CW = (LAS float*)(lds + CW_OFF); LAS float* RED = (LAS float*)(lds + RED_OFF); LAS float* RED2 = (LAS float*)(lds + RED2_OFF); LAS float* OSUM = (LAS float*)(lds + OSUM_OFF);
    LAS float* BETA = (LAS float*)(lds + SCA_OFF); LAS float* AV = BETA + 32;
    __syncthreads();
    for (int i = tid; i < 5 * 384; i += 512) { const int j = i / 384, c = i - j * 384; CW[i] = a.in[I_GCONV][(size_t)layer * 5 * 1536 + j * 1536 + (c >> 7) * 512 + h * 128 + (c & 127)]; }
    const float* gn = a.in[I_GNORM] + layer * 128;
    const int e = tid & 127, dg = tid >> 7; const size_t rowb = (size_t)b * TPB;
    for (int dir = 0; dir < 2; ++dir) {
        float S[32];
#pragma unroll
        for (int j = 0; j < 32; ++j) S[j] = 0.f;
        const float A_ = expf(a.in[I_GALOG][layer * 8 + dir * 4 + h]), dtb = a.in[I_GDT][layer * 8 + dir * 4 + h];
        for (int step = 0; step < 136; ++step) {
            int lo, hi; const int t0 = chunk32_t0(step, dir, lo, hi);
            __syncthreads();
            for (int idx = tid; idx < 36 * 48; idx += 512) { const int rr = idx / 48, ch = idx - rr * 48, t = t0 - 2 + rr; v4u v = (v4u){0u, 0u, 0u, 0u};
                if (t >= lo && t < hi) v = *(const GAS v4u*)(Z + (rowb + t) * ZLD + (ch >> 4) * 512 + h * 128 + (ch & 15) * 8);
                *(LAS v4u*)(RAW + rr * 384 + ch * 8) = v; }
            if (tid < 32) { const bf16* zr = Z + (rowb + t0 + tid) * ZLD; const float zb = bf2f(zr[ZC_GB + dir * 4 + h]), za = bf2f(zr[ZC_GA + dir * 4 + h]);
                BETA[tid] = sigmoidf_(zb); AV[tid] = __expf(-A_ * softplusf_(za + dtb)); }
            __syncthreads();
            for (int idx = tid; idx < 32 * 384; idx += 512) { const int i = idx / 384, c = idx - i * 384; float acc = 0.f;
#pragma unroll
                for (int j = 0; j < 5; ++j) acc += CW[j * 384 + c] * bf2f(RAW[(i + j) * 384 + c]);
                const float y = siluf_(acc); LAS float* dst = c < 128 ? QF : (c < 256 ? KF : VF); dst[i * 128 + (c & 127)] = y; }
            __syncthreads();
            for (int pp = 0; pp < 8; ++pp) { const int p = wave * 8 + pp, tok = p >> 1, which = p & 1; LAS float* ptr = (which ? KF : QF) + tok * 128;
                const float x0 = ptr[lane], x1 = ptr[lane + 64]; const float sc = rsqrtf(wave_sum(x0 * x0 + x1 * x1) + 1e-6f) * (which ? 1.0f : 0.08838834764831845f);
                ptr[lane] = x0 * sc; ptr[lane + 64] = x1 * sc; }
            __syncthreads();
            for (int ii = 0; ii < 32; ++ii) {
                const int i = dir ? 31 - ii : ii, p = ii & 1;
                const LAS f32x4* kr = (const LAS f32x4*)(KF + i * 128 + dg * 32); const LAS f32x4* qr = (const LAS f32x4*)(QF + i * 128 + dg * 32);
                float kk[32]; float part = 0.f;
#pragma unroll
                for (int j = 0; j < 8; ++j) { const f32x4 v = kr[j]; kk[4 * j] = v.x; kk[4 * j + 1] = v.y; kk[4 * j + 2] = v.z; kk[4 * j + 3] = v.w; }
#pragma unroll
                for (int j = 0; j < 32; ++j) part += kk[j] * S[j];
                RED[p * 512 + dg * 128 + e] = part;
                __syncthreads();
                if (ii > 0 && dg == 0) { const int ip = dir ? 32 - ii : ii - 1; const LAS float* r2 = RED2 + (p ^ 1) * 512 + e; const float o = (r2[0] + r2[128]) + (r2[256] + r2[384]);
                    const size_t oi = (rowb + t0 + ip) * 512 + h * 128 + e;
                    if (dir == 0) OS[oi] = (bf16)f2bf(o); else OSUM[ip * 128 + e] = o + bf2f(OS[oi]); }
                const LAS float* r1 = RED + p * 512 + e; const float kS = (r1[0] + r1[128]) + (r1[256] + r1[384]);
                const float av = AV[i], delta = BETA[i] * (VF[i * 128 + e] - av * kS);
                float opart = 0.f;
#pragma unroll
                for (int j = 0; j < 8; ++j) { const f32x4 q4 = qr[j];
                    S[4 * j] = av * S[4 * j] + kk[4 * j] * delta; S[4 * j + 1] = av * S[4 * j + 1] + kk[4 * j + 1] * delta; S[4 * j + 2] = av * S[4 * j + 2] + kk[4 * j + 2] * delta; S[4 * j + 3] = av * S[4 * j + 3] + kk[4 * j + 3] * delta;
                    opart += (q4.x * S[4 * j] + q4.y * S[4 * j + 1]) + (q4.z * S[4 * j + 2] + q4.w * S[4 * j + 3]); }
                RED2[p * 512 + dg * 128 + e] = opart;
            }
            __syncthreads();
            if (dg == 0) { const int ip = dir ? 0 : 31; const LAS float* r2 = RED2 + 1 * 512 + e; const float o = (r2[0] + r2[128]) + (r2[256] + r2[384]);
                const size_t oi = (rowb + t0 + ip) * 512 + h * 128 + e;
                if (dir == 0) OS[oi] = (bf16)f2bf(o); else OSUM[ip * 128 + e] = o + bf2f(OS[oi]); }
            if (dir == 1) {
                __syncthreads();
                for (int tt = 0; tt < 4; ++tt) { const int tok = wave * 4 + tt; const float x0 = OSUM[tok * 128 + lane], x1 = OSUM[tok * 128 + lane + 64];
                    const float rs = rsqrtf(wave_sum(x0 * x0 + x1 * x1) * (1.f / 128.f) + EPS);
                    bf16* zg = Z + (rowb + t0 + tok) * ZLD + ZC_GG + h * 128;
                    const float g0 = bf2f(zg[lane]), g1 = bf2f(zg[lane + 64]);
                    zg[lane] = (bf16)f2bf(x0 * rs * gn[lane] * siluf_(g0)); zg[lane + 64] = (bf16)f2bf(x1 * rs * gn[lane + 64] * siluf_(g1)); }
            }
        }
    }
}
}
namespace hg0 {
constexpr int QF_OFF = 0, FF_OFF = 16384, KF_OFF = 32768, VF_OFF = 49152, RED_OFF = 57344, OSUM_OFF = 61440;
__device__ __forceinline__ void chain(CArgs& a, LAS unsigned char* lds, int layer, int b, int h) {
    int tid_ = threadIdx.x; asm volatile("" : "+v"(tid_)); const int tid = tid_, lane = tid & 63, wave = tid >> 6;
    bf16* Z = (bf16*)(a.ws + WS_Z); bf16* OS = (bf16*)(a.ws + WS_OSH); const float* LB = (const float*)(a.ws + WS_LB);
    LAS float* QF = (LAS float*)(lds + QF_OFF); LAS float* FF = (LAS float*)(lds + FF_OFF); LAS float* KF = (LAS float*)(lds + KF_OFF); LAS float* VF = (LAS float*)(lds + VF_OFF);
    LAS float* RED = (LAS float*)(lds + RED_OFF); LAS float* OSUM = (LAS float*)(lds + OSUM_OFF);
    const float* hn = a.in[I_HNORM] + layer * 64;
    const int e = tid & 63, dg = tid >> 6; const size_t rowb = (size_t)b * TPB;
    for (int dir = 0; dir < 2; ++dir) {
        float S[16];
#pragma unroll
        for (int j = 0; j < 16; ++j) S[j] = 0.f;
        const int zf = dir ? ZC_HFB : ZC_HFF;
        for (int step = 0; step < 136; ++step) {
            int lo, hi; const int t0 = chunk32_t0(step, dir, lo, hi);
            __syncthreads();
            for (int idx = tid; idx < 32 * 128; idx += 512) { const int i = idx >> 7, d = idx & 127; const bf16* zr = Z + (rowb + t0 + i) * ZLD;
                const float xq = bf2f(zr[ZC_HQ + h * 128 + d]), xf = bf2f(zr[zf + h * 128 + d]), lbv = LB[layer * 1024 + dir * 512 + h * 128 + d];
                const float sg = 1.0f / (1.0f + __expf(-xf)), sgn = 1.0f / (1.0f + __expf(xf));
                QF[idx] = xq * 0.08838834764831845f; FF[idx] = lbv + (1.0f - lbv) * sg; KF[idx] = (1.0f - lbv) * sgn; }
            for (int idx = tid; idx < 32 * 64; idx += 512) { const int i = idx >> 6; VF[idx] = bf2f(Z[(rowb + t0 + i) * ZLD + ZC_HI + h * 64 + (idx & 63)]); }
            __syncthreads();
            for (int ii = 0; ii < 32; ++ii) {
                const int i = dir ? 31 - ii : ii, p = ii & 1;
                const LAS f32x4* fr = (const LAS f32x4*)(FF + i * 128 + dg * 16); const LAS f32x4* kr = (const LAS f32x4*)(KF + i * 128 + dg * 16); const LAS f32x4* qr = (const LAS f32x4*)(QF + i * 128 + dg * 16);
                const float v = VF[i * 64 + e]; float opart = 0.f;
#pragma unroll
                for (int j = 0; j < 4; ++j) { const f32x4 f4 = fr[j], k4 = kr[j], q4 = qr[j];
                    S[4 * j] = f4.x * S[4 * j] + k4.x * v; S[4 * j + 1] = f4.y * S[4 * j + 1] + k4.y * v; S[4 * j + 2] = f4.z * S[4 * j + 2] + k4.z * v; S[4 * j + 3] = f4.w * S[4 * j + 3] + k4.w * v;
                    opart += (q4.x * S[4 * j] + q4.y * S[4 * j + 1]) + (q4.z * S[4 * j + 2] + q4.w * S[4 * j + 3]); }
                RED[p * 512 + dg * 64 + e] = opart;
                __syncthreads();
                if (dg == 0) { const LAS float* r = RED + p * 512 + e; const float o = ((r[0] + r[64]) + (r[128] + r[192])) + ((r[256] + r[320]) + (r[384] + r[448]));
                    const size_t oi = (rowb + t0 + i) * 256 + h * 64 + e;
                    if (dir == 0) OS[oi] = (bf16)f2bf(o); else OSUM[i * 64 + e] = o + bf2f(OS[oi]); }
            }
            if (dir == 1) {
                __syncthreads();
                for (int tt = 0; tt < 4; ++tt) { const int tok = wave * 4 + tt; const float x = OSUM[tok * 64 + lane];
                    const float rs = rsqrtf(wave_sum(x * x) * (1.f / 64.f) + EPS);
                    bf16* zg = Z + (rowb + t0 + tok) * ZLD + ZC_HG + h * 64;
                    const float g = bf2f(zg[lane]);
                    zg[lane] = (bf16)f2bf(x * rs * hn[lane] * siluf_(g)); }
            }
        }
    }
}
}

#ifndef PH_MASK
#define PH_MASK 0xFFFFF
#endif
#define PH_ON(i) (((PH_MASK) >> (i)) & 1)
constexpr int PH_PER_LAYER = 9, N_PHASES = 2 + DEPTH * PH_PER_LAYER;
enum PhaseKind { PK_GEMM_IN = 0, PK_MLA_UP, PK_MLA_ROPE, PK_MIX, PK_GEMM_OUT, PK_POST1, PK_MLP1, PK_MLP2, PK_POST2 };
constexpr int ATT_UNITS_LAT = NB * 4 * 16, ATT_UNITS_CTX = NB * 4;
__device__ __forceinline__ CArgs& kargs() { CArgs* p = (CArgs*)__builtin_amdgcn_kernarg_segment_ptr(); asm volatile("" : "+s"(p)); return *p; }

__global__ void __launch_bounds__(NWAVES * 64, 2) fwd_kernel(Args args_unused) {
    extern __shared__ __attribute__((aligned(16))) unsigned char lds_[];
    LAS unsigned char* lds = (LAS unsigned char*)lds_;
    {   const int tid = threadIdx.x;
        for (int u = tid; u < (LDS_BYTES - LDSCTL_OFF) / 4; u += NWAVES * 64) ((LAS unsigned*)(lds + LDSCTL_OFF))[u] = 0u; }
    __syncthreads();
    XcdBarrier bar; { unsigned char* ws = kargs().ws; bar.bar = (unsigned*)(ws + WS_CTL) + CW_BAR; bar.x = 0; bar.st = nullptr;
        if (MK_ONE_LAUNCH) bar = xcd_barrier_post(bar.bar, (volatile LAS unsigned*)(lds + MISC_OFF) + 8); }
    const int ph_lo = kargs().ph_lo, ph_hi = kargs().ph_hi;
    for (int ph = ph_lo; ph < ph_hi; ++ph) {
        CArgs& a = kargs();
        int tid_ = threadIdx.x; asm volatile("" : "+v"(tid_));
        const int tid = tid_, lane = tid & 63, wave = __builtin_amdgcn_readfirstlane(tid >> 6);
        const int G = gridDim.x, bx = blockIdx.x, vcu = (G % 8 == 0) ? (bx % 8) * (G / 8) + bx / 8 : bx;
        const int gw = vcu * NWAVES + wave, NGW = G * NWAVES;
        if (ph == 0) { if constexpr (PH_ON(0)) p0a_prologue(a, lds, vcu, G, wave, lane, tid); }
        else if (ph == 1) { if constexpr (PH_ON(1)) p0b_prenorm(a, gw, NGW, lane); }
        else {
            const int layer = (ph - 2) / PH_PER_LAYER, kind = (ph - 2) % PH_PER_LAYER;
            if (kind == PK_GEMM_IN || kind == PK_MLA_UP || kind == PK_GEMM_OUT || kind == PK_MLP1 || kind == PK_MLP2) {
                {
                    bf16* HB = (bf16*)(a.ws + WS_HB); bf16* Z = (bf16*)(a.ws + WS_Z);
                    const unsigned char* wb = a.ws + WS_W + (size_t)layer * W_LAYER;
                    pg8::StaticOrder S;
#define RUN_GEMM(Aop, Bop, N_, K_, LDA_, Out, LDC_, ACT_) do { int kk_ = K_; asm volatile("" : "+s"(kk_)); const pg8::Gemm g{Aop, (const bf16*)(Bop), MT, N_, kk_, LDA_}; const pg8::EpiBf16 E{Out, LDC_, ACT_}; S.init(MT, N_, G, bx); \
                        pg8::gemm_phase<pg8::EpiBf16, pg8::StaticOrder, true, true>(lds, g, S, E); } while (0)
                    if (kind == PK_GEMM_IN)     { if constexpr (PH_ON(2)) RUN_GEMM(HB, wb + W_IN, ZLD, DM, DM, Z, ZLD, 0); }
                    else if (kind == PK_MLA_UP) { if constexpr (PH_ON(3)) RUN_GEMM(Z + ZC_CQ, wb + W_UQ, 512, 256, ZLD, HB, DM, 0);
                                                  if constexpr (PH_ON(11)) RUN_GEMM(Z + ZC_CKV, wb + W_UKV, 512, 128, ZLD, HB + 512, DM, 0); }
                    else if (kind == PK_GEMM_OUT) { if constexpr (PH_ON(6)) RUN_GEMM(Z + ZC_GG, wb + W_OUT, DM, DM, ZLD, HB, DM, 0); }
                    else if (kind == PK_MLP1)   { if constexpr (PH_ON(8)) RUN_GEMM(HB, wb + W_1, DFF, DM, DM, Z, DFF, 2); }
                    else                        { if constexpr (PH_ON(9)) RUN_GEMM(Z, wb + W_2, DM, DFF, DFF, HB, DM, 0); }
#undef RUN_GEMM
                }
            } else if (kind == PK_MLA_ROPE) { if constexpr (PH_ON(4)) mla_rope_pass(a, lds, wave, gw, NGW, lane); }
            else if (kind == PK_MIX) {
                if constexpr (PH_ON(5)) {
                    if (bx < 32) gdn0::chain(a, lds, layer, bx >> 2, bx & 3);
                    else if (bx < 64) hg0::chain(a, lds, layer, (bx - 32) >> 2, (bx - 32) & 3);
                    __syncthreads();
                    volatile LAS unsigned* MISC = (volatile LAS unsigned*)(lds + MISC_OFF);
                    const bf16* HB = (const bf16*)(a.ws + WS_HB); bf16* Z = (bf16*)(a.ws + WS_Z); unsigned* qhead = (unsigned*)(a.ws + WS_CTL) + CW_ATTQ + 64 * layer;
                    const int nunits = ATT_UNITS_LAT + (layer == DEPTH - 1 ? 0 : ATT_UNITS_CTX);
                    for (;;) {
                        if (tid == 0) MISC[0] = __hip_atomic_fetch_add(qhead, 1u, __ATOMIC_RELAXED, __HIP_MEMORY_SCOPE_AGENT);
                        __syncthreads();
                        const int u = (int)MISC[0];
                        __syncthreads();
                        if (u >= nunits) break;
                        int b, h, qb;
                        if (u < ATT_UNITS_LAT) { b = u >> 6; h = (u >> 4) & 3; qb = 1 + (u & 15); } else { const int uu = u - ATT_UNITS_LAT; b = uu >> 2; h = uu & 3; qb = 0; }
                        att::attn_unit(b, h, qb, HB, Z, lds);
                    }
                }
            }
            else if (kind == PK_POST1) { if constexpr (PH_ON(7)) post_pass(a, layer, 0, gw, NGW, lane); }
            else { if constexpr (PH_ON(10)) post_pass(a, layer, 1, gw, NGW, lane); }
        }
        if (ph + 1 < ph_hi) xcd_barrier(bar);
    }
}

extern "C" void kernel_launch(void* const* d_in, const int* in_sizes, int n_in, void* d_out, int out_size, void* d_ws, size_t ws_size, hipStream_t stream) {
    static int grid = 0;
    if (grid == 0) {
        if (n_in != 24 || in_sizes[0] != NB * SEQ * DM || out_size != NB * SEQ * DM || ws_size < WS_END) {
            fprintf(stderr, "kernel_launch: unexpected shapes (n_in %d, in0 %d, out %d, ws %zu, need %zu); nothing launched\n", n_in, n_in > 0 ? in_sizes[0] : -1, out_size, ws_size, (size_t)WS_END); grid = -1; return; }
        int dev = 0, cus = 0, per_cu = 0;
        if (hipGetDevice(&dev) != hipSuccess || hipDeviceGetAttribute(&cus, hipDeviceAttributeMultiprocessorCount, dev) != hipSuccess) { fprintf(stderr, "kernel_launch: device query failed\n"); grid = -1; return; }
        if (hipFuncSetAttribute((const void*)fwd_kernel, hipFuncAttributeMaxDynamicSharedMemorySize, LDS_BYTES) != hipSuccess) { fprintf(stderr, "kernel_launch: hipFuncSetAttribute failed\n"); grid = -1; return; }
        if (hipOccupancyMaxActiveBlocksPerMultiprocessor(&per_cu, (const void*)fwd_kernel, NWAVES * 64, LDS_BYTES) != hipSuccess || per_cu < 1)
            fprintf(stderr, "kernel_launch: note: occupancy query reports %d workgroups per CU\n", per_cu);
        (void)hipGetLastError();
        grid = cus;
        if (grid < 192) { fprintf(stderr, "kernel_launch: %d CUs < 192: unsupported\n", grid); grid = -1; return; }
    }
    if (grid < 0) return;
    if (hipMemsetAsync((char*)d_ws + WS_CTL, 0, CTL_ZERO_BYTES, stream) != hipSuccess) { fprintf(stderr, "kernel_launch: memset failed\n"); return; }
    Args a{};
    for (int i = 0; i < 24; ++i) a.in[i] = (const float*)d_in[i];
    a.out = (float*)d_out; a.ws = (unsigned char*)d_ws;
#if MK_ONE_LAUNCH
    a.ph_lo = 0; a.ph_hi = N_PHASES;
    hipLaunchKernelGGL(fwd_kernel, dim3(grid), dim3(NWAVES * 64), LDS_BYTES, stream, a);
#else
    for (int ph = 0; ph < N_PHASES; ++ph) { a.ph_lo = ph; a.ph_hi = ph + 1; hipLaunchKernelGGL(fwd_kernel, dim3(grid), dim3(NWAVES * 64), LDS_BYTES, stream, a); }
#endif
    const hipError_t le = hipPeekAtLastError();
    if (le != hipSuccess) fprintf(stderr, "kernel_launch: launch failed: %s\n", hipGetErrorName(le));
}
```

```cpp
#include <hip/hip_runtime.h>
#include <hip/hip_bf16.h>
#include <cstdio>
#include <cstdint>
#include <cmath>

#ifndef MK_ONE_LAUNCH
#define MK_ONE_LAUNCH 1
#endif

constexpr int NB = 8, SEQ = 4096, CTXL = 256, TPB = SEQ + CTXL  , MT = NB * TPB  ;
constexpr int DM = 1024, DFF = 4096, DEPTH = 2, DIN = 4528, ZLD = 4608;
constexpr float EPS = 1e-6f;
constexpr int ZC_GQ = 0, ZC_GK = 512, ZC_GV = 1024, ZC_GG = 1536, ZC_CQ = 2048, ZC_HG = 2304, ZC_CKV = 2560, ZC_KR = 2688,
              ZC_GB = 2720, ZC_GA = 2728, ZC_HQ = 2752, ZC_HFF = 3264, ZC_HFB = 3776, ZC_HI = 4288, ZC_END = 4544;
__host__ __device__ __forceinline__ int zcol_src(int n) {
    if (n < 2048) return n;
    if (n < 2304) return 2064 + (n - 2048);
    if (n < 2560) return 4272 + (n - 2304);
    if (n < 2688) return 2320 + (n - 2560);
    if (n < 2720) return 2448 + (n - 2688);
    if (n < 2728) return 2048 + (n - 2720);
    if (n < 2736) return 2056 + (n - 2728);
    if (n < 2752) return -1;
    if (n < 3264) return 2480 + (n - 2752);
    if (n < 3776) return 2992 + (n - 3264);
    if (n < 4288) return 3504 + (n - 3776);
    if (n < 4544) return 4016 + (n - 4288);
    return -1;
}
constexpr int HB_Q = 0, HB_K = 384, HB_V = 768;
constexpr float ATT_C2 = 0.10206207261596577f * 1.4426950408889634f;

constexpr size_t MiB = 1u << 20;
constexpr size_t WS_CTL = 0, CTL_ZERO_BYTES = 1 * MiB;
constexpr size_t WS_MODS = 1 * MiB;
constexpr size_t WS_ROPE = WS_MODS + 512 * 1024;
constexpr size_t WS_LB = WS_ROPE + 512 * 1024 + 0;
constexpr size_t WS_W = 3 * MiB;
constexpr size_t W_IN = 0, W_OUT = W_IN + (size_t)ZLD * DM * 2, W_1 = W_OUT + (size_t)DM * DM * 2, W_2 = W_1 + (size_t)DFF * DM * 2,
                 W_UQ = W_2 + (size_t)DM * DFF * 2, W_UKV = W_UQ + 512 * 256 * 2, W_LAYER = W_UKV + 512 * 128 * 2;
constexpr size_t WS_XC = 58 * MiB;
constexpr size_t WS_HB = 66 * MiB;
constexpr size_t WS_OSG = 134 * MiB;
constexpr size_t WS_OSH = 168 * MiB;
constexpr size_t WS_Z = 185 * MiB;
constexpr size_t WS_HALO = 492 * MiB;
constexpr size_t WS_BG = 499 * MiB;
constexpr size_t WS_END = 502 * MiB;
static_assert(WS_LB + 8192 <= WS_W && WS_W + 2 * W_LAYER <= WS_XC && WS_XC + (size_t)NB * CTXL * DM * 4 <= WS_HB && WS_HB + (size_t)MT * DM * 2 <= WS_OSG &&
              WS_OSG + (size_t)MT * 512 * 2 <= WS_OSH && WS_OSH + (size_t)MT * 256 * 2 <= WS_Z && WS_Z + (size_t)MT * ZLD * 2 <= WS_HALO && WS_HALO + (size_t)(MT / 64) * 4 * 1536 * 2 <= WS_BG && WS_BG + (size_t)MT * 16 * 4 <= WS_END && WS_END <= 512 * MiB, "d_ws map");
constexpr int CW_BAR = 4096;
constexpr int CW_ATTQ = 16384;

constexpr int RING_BYTES = 131072, LDSCTL_OFF = 146432, MISC_OFF = LDSCTL_OFF + 320, LDS_BYTES = 147456;
constexpr int NWAVES = 8;

#define GAS __attribute__((address_space(1)))
#define LAS __attribute__((address_space(3)))
typedef unsigned short bf16;
typedef unsigned v4u __attribute__((ext_vector_type(4)));
typedef unsigned v2u __attribute__((ext_vector_type(2)));
typedef float f32x4 __attribute__((ext_vector_type(4)));
typedef float f32x16 __attribute__((ext_vector_type(16)));
typedef short bf16x8 __attribute__((ext_vector_type(8)));
typedef short s16x4 __attribute__((ext_vector_type(4)));
typedef GAS unsigned gu32;
#define RLX_AGENT __ATOMIC_RELAXED, __HIP_MEMORY_SCOPE_AGENT
#define LDS_WAIT() asm volatile("s_waitcnt lgkmcnt(0)" ::: "memory")
#define VM_WAIT() asm volatile("s_waitcnt vmcnt(0)" ::: "memory")
__device__ __forceinline__ unsigned f2bf(float f) { unsigned u = __builtin_bit_cast(unsigned, f); return (u + 0x7fffu + ((u >> 16) & 1u)) >> 16; }
__device__ __forceinline__ unsigned pk2(float lo, float hi) { return f2bf(lo) | (f2bf(hi) << 16); }
__device__ __forceinline__ float bf2f(unsigned b) { return __builtin_bit_cast(float, b << 16); }
__device__ __forceinline__ float bflo(unsigned w) { return __builtin_bit_cast(float, w << 16); }
__device__ __forceinline__ float bfhi(unsigned w) { return __builtin_bit_cast(float, w & 0xffff0000u); }
__device__ __forceinline__ float wave_sum(float v) {
#pragma unroll
    for (int o = 1; o < 64; o <<= 1) v += __shfl_xor(v, o);
    return v;
}
__device__ __forceinline__ float sigmoidf_(float x) { return 1.0f / (1.0f + __expf(-x)); }
__device__ __forceinline__ float siluf_(float x) { return x / (1.0f + __expf(-x)); }

namespace pg8 {
#define PG8_LAS __attribute__((address_space(3)))
typedef unsigned short bf16_t;
typedef short bf16x8 __attribute__((ext_vector_type(8)));
typedef float f32x4 __attribute__((ext_vector_type(4)));
typedef unsigned u32x4 __attribute__((ext_vector_type(4)));
constexpr int BM = 256, BK = 64, HALF = 128, HTB = HALF * BK * 2  , STAGE_BYTES = 8 * HTB, NXCD = 8, WGM = 8;

__host__ __device__ __forceinline__ int lds_byte(int r, int c) { const int st = (r >> 4) * 2 + (c >> 5), rr = r & 15, cc = c & 31, ob = rr * 64 + cc * 2; return st * 1024 + (ob ^ (((ob >> 9) & 1) << 5)); }
__host__ __device__ __forceinline__ void stage_rc(int b, int& R, int& C) { const int st = b / 1024, sb = b % 1024, swz = sb ^ (((sb >> 9) & 1) << 5); R = (st >> 1) * 16 + swz / 64; C = (st & 1) * 32 + (swz % 64) / 2; }
__host__ __device__ __forceinline__ int perm32(int rho) { const int n = rho >> 4, i = rho & 15; return 8 * (i >> 2) + 4 * n + (i & 3); }

struct Unit { int pm, pn; };
struct Gemm { const bf16_t* A; const bf16_t* Bt; int M, N, K, lda; };

struct StaticOrder {
    int nM, nN, nwg, G, c;
    __host__ __device__ void init(int M, int N, int G_, int c_) { nM = M / BM; nN = N / BM; nwg = nM * nN; G = G_; c = c_; }
    __host__ __device__ bool next(int i, Unit& u) const {
        const long L = (long)i * G + c; if (L >= nwg) return false;
        int wgid = (int)L; { const int q = nwg / NXCD, r = nwg % NXCD, xcd = wgid % NXCD, off = wgid / NXCD; wgid = (xcd < r ? xcd * (q + 1) : r * (q + 1) + (xcd - r) * q) + off; }
        const int nig = WGM * nN, gid = wgid / nig, fm = gid * WGM, gsz = (nM - fm) < WGM ? (nM - fm) : WGM;
        u.pm = fm + ((wgid % nig) % gsz); u.pn = (wgid % nig) / gsz; return true;
    }
    __device__ __forceinline__ void a_ready(const Unit&) const {}
    __device__ __forceinline__ void done(const Unit&) const {}
};

__device__ __forceinline__ unsigned cvt_pk_bf16(float lo, float hi) { unsigned r; asm volatile("v_cvt_pk_bf16_f32 %0, %1, %2" : "=v"(r) : "v"(lo), "v"(hi)); return r; }
typedef float f32x2 __attribute__((ext_vector_type(2)));
struct EpiBf16 {
    static constexpr bool PERM = true, AFTER_DRAIN = false;
    bf16_t* O; int ldc; int act;
    __device__ __forceinline__ void operator()(const f32x4 (&acc)[2][2][4][2], const Unit& u, int wr, int wc, int fr, int fq) const {
        const int row0 = u.pm * BM + wr * 64 + fr; const int col0 = u.pn * BM + wc * 32 + 8 * fq;
        const bool sq = act == 2;
#pragma unroll
        for (int ai = 0; ai < 2; ++ai)
#pragma unroll
            for (int m = 0; m < 4; ++m) { bf16_t* rowp = O + (size_t)(row0 + ai * HALF + m * 16) * ldc + col0;
#pragma unroll
                for (int bj = 0; bj < 2; ++bj) { f32x4 v0 = acc[ai][bj][m][0], v1 = acc[ai][bj][m][1];
                    if (sq) {
#pragma unroll
                        for (int q = 0; q < 4; ++q) { const float a = v0[q] > 0.f ? v0[q] : 0.f, b = v1[q] > 0.f ? v1[q] : 0.f; v0[q] = a * a; v1[q] = b * b; } }
                    u32x4 w; w.x = cvt_pk_bf16(v0[0], v0[1]); w.y = cvt_pk_bf16(v0[2], v0[3]); w.z = cvt_pk_bf16(v1[0], v1[1]); w.w = cvt_pk_bf16(v1[2], v1[3]);
                    *(u32x4*)(rowp + bj * HALF) = w; } }
    }
};

template <class Epi, class Sched, bool ALIGN_EPI = false, bool SP2 = false>
__device__ __forceinline__ void gemm_phase(PG8_LAS unsigned char* lds, const Gemm g, const Sched& S, const Epi& E) {
    int tid_ = threadIdx.x; asm volatile("" : "+v"(tid_));
    const int tid = tid_, wid = __builtin_amdgcn_readfirstlane(tid >> 6), lane = tid & 63, wr = wid >> 2, wc = wid & 3, fr = lane & 15, fq = lane >> 4;
    const int K = g.K, nt = K / BK;
    unsigned voffA[2], voffB[2];
#pragma unroll
    for (int i = 0; i < 2; ++i) { int R, C; stage_rc(tid * 16 + i * 8192, R, C); const int Rb = Epi::PERM ? ((R & ~31) + perm32(R & 31)) : R;
        voffA[i] = (unsigned)(R * g.lda + C) * 2u; voffB[i] = (unsigned)(Rb * K + C) * 2u; }
    const size_t kstep = (size_t)(BK * 2);
    const size_t hstepA = (size_t)HALF * g.lda * 2, hstepB = (size_t)HALF * K * 2;
    const size_t tstepA = 2 * hstepA, tstepB = 2 * hstepB;
    const unsigned ldsw = (unsigned)wid * 1024u;
    const int aoff = lds_byte(wr * 64 + fr, fq * 8), boff = lds_byte(wc * 32 + fr, fq * 8);
#define PG8_SA(b, h) (((b) * 2 + (h)) * HTB)
#define PG8_SB(b, h) ((4 + (b) * 2 + (h)) * HTB)
#define PG8_STAGE(bufoff, gbase, voff) do { _Pragma("unroll") for (int _i = 0; _i < 2; ++_i) \
        __builtin_amdgcn_global_load_lds((const unsigned*)((const char*)(gbase) + (voff)[_i]), (PG8_LAS unsigned*)(lds + (bufoff) + ldsw + _i * 8192), 16, 0, 0); } while (0)
#define PG8_LDA(dst, b, h) do { _Pragma("unroll") for (int m = 0; m < 4; ++m) _Pragma("unroll") for (int k = 0; k < 2; ++k) dst[m][k] = *(const PG8_LAS bf16x8*)(lds + PG8_SA(b, h) + aoff + m * 2048 + k * 1024); } while (0)
#define PG8_LDB(dst, b, h) do { _Pragma("unroll") for (int n = 0; n < 2; ++n) _Pragma("unroll") for (int k = 0; k < 2; ++k) dst[n][k] = *(const PG8_LAS bf16x8*)(lds + PG8_SB(b, h) + boff + n * 2048 + k * 1024); } while (0)
#define PG8_MMA(ai, bj, At, Bt) do { __builtin_amdgcn_s_setprio(1); _Pragma("unroll") for (int m = 0; m < 4; ++m) _Pragma("unroll") for (int n = 0; n < 2; ++n) _Pragma("unroll") for (int k = 0; k < 2; ++k) \
        acc[ai][bj][m][n] = __builtin_amdgcn_mfma_f32_16x16x32_bf16(Bt[n][k], At[m][k], acc[ai][bj][m][n], 0, 0, 0); __builtin_amdgcn_s_setprio(0); } while (0)
#define PG8_WAIT_V(n) asm volatile("s_waitcnt vmcnt(" #n ")" ::: "memory")
#define PG8_WAIT_L(n) asm volatile("s_waitcnt lgkmcnt(" #n ")" ::: "memory")
#define PG8_BAR __builtin_amdgcn_s_barrier()
#define PG8_SCHED __builtin_amdgcn_sched_barrier(0)
    Unit cur, nxt; int ui = 0;
    if (!S.next(0, cur)) return;
    f32x4 acc[2][2][4][2];
#pragma unroll
    for (int a = 0; a < 2; ++a)
#pragma unroll
        for (int b = 0; b < 2; ++b)
#pragma unroll
            for (int m = 0; m < 4; ++m)
#pragma unroll
                for (int n = 0; n < 2; ++n) acc[a][b][m][n] = (f32x4){0.f, 0.f, 0.f, 0.f};
    bf16x8 At[4][2], B0[2][2], B1[2][2];
    const char* cA = (const char*)g.A + (size_t)cur.pm * tstepA; const char* cB = (const char*)g.Bt + (size_t)cur.pn * tstepB;
    S.a_ready(cur);
    if constexpr (SP2) {
        PG8_STAGE(PG8_SB(0, 0), cB, voffB); PG8_STAGE(PG8_SB(0, 1), cB + hstepB, voffB); PG8_STAGE(PG8_SA(0, 0), cA, voffA); PG8_STAGE(PG8_SA(0, 1), cA + hstepA, voffA);
        if (wr == 1) PG8_BAR;
        PG8_WAIT_V(2); PG8_BAR;
        PG8_STAGE(PG8_SB(1, 0), cB + kstep, voffB); PG8_STAGE(PG8_SA(1, 0), cA + kstep, voffA); PG8_STAGE(PG8_SB(1, 1), cB + hstepB + kstep, voffB);
        PG8_WAIT_V(6); PG8_BAR;
    } else {
        PG8_STAGE(PG8_SB(0, 0), cB, voffB); PG8_STAGE(PG8_SA(0, 0), cA, voffA); PG8_STAGE(PG8_SB(0, 1), cB + hstepB, voffB); PG8_STAGE(PG8_SA(0, 1), cA + hstepA, voffA);
        if (wr == 1) PG8_BAR;
        PG8_WAIT_V(4); PG8_BAR;
        PG8_STAGE(PG8_SB(1, 0), cB + kstep, voffB); PG8_STAGE(PG8_SA(1, 0), cA + kstep, voffA); PG8_STAGE(PG8_SB(1, 1), cB + hstepB + kstep, voffB);
        PG8_WAIT_V(6); PG8_BAR;
    }
    for (;;) {
        const bool has_next = S.next(ui + 1, nxt);
        const char* nA = has_next ? (const char*)g.A + (size_t)nxt.pm * tstepA : cA; const char* nB = has_next ? (const char*)g.Bt + (size_t)nxt.pn * tstepB : cB;

#pragma nounroll
        for (int t = 0; t < nt; t += 2) {
            const bool last = (t == nt - 2);
            const char* a1 = cA + (size_t)(t + 1) * kstep;
            const char* a2 = last ? nA : cA + (size_t)(t + 2) * kstep; const char* b2 = last ? nB : cB + (size_t)(t + 2) * kstep;
            const char* a3 = a2 + kstep; const char* b3 = b2 + kstep;
            if (last && has_next) S.a_ready(nxt);
            if constexpr (SP2) {
            PG8_LDB(B0, 0, 0); PG8_LDB(B1, 0, 1); PG8_SCHED; PG8_LDA(At, 0, 0); PG8_STAGE(PG8_SA(1, 1), a1 + hstepA, voffA);
            PG8_WAIT_V(8); PG8_WAIT_L(0); PG8_BAR; PG8_MMA(0, 0, At, B0); PG8_MMA(0, 1, At, B1); PG8_BAR; PG8_SCHED;
            PG8_LDA(At, 0, 1); PG8_STAGE(PG8_SB(0, 0), b2, voffB); PG8_STAGE(PG8_SB(0, 1), b2 + hstepB, voffB); PG8_STAGE(PG8_SA(0, 0), a2, voffA);
            PG8_WAIT_V(8); PG8_WAIT_L(0); PG8_BAR; PG8_MMA(1, 0, At, B0); PG8_MMA(1, 1, At, B1); PG8_BAR; PG8_SCHED;
            PG8_LDB(B0, 1, 0); PG8_LDB(B1, 1, 1); PG8_SCHED; PG8_LDA(At, 1, 0); PG8_STAGE(PG8_SA(0, 1), a2 + hstepA, voffA);
            PG8_WAIT_V(8); PG8_WAIT_L(0); PG8_BAR; PG8_MMA(0, 0, At, B0); PG8_MMA(0, 1, At, B1); PG8_BAR; PG8_SCHED;
            PG8_LDA(At, 1, 1); PG8_STAGE(PG8_SB(1, 0), b3, voffB); PG8_STAGE(PG8_SB(1, 1), b3 + hstepB, voffB); PG8_STAGE(PG8_SA(1, 0), a3, voffA);
            PG8_WAIT_V(8); PG8_WAIT_L(0); PG8_BAR; PG8_MMA(1, 0, At, B0); PG8_MMA(1, 1, At, B1); PG8_BAR; PG8_SCHED;
            } else {
            PG8_LDB(B0, 0, 0); PG8_SCHED; PG8_LDA(At, 0, 0); PG8_STAGE(PG8_SA(1, 1), a1 + hstepA, voffA);
            PG8_WAIT_L(8); PG8_BAR; PG8_WAIT_L(0); PG8_MMA(0, 0, At, B0); PG8_BAR; PG8_SCHED;
            PG8_LDB(B1, 0, 1); PG8_STAGE(PG8_SB(0, 0), b2, voffB);
            PG8_BAR; PG8_WAIT_L(0); PG8_MMA(0, 1, At, B1); PG8_BAR;
            PG8_LDA(At, 0, 1); PG8_STAGE(PG8_SA(0, 0), a2, voffA);
            PG8_BAR; PG8_WAIT_L(0); PG8_MMA(1, 0, At, B0); PG8_BAR; PG8_SCHED;
            PG8_STAGE(PG8_SB(0, 1), b2 + hstepB, voffB);
            PG8_WAIT_V(6); PG8_BAR; PG8_MMA(1, 1, At, B1); PG8_BAR;
            PG8_LDB(B0, 1, 0); PG8_SCHED; PG8_LDA(At, 1, 0); PG8_STAGE(PG8_SA(0, 1), a2 + hstepA, voffA);
            PG8_WAIT_L(8); PG8_BAR; PG8_WAIT_L(0); PG8_MMA(0, 0, At, B0); PG8_BAR; PG8_SCHED;
            PG8_LDB(B1, 1, 1); PG8_STAGE(PG8_SB(1, 0), b3, voffB);
            PG8_BAR; PG8_WAIT_L(0); PG8_MMA(0, 1, At, B1); PG8_BAR;
            PG8_LDA(At, 1, 1); PG8_STAGE(PG8_SA(1, 0), a3, voffA);
            PG8_BAR; PG8_WAIT_L(0); PG8_MMA(1, 0, At, B0); PG8_BAR; PG8_SCHED;
            PG8_STAGE(PG8_SB(1, 1), b3 + hstepB, voffB);
            PG8_WAIT_V(6); PG8_BAR; PG8_MMA(1, 1, At, B1); PG8_BAR;
            }
        }
        if constexpr (ALIGN_EPI) { if (wr == 0) PG8_BAR; }
        if constexpr (!Epi::AFTER_DRAIN) { E(acc, cur, wr, wc, fr, fq); S.done(cur); }
        if (!has_next) break;
#pragma unroll
        for (int a = 0; a < 2; ++a)
#pragma unroll
            for (int b = 0; b < 2; ++b)
#pragma unroll
                for (int m = 0; m < 4; ++m)
#pragma unroll
                    for (int n = 0; n < 2; ++n) acc[a][b][m][n] = (f32x4){0.f, 0.f, 0.f, 0.f};
        cur = nxt; cA = nA; cB = nB; ++ui;
        if constexpr (ALIGN_EPI) { if (wr == 1) PG8_BAR; }
    }
    PG8_WAIT_V(0);
    if constexpr (!ALIGN_EPI) { if (wr == 0) PG8_BAR; }
    PG8_BAR;
    if constexpr (Epi::AFTER_DRAIN) { E.fused(acc, cur, wr, wc, fr, fq, lds, wid, lane); S.done(cur); }
#undef PG8_SA
#undef PG8_SB
#undef PG8_STAGE
#undef PG8_LDA
#undef PG8_LDB
#undef PG8_MMA
#undef PG8_WAIT_V
#undef PG8_WAIT_L
#undef PG8_BAR
#undef PG8_SCHED
}
}
__device__ __forceinline__ unsigned long long rt() { return __builtin_amdgcn_s_memrealtime(); }
#define XB_TMO      128
#define XB_XCNT(j)  (256  + 64 * (j))
#define XB_XSUB(j)  (1280 + 64 * (j))
#define XB_XGEN(j)  (2304 + 64 * (j))
#define XB_TOP      3328
#define XB_TOPGEN   3392
#define XCD_BAR_WORDS 3456
#define XB_SPIN_CAP (1u << 22)

__device__ __forceinline__ unsigned xb_ld(unsigned* p)              { return __hip_atomic_load(p, __ATOMIC_RELAXED, __HIP_MEMORY_SCOPE_AGENT); }
__device__ __forceinline__ unsigned xb_add(unsigned* p, unsigned v) { return __hip_atomic_fetch_add(p, v, __ATOMIC_RELAXED, __HIP_MEMORY_SCOPE_AGENT); }
__device__ __forceinline__ unsigned xb_xcc_id() { return (unsigned)__builtin_amdgcn_s_getreg((3 << 11) | 20) & 0xFu; }
#define XB_SPIN(cond, bar) do { unsigned _sp = 0; while (cond) { __builtin_amdgcn_s_sleep(1); \
    if ((++_sp & 255u) == 0u) { if (xb_ld(&(bar)[XB_TMO])) break; if (_sp > XB_SPIN_CAP) { atomicAdd(&(bar)[XB_TMO], 1u); break; } } } } while (0)

struct XcdBarrier {
    unsigned* bar; unsigned x;
    volatile LAS unsigned* st;
};

__device__ __forceinline__ XcdBarrier xcd_barrier_post(unsigned* bar, volatile LAS unsigned* st) {
    XcdBarrier b; b.bar = bar; b.x = xb_xcc_id(); b.st = st;
    if (threadIdx.x == 0) (void)xb_add(&bar[XB_XCNT(b.x)], 1u);
    return b;
}
__device__ __forceinline__ void xcd_barrier_complete(unsigned* bar, unsigned x, unsigned& nloc, unsigned& nx) {
    const unsigned G = gridDim.x * gridDim.y * gridDim.z;
    unsigned sum, cnt, mine, sp = 0u;
    for (;;) {
        sum = 0u; cnt = 0u; mine = 0u;
#pragma unroll
        for (unsigned j = 0; j < 16; ++j) { const unsigned c = xb_ld(&bar[XB_XCNT(j)]); sum += c; cnt += (c > 0u) ? 1u : 0u; mine = (j == x) ? c : mine; }
        if (sum == G) break;
        __builtin_amdgcn_s_sleep(1);
        if ((++sp & 255u) == 0u) { if (xb_ld(&bar[XB_TMO])) break; if (sp > XB_SPIN_CAP) { atomicAdd(&bar[XB_TMO], 1u); break; } }
    }
    nloc = mine > 0u ? mine : 1u; nx = cnt > 0u ? cnt : 1u;
}

__device__ __forceinline__ void xcd_barrier(const XcdBarrier& b) {
    asm volatile("s_waitcnt vmcnt(0)" ::: "memory");
    __syncthreads();
    if (threadIdx.x == 0) {
        unsigned* bar = b.bar;
        __builtin_amdgcn_s_waitcnt(0);
        unsigned nloc = b.st[0], nx = b.st[1];
        if (nloc == 0u) { xcd_barrier_complete(bar, b.x, nloc, nx); b.st[0] = nloc; b.st[1] = nx; }
        const unsigned old = xb_add(&bar[XB_XSUB(b.x)], 1u);
        const unsigned gen = old / nloc;
        if (old + 1u == (gen + 1u) * nloc) {
            __builtin_amdgcn_fence(__ATOMIC_RELEASE, "agent");
            asm volatile("s_waitcnt vmcnt(0)" ::: "memory");
            const unsigned og = xb_add(&bar[XB_TOP], 1u);
            const unsigned tg = og / nx;
            if (og + 1u == (tg + 1u) * nx) xb_add(&bar[XB_TOPGEN], 1u);
            else XB_SPIN(xb_ld(&bar[XB_TOPGEN]) == tg, bar);
            __builtin_amdgcn_fence(__ATOMIC_ACQUIRE, "agent");
            xb_add(&bar[XB_XGEN(b.x)], 1u);
            asm volatile("s_waitcnt vmcnt(0)" ::: "memory");
        } else {
            XB_SPIN(xb_ld(&bar[XB_XGEN(b.x)]) == gen, bar);
            __builtin_amdgcn_fence(__ATOMIC_ACQUIRE, "agent");
            asm volatile("s_waitcnt vmcnt(0)" ::: "memory");
        }
    }
    __syncthreads();
}

struct Args {
    const float* in[24];
    float* out; unsigned char* ws;
    int ph_lo, ph_hi;
};
typedef const __attribute__((address_space(4))) Args CArgs;
enum InIdx { I_X = 0, I_C, I_CTX, I_CCTX, I_WADA, I_BADA, I_NMIXPRE, I_NMIXPOST, I_NMLPPRE, I_NMLPPOST, I_WIN, I_WOUT, I_GCONV, I_GALOG, I_GDT, I_GNORM,
             I_QNORM, I_KVNORM, I_WUQ, I_WUKV, I_LBLOG, I_HNORM, I_W1, I_W2 };

__device__ __forceinline__ const float* resid_in0(const float* x, const float* ctx, int row) {
    const int b = row / TPB, t = row - b * TPB;
    return t < CTXL ? ctx + ((size_t)b * CTXL + t) * DM : x + ((size_t)b * SEQ + (t - CTXL)) * DM;
}
__device__ __forceinline__ float* resid_ptr(float* out, float* xc, int row) {
    const int b = row / TPB, t = row - b * TPB;
    return t < CTXL ? xc + ((size_t)b * CTXL + t) * DM : out + ((size_t)b * SEQ + (t - CTXL)) * DM;
}
__device__ __forceinline__ int mod_row(int row) { const int b = row / TPB, t = row - b * TPB; return t < CTXL ? 8 : b; }

__device__ __forceinline__ void transpose_item(const float* W, int K, int ldsrc, int nsrc, bool zmap, const float* gain, bf16* WT, LAS float* scr, int item, int nblk, int lane) {
    const int kb = item / nblk, nb = item % nblk, k0 = 32 * kb, n0 = 64 * nb;
    const int np = n0 + lane; int src = zmap ? zcol_src(np) : np; if (src >= nsrc) src = -1;
#pragma unroll 8
    for (int kk = 0; kk < 32; ++kk) { float v = 0.f; if (src >= 0) { v = W[(size_t)(k0 + kk) * ldsrc + src]; if (gain) v *= gain[k0 + kk]; } scr[kk * 65 + lane] = v; }
    LDS_WAIT(); asm volatile("" ::: "memory");
    const int c = lane & 3;
#pragma unroll
    for (int j = 0; j < 4; ++j) { const int n = (lane >> 2) + 16 * j; const LAS float* s = scr + (8 * c) * 65 + n;
        v4u o; o.x = pk2(s[0 * 65], s[1 * 65]); o.y = pk2(s[2 * 65], s[3 * 65]); o.z = pk2(s[4 * 65], s[5 * 65]); o.w = pk2(s[6 * 65], s[7 * 65]);
        *(GAS v4u*)(WT + (size_t)(n0 + n) * K + k0 + 8 * c) = o; }
    LDS_WAIT(); asm volatile("" ::: "memory");
}
__device__ __forceinline__ void p0a_prologue(CArgs& a, LAS unsigned char* lds, int vcu, int G, int wave, int lane, int tid) {
    LAS float* scr = (LAS float*)(lds + wave * 8320);
    const int gw = vcu * NWAVES + wave, NGW = G * NWAVES;
    constexpr int I_IN = (DM / 32) * (ZLD / 64), I_OUT = (DM / 32) * (DM / 64), I_1 = (DM / 32) * (DFF / 64), I_2 = (DFF / 32) * (DM / 64), I_UQ = (256 / 32) * (512 / 64), I_UKV = (128 / 32) * (512 / 64);
    constexpr int PER_LAYER = I_IN + I_OUT + I_1 + I_2 + I_UQ + I_UKV;
    for (int it = gw; it < DEPTH * PER_LAYER; it += NGW) {
        const int l = it / PER_LAYER; int r = it - l * PER_LAYER;
        unsigned char* wb = a.ws + WS_W + (size_t)l * W_LAYER;
        if (r < I_IN) { transpose_item(a.in[I_WIN] + (size_t)l * DM * DIN, DM, DIN, DIN, true, nullptr, (bf16*)(wb + W_IN), scr, r, ZLD / 64, lane); continue; } r -= I_IN;
        if (r < I_OUT) { transpose_item(a.in[I_WOUT] + (size_t)l * DM * DM, DM, DM, DM, false, nullptr, (bf16*)(wb + W_OUT), scr, r, DM / 64, lane); continue; } r -= I_OUT;
        if (r < I_1) { transpose_item(a.in[I_W1] + (size_t)l * DM * DFF, DM, DFF, DFF, false, nullptr, (bf16*)(wb + W_1), scr, r, DFF / 64, lane); continue; } r -= I_1;
        if (r < I_2) { transpose_item(a.in[I_W2] + (size_t)l * DFF * DM, DFF, DM, DM, false, nullptr, (bf16*)(wb + W_2), scr, r, DM / 64, lane); continue; } r -= I_2;
        if (r < I_UQ) { transpose_item(a.in[I_WUQ] + (size_t)l * 256 * 384, 256, 384, 384, false, a.in[I_QNORM] + l * 256, (bf16*)(wb + W_UQ), scr, r, 512 / 64, lane); continue; } r -= I_UQ;
        transpose_item(a.in[I_WUKV] + (size_t)l * 128 * 512, 128, 512, 512, false, a.in[I_KVNORM] + l * 128, (bf16*)(wb + W_UKV), scr, r, 512 / 64, lane);
    }
    {
        const int gt = vcu * (NWAVES * 64) + tid, NGT = G * NWAVES * 64;
        float* rc = (float*)(a.ws + WS_ROPE); float* rs = rc + SEQ * 16;
        for (int i = gt; i < SEQ * 16; i += NGT) { const int t = i >> 4, j = i & 15, f = j & 7;
            const float inv = exp2f(-(float)f * 0.125f * 13.287712379549449f);
            const float pos = (float)(j < 8 ? (t >> 6) : (t & 63)); const float ang = pos * inv;
            rc[i] = cosf(ang); rs[i] = sinf(ang); }
        float* lb = (float*)(a.ws + WS_LB);
        for (int i = gt; i < 2 * 1024; i += NGT) { const int l = i >> 10, j = i & 1023;
            const float l0 = a.in[I_LBLOG][j], l1 = a.in[I_LBLOG][1024 + j];
            lb[i] = l == 0 ? 0.f : 1.0f / (1.0f + expf(l0 - l1)); }
    }
    if (wave == 0 && vcu < 192) {
        LAS float* sc = (LAS float*)(lds + 69632);
        for (int i = lane; i < 9 * 1024; i += 64) { const int r = i >> 10, k = i & 1023; const float v = r < 8 ? a.in[I_C][r * 1024 + k] : a.in[I_CCTX][k]; sc[i] = siluf_(v); }
        LDS_WAIT(); asm volatile("" ::: "memory");
        const int l = vcu / 96, n = (vcu % 96) * 64 + lane;
        const float* w = a.in[I_WADA] + (size_t)l * DM * 6 * DM + n;
        float acc[9];
#pragma unroll
        for (int r = 0; r < 9; ++r) acc[r] = 0.f;
#pragma unroll 8
        for (int k = 0; k < DM; ++k) { const float wv = w[(size_t)k * 6 * DM];
#pragma unroll
            for (int r = 0; r < 9; ++r) acc[r] += sc[r * 1024 + k] * wv; }
        const float bv = a.in[I_BADA][l * 6 * DM + n];
        float* mods = (float*)(a.ws + WS_MODS) + (size_t)l * 9 * 6 * DM;
#pragma unroll
        for (int r = 0; r < 9; ++r) mods[(size_t)r * 6 * DM + n] = acc[r] + bv;
    }
}

__device__ __forceinline__ void norm_mod_store(const f32x4 (&v)[4], const float* gain, const float* sh, const float* sc, bf16* orow, int lane) {
    float ss = 0.f;
#pragma unroll
    for (int j = 0; j < 4; ++j) ss += (v[j].x * v[j].x + v[j].y * v[j].y) + (v[j].z * v[j].z + v[j].w * v[j].w);
    const float rstd = rsqrtf(wave_sum(ss) * (1.f / DM) + EPS);
    GAS v2u* o8 = (GAS v2u*)orow + lane;
#pragma unroll
    for (int j = 0; j < 4; ++j) { const int c = 4 * lane + 256 * j;
        const f32x4 g = *(const f32x4*)(gain + c), s1 = *(const f32x4*)(sh + c), s2 = *(const f32x4*)(sc + c);
        f32x4 h; h.x = v[j].x * rstd * g.x * (1.f + s2.x) + s1.x; h.y = v[j].y * rstd * g.y * (1.f + s2.y) + s1.y; h.z = v[j].z * rstd * g.z * (1.f + s2.z) + s1.z; h.w = v[j].w * rstd * g.w * (1.f + s2.w) + s1.w;
        v2u w; w.x = pk2(h.x, h.y); w.y = pk2(h.z, h.w); o8[64 * j] = w; }
}
__device__ __forceinline__ void p0b_prenorm(CArgs& a, int gw, int NGW, int lane) {
    const float* mods = (const float*)(a.ws + WS_MODS);
    bf16* HB = (bf16*)(a.ws + WS_HB);
    for (int row = gw; row < MT; row += NGW) {
        const GAS f32x4* xr = (const GAS f32x4*)resid_in0(a.in[I_X], a.in[I_CTX], row) + lane;
        f32x4 v[4];
#pragma unroll
        for (int j = 0; j < 4; ++j) v[j] = xr[64 * j];
        const float* m = mods + (size_t)mod_row(row) * 6 * DM;
        norm_mod_store(v, a.in[I_NMIXPRE], m, m + DM, HB + (size_t)row * DM, lane);
    }
}
__device__ __forceinline__ void post_pass(CArgs& a, int layer, int which, int gw, int NGW, int lane) {
    const float* mods = (const float*)(a.ws + WS_MODS) + (size_t)layer * 9 * 6 * DM;
    bf16* HB = (bf16*)(a.ws + WS_HB); float* xc = (float*)(a.ws + WS_XC);
    const float* gpost = (which == 0 ? a.in[I_NMIXPOST] : a.in[I_NMLPPOST]) + layer * DM;
    const bool has_next = (which == 0) || (layer + 1 < DEPTH);
    const float* gnext = which == 0 ? a.in[I_NMLPPRE] + layer * DM : a.in[I_NMIXPRE] + (layer + 1) * DM;
    for (int row = gw; row < MT; row += NGW) {
        const int mr = mod_row(row);
        if (layer == DEPTH - 1 && mr == 8) continue;
        const float* m = mods + (size_t)mr * 6 * DM;
        const float* gate = m + (which == 0 ? 2 : 5) * DM;
        const GAS v2u* yr = (const GAS v2u*)(HB + (size_t)row * DM) + lane;
        const float* xin = (layer == 0 && which == 0) ? resid_in0(a.in[I_X], a.in[I_CTX], row) : resid_ptr(a.out, xc, row);
        float* xout = resid_ptr(a.out, xc, row);
        f32x4 y[4], x[4]; float ss = 0.f;
#pragma unroll
        for (int j = 0; j < 4; ++j) { const v2u w = yr[64 * j]; y[j] = (f32x4){bflo(w.x), bfhi(w.x), bflo(w.y), bfhi(w.y)}; x[j] = *((const GAS f32x4*)xin + lane + 64 * j);
            ss += (y[j].x * y[j].x + y[j].y * y[j].y) + (y[j].z * y[j].z + y[j].w * y[j].w); }
        const float rstd = rsqrtf(wave_sum(ss) * (1.f / DM) + EPS);
#pragma unroll
        for (int j = 0; j < 4; ++j) { const int c = 4 * lane + 256 * j; const f32x4 gp = *(const f32x4*)(gpost + c), gt = *(const f32x4*)(gate + c);
            x[j].x += gt.x * (y[j].x * rstd * gp.x); x[j].y += gt.y * (y[j].y * rstd * gp.y); x[j].z += gt.z * (y[j].z * rstd * gp.z); x[j].w += gt.w * (y[j].w * rstd * gp.w);
            *((GAS f32x4*)xout + lane + 64 * j) = x[j]; }
        if (has_next) {
            const float* mn = which == 0 ? m : (const float*)(a.ws + WS_MODS) + ((size_t)(layer + 1) * 9 + mr) * 6 * DM;
            const float* sh = mn + (which == 0 ? 3 : 0) * DM; const float* sc = mn + (which == 0 ? 4 : 1) * DM;
            norm_mod_store(x, gnext, sh, sc, HB + (size_t)row * DM, lane);
        }
    }
}
__device__ __forceinline__ void mla_rope_pass(CArgs& a, LAS unsigned char* lds, int wave, int gw, int NGW, int lane) {
    bf16* HB = (bf16*)(a.ws + WS_HB); const bf16* Z = (const bf16*)(a.ws + WS_Z);
    const float* rc = (const float*)(a.ws + WS_ROPE); const float* rs = rc + SEQ * 16;
    LAS bf16* raw = (LAS bf16*)(lds + wave * 2304);
    for (int row = gw; row < MT; row += NGW) {
        const int b = row / TPB, t = row - b * TPB; const bool lat = t >= CTXL; const int tp = t - CTXL;
        const GAS v4u* hr = (const GAS v4u*)(HB + (size_t)row * DM);
        const v4u r0 = hr[lane], r1 = hr[64 + lane];
        const bf16* zr = Z + (size_t)row * ZLD;
        const v2u cq = *((const GAS v2u*)(zr + ZC_CQ) + lane); const unsigned ckv = *((const GAS unsigned*)(zr + ZC_CKV) + lane);
        float s1 = bflo(cq.x) * bflo(cq.x) + bfhi(cq.x) * bfhi(cq.x) + bflo(cq.y) * bflo(cq.y) + bfhi(cq.y) * bfhi(cq.y);
        float s2 = bflo(ckv) * bflo(ckv) + bfhi(ckv) * bfhi(ckv);
        const float sq = rsqrtf(wave_sum(s1) * (1.f / 256.f) + EPS) * ATT_C2, skv = rsqrtf(wave_sum(s2) * (1.f / 128.f) + EPS);
        *((LAS v4u*)raw + lane) = r0; *((LAS v4u*)raw + 64 + lane) = r1;
        if (lane < 16) *((LAS unsigned*)(raw + 1024) + lane) = *((const GAS unsigned*)(zr + ZC_KR) + lane);
        VM_WAIT(); LDS_WAIT(); asm volatile("" ::: "memory");
        unsigned ow[8];
#pragma unroll
        for (int e2 = 0; e2 < 8; ++e2) { float o2[2];
#pragma unroll
            for (int q = 0; q < 2; ++q) { const int c = lane * 16 + e2 * 2 + q; float val;
                if (c < 384) { const int h = c / 96, d = c - h * 96;
                    if (d < 64 || !lat) val = bf2f(raw[c]) * sq;
                    else { const int i = (d - 64) & 15, hf = (d - 64) >> 4; const float t1 = bf2f(raw[h * 96 + 64 + i]), t2 = bf2f(raw[h * 96 + 80 + i]), cs = rc[tp * 16 + i], sn = rs[tp * 16 + i];
                           val = (hf == 0 ? t1 * cs - t2 * sn : t1 * sn + t2 * cs) * sq; } }
                else if (c < 768) { const int cc = c - 384, h = cc / 96, d = cc - h * 96;
                    if (d < 64) val = bf2f(raw[512 + h * 128 + d]) * skv;
                    else if (!lat) val = bf2f(raw[1024 + d - 64]);
                    else { const int i = (d - 64) & 15, hf = (d - 64) >> 4; const float t1 = bf2f(raw[1024 + i]), t2 = bf2f(raw[1040 + i]), cs = rc[tp * 16 + i], sn = rs[tp * 16 + i];
                           val = hf == 0 ? t1 * cs - t2 * sn : t1 * sn + t2 * cs; } }
                else { const int cc = c - 768, h = cc >> 6, dv = cc & 63; val = bf2f(raw[512 + h * 128 + 64 + dv]) * skv; }
                o2[q] = val; }
            ow[e2] = pk2(o2[0], o2[1]); }
        GAS v4u* orow = (GAS v4u*)(HB + (size_t)row * DM) + 2 * lane;
        orow[0] = (v4u){ow[0], ow[1], ow[2], ow[3]}; orow[1] = (v4u){ow[4], ow[5], ow[6], ow[7]};
        LDS_WAIT(); asm volatile("" ::: "memory");
    }
}

namespace att {
constexpr int KT_BYTES = 12288, VT_BYTES = 8192, SLOT = KT_BYTES + VT_BYTES, WS_OFF = 2 * SLOT;
__device__ __forceinline__ int crow(int r, int hi) { return (r & 3) + 8 * (r >> 2) + 4 * hi; }
#define ATT_WAIT_BAR() asm volatile("s_waitcnt vmcnt(0) lgkmcnt(0)\n\ts_barrier" ::: "memory")
__device__ __forceinline__ float rowmax32(const f32x16& p0, const f32x16& p1) {
    float m = fmaxf(p0[0], p1[0]);
#pragma unroll
    for (int r = 1; r < 16; ++r) m = fmaxf(m, fmaxf(p0[r], p1[r]));
    return fmaxf(m, __shfl_xor(m, 32));
}
__device__ __forceinline__ unsigned cvtpk(float lo, float hi) { unsigned r; asm volatile("v_cvt_pk_bf16_f32 %0, %1, %2" : "=v"(r) : "v"(lo), "v"(hi)); return r; }
__device__ __forceinline__ void att_dma(const bf16* HB, LAS unsigned char* lds, int rowb, int h, int t, int slot, int wid, int lane) {
    const bf16* kv = HB + (size_t)(rowb + 64 * t) * DM;
#pragma unroll
    for (int i = 0; i < 3; ++i) { const int p = wid + 8 * i;
        if (p < 12) __builtin_amdgcn_global_load_lds((const unsigned*)(kv + (size_t)lane * DM + HB_K + h * 96 + p * 8), (LAS unsigned*)(lds + slot * SLOT + p * 1024), 16, 0, 0);
        else if (p < 20) { const int pv_ = p - 12, dh = pv_ >> 2, rg = pv_ & 3;
            __builtin_amdgcn_global_load_lds((const unsigned*)(kv + (size_t)(16 * rg + (lane >> 2)) * DM + HB_V + h * 64 + dh * 32 + (lane & 3) * 8), (LAS unsigned*)(lds + slot * SLOT + KT_BYTES + pv_ * 1024), 16, 0, 0); } }
}
__device__ __forceinline__ void attn_unit(int b, int h, int qb, const bf16* HB, bf16* Z, LAS unsigned char* lds) {
    int tid_ = threadIdx.x; asm volatile("" : "+v"(tid_)); const int tid = tid_, lane = tid & 63, r32 = lane & 31, hi = lane >> 5; const int wid = __builtin_amdgcn_readfirstlane(tid >> 6);
    const int rowb = b * TPB; const int row0 = rowb + 256 * qb + 32 * wid;
    const int NT = qb == 0 ? CTXL / 64 : TPB / 64;
    LAS float* wsf = (LAS float*)(lds + WS_OFF + wid * 256);
    const unsigned lds0 = (unsigned)(uintptr_t)lds;
    att_dma(HB, lds, rowb, h, 0, 0, wid, lane);
    bf16x8 qr[6];
#pragma unroll
    for (int d0 = 0; d0 < 6; ++d0) qr[d0] = *(const bf16x8*)(HB + (size_t)(row0 + r32) * DM + HB_Q + h * 96 + d0 * 16 + hi * 8);
    float mref = -1e30f, lsum = 0.f; f32x16 o[2]; o[0] = f32x16{}; o[1] = f32x16{};
    ATT_WAIT_BAR();
    for (int t = 0; t < NT; ++t) {
        const int slot = t & 1;
        if (t + 1 < NT) att_dma(HB, lds, rowb, h, t + 1, slot ^ 1, wid, lane);
        f32x16 p0 = f32x16{}, p1 = f32x16{};
        { const LAS unsigned char* kb = lds + slot * SLOT + hi * 1024 + r32 * 16;
#pragma unroll
          for (int d0 = 0; d0 < 6; ++d0) { const bf16x8 k0 = *(const LAS bf16x8*)(kb + d0 * 2048), k1 = *(const LAS bf16x8*)(kb + d0 * 2048 + 512);
              p0 = __builtin_amdgcn_mfma_f32_32x32x16_bf16(k0, qr[d0], p0, 0, 0, 0); p1 = __builtin_amdgcn_mfma_f32_32x32x16_bf16(k1, qr[d0], p1, 0, 0, 0); } }
        const float rm = rowmax32(p0, p1);
        if (__any(rm > mref + 8.0f)) {
            const float mn = fmaxf(mref, rm), al = __builtin_amdgcn_exp2f(mref - mn); mref = mn; lsum *= al;
            if (hi == 0) wsf[r32] = al;
            LDS_WAIT(); asm volatile("" ::: "memory");
#pragma unroll
            for (int r = 0; r < 16; ++r) { const float f = wsf[crow(r, hi)]; o[0][r] *= f; o[1][r] *= f; }
            LDS_WAIT(); asm volatile("" ::: "memory");
        }
        float sacc = 0.f;
#pragma unroll
        for (int r = 0; r < 16; ++r) { p0[r] = __builtin_amdgcn_exp2f(p0[r] - mref); p1[r] = __builtin_amdgcn_exp2f(p1[r] - mref); sacc += p0[r] + p1[r]; }
        lsum += sacc;
        v4u pw[4];
#pragma unroll
        for (int k = 0; k < 2; ++k) { pw[k] = (v4u){cvtpk(p0[8 * k], p0[8 * k + 1]), cvtpk(p0[8 * k + 2], p0[8 * k + 3]), cvtpk(p0[8 * k + 4], p0[8 * k + 5]), cvtpk(p0[8 * k + 6], p0[8 * k + 7])};
            pw[2 + k] = (v4u){cvtpk(p1[8 * k], p1[8 * k + 1]), cvtpk(p1[8 * k + 2], p1[8 * k + 3]), cvtpk(p1[8 * k + 4], p1[8 * k + 5]), cvtpk(p1[8 * k + 6], p1[8 * k + 7])}; }
        { const int vb = (int)(lds0 + slot * SLOT + KT_BYTES) + ((lane >> 4) & 1) * 32 + (lane & 3) * 8 + (4 * hi + ((lane & 15) >> 2)) * 64;
#pragma unroll
          for (int d0 = 0; d0 < 2; ++d0) { s16x4 lo[4], hh[4];
#pragma unroll
              for (int ks = 0; ks < 4; ++ks) {
                  asm volatile("ds_read_b64_tr_b16 %0,%1 offset:%c2" : "=&v"(lo[ks]) : "v"(vb), "i"(d0 * 4096 + ks * 1024) : "memory");
                  asm volatile("ds_read_b64_tr_b16 %0,%1 offset:%c2" : "=&v"(hh[ks]) : "v"(vb), "i"(d0 * 4096 + ks * 1024 + 512) : "memory"); }
              asm volatile("s_waitcnt lgkmcnt(0)" ::: "memory"); __builtin_amdgcn_sched_barrier(0);
#pragma unroll
              for (int ks = 0; ks < 4; ++ks) { const bf16x8 vf = (bf16x8){lo[ks][0], lo[ks][1], lo[ks][2], lo[ks][3], hh[ks][0], hh[ks][1], hh[ks][2], hh[ks][3]};
                  o[d0] = __builtin_amdgcn_mfma_f32_32x32x16_bf16(__builtin_bit_cast(bf16x8, pw[ks]), vf, o[d0], 0, 0, 0); } } }
        ATT_WAIT_BAR();
    }
    lsum += __shfl_xor(lsum, 32);
    if (hi == 0) wsf[32 + r32] = lsum;
    LDS_WAIT(); asm volatile("" ::: "memory");
#pragma unroll
    for (int r = 0; r < 16; ++r) { const int q = crow(r, hi); const float inv = 1.0f / wsf[32 + q];
        bf16* op = Z + (size_t)(row0 + q) * ZLD + ZC_CQ + h * 64 + r32;
        op[0] = (bf16)f2bf(o[0][r] * inv); op[32] = (bf16)f2bf(o[1][r] * inv); }
    ATT_WAIT_BAR();
}
}

__device__ __forceinline__ float softplusf_(float x) { return x > 20.f ? x : log1pf(__expf(x)); }
__device__ __forceinline__ int chunk32_t0(int step, int dir, int& lo, int& hi) {
    if (step < 8) { lo = 0; hi = CTXL; return 32 * (dir ? 7 - step : step); }
    lo = CTXL; hi = TPB; return CTXL + 32 * (dir ? 127 - (step - 8) : step - 8);
}
namespace gdn0 {
constexpr int RAW_OFF = 0, QF_OFF = 28672, KF_OFF = QF_OFF + 16384, VF_OFF = KF_OFF + 16384, CW_OFF = 77824, RED_OFF = 86016, RED2_OFF = 90112, OSUM_OFF = 94208, SCA_OFF = 110592;
__device__ __forceinline__ void chain(CArgs& a, LAS unsigned char* lds, int layer, int b, int h) {
    int tid_ = threadIdx.x; asm volatile("" : "+v"(tid_)); const int tid = tid_, lane = tid & 63, wave = tid >> 6;
    bf16* Z = (bf16*)(a.ws + WS_Z); bf16* OS = (bf16*)(a.ws + WS_OSG);
    LAS bf16* RAW = (LAS bf16*)(lds + RAW_OFF); LAS float* QF = (LAS float*)(lds + QF_OFF); LAS float* KF = (LAS float*)(lds + KF_OFF); LAS float* VF = (LAS float*)(lds + VF_OFF);
    LAS float* CW = (LAS float*)(lds + CW_OFF); LAS float* RED = (LAS float*)(lds + RED_OFF); LAS float* RED2 = (LAS float*)(lds + RED2_OFF); LAS float* OSUM = (LAS float*)(lds + OSUM_OFF);
    LAS float* BETA = (LAS float*)(lds + SCA_OFF); LAS float* AV = BETA + 32;
    __syncthreads();
    for (int i = tid; i < 5 * 384; i += 512) { const int j = i / 384, c = i - j * 384; CW[i] = a.in[I_GCONV][(size_t)layer * 5 * 1536 + j * 1536 + (c >> 7) * 512 + h * 128 + (c & 127)]; }
    const float* gn = a.in[I_GNORM] + layer * 128;
    const int e = tid & 127, dg = tid >> 7; const size_t rowb = (size_t)b * TPB;
    for (int dir = 0; dir < 2; ++dir) {
        float S[32];
#pragma unroll
        for (int j = 0; j < 32; ++j) S[j] = 0.f;
        const float A_ = expf(a.in[I_GALOG][layer * 8 + dir * 4 + h]), dtb = a.in[I_GDT][layer * 8 + dir * 4 + h];
        for (int step = 0; step < 136; ++step) {
            int lo, hi; const int t0 = chunk32_t0(step, dir, lo, hi);
            __syncthreads();
            for (int idx = tid; idx < 36 * 48; idx += 512) { const int rr = idx / 48, ch = idx - rr * 48, t = t0 - 2 + rr; v4u v = (v4u){0u, 0u, 0u, 0u};
                if (t >= lo && t < hi) v = *(const GAS v4u*)(Z + (rowb + t) * ZLD + (ch >> 4) * 512 + h * 128 + (ch & 15) * 8);
                *(LAS v4u*)(RAW + rr * 384 + ch * 8) = v; }
            if (tid < 32) { const bf16* zr = Z + (rowb + t0 + tid) * ZLD; const float zb = bf2f(zr[ZC_GB + dir * 4 + h]), za = bf2f(zr[ZC_GA + dir * 4 + h]);
                BETA[tid] = sigmoidf_(zb); AV[tid] = __expf(-A_ * softplusf_(za + dtb)); }
            __syncthreads();
            for (int idx = tid; idx < 32 * 384; idx += 512) { const int i = idx / 384, c = idx - i * 384; float acc = 0.f;
#pragma unroll
                for (int j = 0; j < 5; ++j) acc += CW[j * 384 + c] * bf2f(RAW[(i + j) * 384 + c]);
                const float y = siluf_(acc); LAS float* dst = c < 128 ? QF : (c < 256 ? KF : VF); dst[i * 128 + (c & 127)] = y; }
            __syncthreads();
            for (int pp = 0; pp < 8; ++pp) { const int p = wave * 8 + pp, tok = p >> 1, which = p & 1; LAS float* ptr = (which ? KF : QF) + tok * 128;
                const float x0 = ptr[lane], x1 = ptr[lane + 64]; const float sc = rsqrtf(wave_sum(x0 * x0 + x1 * x1) + 1e-6f) * (which ? 1.0f : 0.08838834764831845f);
                ptr[lane] = x0 * sc; ptr[lane + 64] = x1 * sc; }
            __syncthreads();
            for (int ii = 0; ii < 32; ++ii) {
                const int i = dir ? 31 - ii : ii, p = ii & 1;
                const LAS f32x4* kr = (const LAS f32x4*)(KF + i * 128 + dg * 32); const LAS f32x4* qr = (const LAS f32x4*)(QF + i * 128 + dg * 32);
                float kk[32]; float part = 0.f;
#pragma unroll
                for (int j = 0; j < 8; ++j) { const f32x4 v = kr[j]; kk[4 * j] = v.x; kk[4 * j + 1] = v.y; kk[4 * j + 2] = v.z; kk[4 * j + 3] = v.w; }
#pragma unroll
                for (int j = 0; j < 32; ++j) part += kk[j] * S[j];
                RED[p * 512 + dg * 128 + e] = part;
                __syncthreads();
                if (ii > 0 && dg == 0) { const int ip = dir ? 32 - ii : ii - 1; const LAS float* r2 = RED2 + (p ^ 1) * 512 + e; const float o = (r2[0] + r2[128]) + (r2[256] + r2[384]);
                    const size_t oi = (rowb + t0 + ip) * 512 + h * 128 + e;
                    if (dir == 0) OS[oi] = (bf16)f2bf(o); else OSUM[ip * 128 + e] = o + bf2f(OS[oi]); }
                const LAS float* r1 = RED + p * 512 + e; const float kS = (r1[0] + r1[128]) + (r1[256] + r1[384]);
                const float av = AV[i], delta = BETA[i] * (VF[i * 128 + e] - av * kS);
                float opart = 0.f;
#pragma unroll
                for (int j = 0; j < 8; ++j) { const f32x4 q4 = qr[j];
                    S[4 * j] = av * S[4 * j] + kk[4 * j] * delta; S[4 * j + 1] = av * S[4 * j + 1] + kk[4 * j + 1] * delta; S[4 * j + 2] = av * S[4 * j + 2] + kk[4 * j + 2] * delta; S[4 * j + 3] = av * S[4 * j + 3] + kk[4 * j + 3] * delta;
                    opart += (q4.x * S[4 * j] + q4.y * S[4 * j + 1]) + (q4.z * S[4 * j + 2] + q4.w * S[4 * j + 3]); }
                RED2[p * 512 + dg * 128 + e] = opart;
            }
            __syncthreads();
            if (dg == 0) { const int ip = dir ? 0 : 31; const LAS float* r2 = RED2 + 1 * 512 + e; const float o = (r2[0] + r2[128]) + (r2[256] + r2[384]);
                const size_t oi = (rowb + t0 + ip) * 512 + h * 128 + e;
                if (dir == 0) OS[oi] = (bf16)f2bf(o); else OSUM[ip * 128 + e] = o + bf2f(OS[oi]); }
            if (dir == 1) {
                __syncthreads();
                for (int tt = 0; tt < 4; ++tt) { const int tok = wave * 4 + tt; const float x0 = OSUM[tok * 128 + lane], x1 = OSUM[tok * 128 + lane + 64];
                    const float rs = rsqrtf(wave_sum(x0 * x0 + x1 * x1) * (1.f / 128.f) + EPS);
                    bf16* zg = Z + (rowb + t0 + tok) * ZLD + ZC_GG + h * 128;
                    const float g0 = bf2f(zg[lane]), g1 = bf2f(zg[lane + 64]);
                    zg[lane] = (bf16)f2bf(x0 * rs * gn[lane] * siluf_(g0)); zg[lane + 64] = (bf16)f2bf(x1 * rs * gn[lane + 64] * siluf_(g1)); }
            }
        }
    }
}
}
namespace hg0 {
constexpr int QF_OFF = 0, FF_OFF = 16384, KF_OFF = 32768, VF_OFF = 49152, RED_OFF = 57344, OSUM_OFF = 61440;
__device__ __forceinline__ void chain(CArgs& a, LAS unsigned char* lds, int layer, int b, int h) {
    int tid_ = threadIdx.x; asm volatile("" : "+v"(tid_)); const int tid = tid_, lane = tid & 63, wave = tid >> 6;
    bf16* Z = (bf16*)(a.ws + WS_Z); bf16* OS = (bf16*)(a.ws + WS_OSH); const float* LB = (const float*)(a.ws + WS_LB);
    LAS float* QF = (LAS float*)(lds + QF_OFF); LAS float* FF = (LAS float*)(lds + FF_OFF); LAS float* KF = (LAS float*)(lds + KF_OFF); LAS float* VF = (LAS float*)(lds + VF_OFF);
    LAS float* RED = (LAS float*)(lds + RED_OFF); LAS float* OSUM = (LAS float*)(lds + OSUM_OFF);
    const float* hn = a.in[I_HNORM] + layer * 64;
    const int e = tid & 63, dg = tid >> 6; const size_t rowb = (size_t)b * TPB;
    for (int dir = 0; dir < 2; ++dir) {
        float S[16];
#pragma unroll
        for (int j = 0; j < 16; ++j) S[j] = 0.f;
        const int zf = dir ? ZC_HFB : ZC_HFF;
        for (int step = 0; step < 136; ++step) {
            int lo, hi; const int t0 = chunk32_t0(step, dir, lo, hi);
            __syncthreads();
            for (int idx = tid; idx < 32 * 128; idx += 512) { const int i = idx >> 7, d = idx & 127; const bf16* zr = Z + (rowb + t0 + i) * ZLD;
                const float xq = bf2f(zr[ZC_HQ + h * 128 + d]), xf = bf2f(zr[zf + h * 128 + d]), lbv = LB[layer * 1024 + dir * 512 + h * 128 + d];
                const float sg = 1.0f / (1.0f + __expf(-xf)), sgn = 1.0f / (1.0f + __expf(xf));
                QF[idx] = xq * 0.08838834764831845f; FF[idx] = lbv + (1.0f - lbv) * sg; KF[idx] = (1.0f - lbv) * sgn; }
            for (int idx = tid; idx < 32 * 64; idx += 512) { const int i = idx >> 6; VF[idx] = bf2f(Z[(rowb + t0 + i) * ZLD + ZC_HI + h * 64 + (idx & 63)]); }
            __syncthreads();
            for (int ii = 0; ii < 32; ++ii) {
                const int i = dir ? 31 - ii : ii, p = ii & 1;
                const LAS f32x4* fr = (const LAS f32x4*)(FF + i * 128 + dg * 16); const LAS f32x4* kr = (const LAS f32x4*)(KF + i * 128 + dg * 16); const LAS f32x4* qr = (const LAS f32x4*)(QF + i * 128 + dg * 16);
                const float v = VF[i * 64 + e]; float opart = 0.f;
#pragma unroll
                for (int j = 0; j < 4; ++j) { const f32x4 f4 = fr[j], k4 = kr[j], q4 = qr[j];
                    S[4 * j] = f4.x * S[4 * j] + k4.x * v; S[4 * j + 1] = f4.y * S[4 * j + 1] + k4.y * v; S[4 * j + 2] = f4.z * S[4 * j + 2] + k4.z * v; S[4 * j + 3] = f4.w * S[4 * j + 3] + k4.w * v;
                    opart += (q4.x * S[4 * j] + q4.y * S[4 * j + 1]) + (q4.z * S[4 * j + 2] + q4.w * S[4 * j + 3]); }
                RED[p * 512 + dg * 64 + e] = opart;
                __syncthreads();
                if (dg == 0) { const LAS float* r = RED + p * 512 + e; const float o = ((r[0] + r[64]) + (r[128] + r[192])) + ((r[256] + r[320]) + (r[384] + r[448]));
                    const size_t oi = (rowb + t0 + i) * 256 + h * 64 + e;
                    if (dir == 0) OS[oi] = (bf16)f2bf(o); else OSUM[i * 64 + e] = o + bf2f(OS[oi]); }
            }
            if (dir == 1) {
                __syncthreads();
                for (int tt = 0; tt < 4; ++tt) { const int tok = wave * 4 + tt; const float x = OSUM[tok * 64 + lane];
                    const float rs = rsqrtf(wave_sum(x * x) * (1.f / 64.f) + EPS);
                    bf16* zg = Z + (rowb + t0 + tok) * ZLD + ZC_HG + h * 64;
                    const float g = bf2f(zg[lane]);
                    zg[lane] = (bf16)f2bf(x * rs * hn[lane] * siluf_(g)); }
            }
        }
    }
}
}

constexpr int NCHUNK = MT / 64;
__device__ __forceinline__ void gdn_halo_copy(CArgs& a, int gw, int NGW, int lane) {
    const bf16* Z = (const bf16*)(a.ws + WS_Z); bf16* HL = (bf16*)(a.ws + WS_HALO);
    for (int it = gw; it < NCHUNK * 4; it += NGW) {
        const int cg = it >> 2, slot = it & 3, b = cg / 68, c = cg - b * 68;
        const int lo = c < 4 ? 0 : CTXL, hi = c < 4 ? CTXL : TPB;
        const int t = 64 * c + (slot < 2 ? slot - 2 : 62 + slot);
        const bool ok = t >= lo && t < hi;
        const GAS v4u* src = (const GAS v4u*)(Z + ((size_t)b * TPB + (ok ? t : 64 * c)) * ZLD);
        GAS v4u* dst = (GAS v4u*)(HL + (size_t)it * 1536);
#pragma unroll
        for (int j = 0; j < 3; ++j) { v4u v = src[lane + 64 * j]; if (!ok) v = (v4u){0u, 0u, 0u, 0u}; dst[lane + 64 * j] = v; }
    }
}
__device__ __forceinline__ void gdn_conv_pass(CArgs& a, LAS unsigned char* lds, int layer, int vcu, int G) {
    int tid_ = threadIdx.x; asm volatile("" : "+v"(tid_)); const int tid = tid_, lane = tid & 63, wave = tid >> 6;
    bf16* Z = (bf16*)(a.ws + WS_Z); const bf16* HL = (const bf16*)(a.ws + WS_HALO); float* BG = (float*)(a.ws + WS_BG);
    LAS bf16* RAW = (LAS bf16*)lds;
    for (int u = vcu; u < NCHUNK * 4; u += G) {
        const int cg = u >> 2, h = u & 3; const size_t row0 = (size_t)cg * 64;
        __syncthreads();
        for (int idx = tid; idx < 68 * 48; idx += 512) { const int rr = idx / 48, ch = idx - rr * 48; const int colz = (ch >> 4) * 512 + h * 128 + (ch & 15) * 8;
            const bf16* src = (rr >= 2 && rr < 66) ? Z + (row0 + rr - 2) * ZLD + colz : HL + ((size_t)cg * 4 + (rr < 2 ? rr : rr - 64)) * 1536 + colz;
            *(LAS v4u*)(RAW + rr * 384 + ch * 8) = *(const GAS v4u*)src; }
        if (tid < 128) { const int i = tid & 63, dir = tid >> 6; const bf16* zr = Z + (row0 + i) * ZLD;
            const float zb = bf2f(zr[ZC_GB + dir * 4 + h]), za = bf2f(zr[ZC_GA + dir * 4 + h]);
            const float A_ = expf(a.in[I_GALOG][layer * 8 + dir * 4 + h]), dtb = a.in[I_GDT][layer * 8 + dir * 4 + h];
            float* o = BG + ((row0 + i) * 4 + h) * 4 + dir * 2; o[0] = sigmoidf_(zb); o[1] = -A_ * softplusf_(za + dtb); }
        float cw[5][6];
#pragma unroll
        for (int j = 0; j < 5; ++j)
#pragma unroll
            for (int m = 0; m < 6; ++m) cw[j][m] = a.in[I_GCONV][(size_t)layer * 5 * 1536 + j * 1536 + (m >> 1) * 512 + h * 128 + (m & 1) * 64 + lane];
        __syncthreads();
        for (int i = wave; i < 64; i += 8) {
            float y[6];
#pragma unroll
            for (int m = 0; m < 6; ++m) { float acc = 0.f;
#pragma unroll
                for (int j = 0; j < 5; ++j) acc += cw[j][m] * bf2f(RAW[(i + j) * 384 + m * 64 + lane]);
                y[m] = siluf_(acc); }
            const float sq = rsqrtf(wave_sum(y[0] * y[0] + y[1] * y[1]) + 1e-6f) * 0.08838834764831845f, sk = rsqrtf(wave_sum(y[2] * y[2] + y[3] * y[3]) + 1e-6f);
            bf16* zr = Z + (row0 + i) * ZLD + h * 128 + lane;
            zr[ZC_GQ] = (bf16)f2bf(y[0] * sq); zr[ZC_GQ + 64] = (bf16)f2bf(y[1] * sq); zr[ZC_GK] = (bf16)f2bf(y[2] * sk); zr[ZC_GK + 64] = (bf16)f2bf(y[3] * sk);
            zr[ZC_GV] = (bf16)f2bf(y[4]); zr[ZC_GV + 64] = (bf16)f2bf(y[5]); }
    }
}

namespace gdn1 {
typedef short v4i16 __attribute__((ext_vector_type(4)));
constexpr int LD = 136, LDT = 72;
constexpr int KB_OFF = 0, QB_OFF = 17408, VB_OFF = 34816, SB_OFF = 52224, WB_OFF = 87040, TB_OFF = 104448, AQ_OFF = 113664, LB_OFF = 122880, LDG_OFF = 132096  ,
              XS_OFF = 136448  , YS_OFF = 137984  , SC_OFF = 140544  , SS_OFF = 141888  , END_OFF = 142912;
__device__ __forceinline__ int crow(int r, int hi) { return (r & 3) + 8 * (r >> 2) + 4 * hi; }
__device__ __forceinline__ s16x4 trr(const LAS bf16* p) { return __builtin_bit_cast(s16x4, __builtin_amdgcn_ds_read_tr16_b64_v4i16((LAS v4i16*)p)); }
__device__ __forceinline__ bf16x8 frag_rk(const LAS bf16* base, int ld, int row0, int k0, int lane) { return *(const LAS bf16x8*)(base + (row0 + (lane & 31)) * ld + k0 + 8 * (lane >> 5)); }
__device__ __forceinline__ bf16x8 frag_kr(const LAS bf16* base, int ld, int k0, int x0, int lane) {
    const LAS bf16* p = base + (k0 + 8 * (lane >> 5) + ((lane & 15) >> 2)) * ld + x0 + 16 * ((lane >> 4) & 1) + 4 * (lane & 3);
    const s16x4 lo = trr(p), hi = trr(p + 4 * ld);
    return (bf16x8){lo[0], lo[1], lo[2], lo[3], hi[0], hi[1], hi[2], hi[3]}; }
__device__ __forceinline__ void cstore(const f32x16& acc, LAS bf16* base, int ld, int row0, int col0, int lane, float sgn) {
    const int hi = lane >> 5, l31 = lane & 31;
#pragma unroll
    for (int r = 0; r < 16; ++r) base[(row0 + crow(r, hi)) * ld + col0 + l31] = (bf16)f2bf(sgn * acc[r]); }
#define MFMA32(a, b, c) __builtin_amdgcn_mfma_f32_32x32x16_bf16(a, b, c, 0, 0, 0)

__device__ __forceinline__ void chain(CArgs& a, LAS unsigned char* lds, int layer, int b, int h) {
    int tid0_ = threadIdx.x; asm volatile("" : "+v"(tid0_)); const int w = __builtin_amdgcn_readfirstlane(tid0_ >> 6);
    bf16* Z = (bf16*)(a.ws + WS_Z); bf16* OS = (bf16*)(a.ws + WS_OSG); const float* BG = (const float*)(a.ws + WS_BG);
    LAS bf16* Kb = (LAS bf16*)(lds + KB_OFF); LAS bf16* Qb = (LAS bf16*)(lds + QB_OFF); LAS bf16* Vb = (LAS bf16*)(lds + VB_OFF); LAS bf16* Sb = (LAS bf16*)(lds + SB_OFF);
    LAS bf16* Wb = (LAS bf16*)(lds + WB_OFF); LAS bf16* Tb = (LAS bf16*)(lds + TB_OFF); LAS bf16* Aq = (LAS bf16*)(lds + AQ_OFF); LAS bf16* Lb = (LAS bf16*)(lds + LB_OFF);
    LAS float* Ldg = (LAS float*)(lds + LDG_OFF); LAS bf16* XS = (LAS bf16*)(lds + XS_OFF); LAS bf16* YS = (LAS bf16*)(lds + YS_OFF);
    LAS float* bet = (LAS float*)(lds + SC_OFF); LAS float* gc = bet + 64; LAS float* eg = bet + 128; LAS float* ekl = bet + 192; LAS float* bes = bet + 256; LAS float* egl = bet + 320;
    LAS float* SS = (LAS float*)(lds + SS_OFF);
    const float* gn = a.in[I_GNORM] + layer * 128;
    const size_t rowb = (size_t)b * TPB;
    const int tr = w >> 2, tc = w & 3;
    const int sr = w >> 1, sc0 = 2 * (w & 1);
    for (int dir = 0; dir < 2; ++dir) {
        f32x16 accS[2]; accS[0] = f32x16{}; accS[1] = f32x16{};
        __syncthreads();
        { int tid_ = threadIdx.x; asm volatile("" : "+v"(tid_)); const int tid = tid_;
        for (int i = tid; i < 128 * LD / 2; i += 512) ((LAS unsigned*)Sb)[i] = 0u;
        for (int i = tid; i < 64 * LDT / 2; i += 512) ((LAS unsigned*)Tb)[i] = 0u; }
        v4u pf[6]; float pbg0 = 0.f, pbg1 = 0.f;
#define GDN_T0(step) (64 * ((step) < 4 ? (dir ? 3 - (step) : (step)) : 4 + (dir ? 63 - ((step) - 4) : (step) - 4)))
#define GDN_PREFETCH(step) do { const int t0n = GDN_T0(step); \
            _Pragma("unroll") for (int m = 0; m < 6; ++m) { const int idx = tid + 512 * m, mat = idx >> 10, rem = idx & 1023, i = rem >> 4, ch = rem & 15; \
                pf[m] = *(const GAS v4u*)(Z + (rowb + t0n + (dir ? 63 - i : i)) * ZLD + mat * 512 + h * 128 + ch * 8); } \
            if (w == 7) { const float* p = BG + ((rowb + t0n + (dir ? 63 - lane : lane)) * 4 + h) * 4 + dir * 2; pbg0 = p[0]; pbg1 = p[1]; } } while (0)
#define GDN_COMMIT() do { \
            _Pragma("unroll") for (int m = 0; m < 6; ++m) { const int idx = tid + 512 * m, mat = idx >> 10, rem = idx & 1023, i = rem >> 4, ch = rem & 15; \
                *(LAS v4u*)((mat == 0 ? Qb : (mat == 1 ? Kb : Vb)) + i * LD + ch * 8) = pf[m]; } \
            if (w == 7) { float v = pbg1; \
                _Pragma("unroll") for (int o = 1; o < 64; o <<= 1) { const float t = __shfl_up(v, o); if (lane >= o) v += t; } \
                const float gl = __shfl(v, 63); const float e = __expf(v); \
                bet[lane] = pbg0; gc[lane] = v; eg[lane] = e; ekl[lane] = __expf(gl - v); bes[lane] = pbg0 * e; if (lane == 0) egl[0] = __expf(gl); } } while (0)
        { int tid_ = threadIdx.x; asm volatile("" : "+v"(tid_)); const int tid = tid_, lane = tid & 63;
          GDN_PREFETCH(0);
          GDN_COMMIT(); }
        __syncthreads();
        for (int step = 0; step < 68; ++step) {
            int tid_ = threadIdx.x; asm volatile("" : "+v"(tid_)); const int tid = tid_, lane = tid & 63, l31 = lane & 31, hi = lane >> 5;
            const int t0 = GDN_T0(step);
            if (step + 1 < 68) GDN_PREFETCH(step + 1);
            {   const int ti = (w >> 1) & 1, tj = w & 1; const LAS bf16* src = w < 4 ? Kb : Qb;
                f32x16 acc = f32x16{};
                if (!(ti == 0 && tj == 1)) {
#pragma unroll
                    for (int s = 0; s < 8; ++s) acc = MFMA32(frag_rk(src, LD, 32 * ti, 16 * s, lane), frag_rk(Kb, LD, 32 * tj, 16 * s, lane), acc); }
                const int j = 32 * tj + l31; const float gcj = gc[j];
#pragma unroll
                for (int r = 0; r < 16; ++r) { const int i = 32 * ti + crow(r, hi); const float e = __expf(gc[i] - gcj);
                    if (w < 4) { const float val = i > j ? bet[i] * acc[r] * e : 0.f; Lb[i * LDT + j] = (bf16)f2bf(val);
                        if ((i >> 4) == (j >> 4)) Ldg[((i >> 4) * 16 + (i & 15)) * 17 + (j & 15)] = val; }
                    else { const float val = i >= j ? acc[r] * e : 0.f; Aq[i * LDT + j] = (bf16)f2bf(val); } }
            }
            __syncthreads();
            if (w < 4) {
                const int c = lane & 15; float t[16];
#pragma unroll
                for (int i = 0; i < 16; ++i) { float s = (i == c) ? 1.f : 0.f;
#pragma unroll
                    for (int j = 0; j < i; ++j) s -= Ldg[(w * 16 + i) * 17 + j] * t[j];
                    t[i] = s; }
                if (lane < 16) {
#pragma unroll
                    for (int i = 0; i < 16; ++i) Tb[(16 * w + i) * LDT + 16 * w + c] = (bf16)f2bf(t[i]); }
            } else {
                const int t2 = tid - 256, row = t2 >> 2, c0 = (t2 & 3) * 32; const float bv = bet[row];
#pragma unroll
                for (int q = 0; q < 4; ++q) { LAS v4u* p = (LAS v4u*)(Vb + row * LD + c0 + 8 * q); v4u v = *p;
                    v.x = pk2(bflo(v.x) * bv, bfhi(v.x) * bv); v.y = pk2(bflo(v.y) * bv, bfhi(v.y) * bv); v.z = pk2(bflo(v.z) * bv, bfhi(v.z) * bv); v.w = pk2(bflo(v.w) * bv, bfhi(v.w) * bv); *p = v; }
            }
            __syncthreads();
            if (w < 2) {
                const int p = w, r16 = lane & 15, g = lane >> 4, g1 = g & 1; const bool act = g < 2;
                typedef float f32x4_ __attribute__((ext_vector_type(4)));
                bf16x8 af = *(const LAS bf16x8*)(Lb + (32 * p + 16 + r16) * LDT + 32 * p + 8 * g1), bfr;
#pragma unroll
                for (int j = 0; j < 8; ++j) bfr[j] = (short)Tb[(32 * p + 8 * g1 + j) * LDT + 32 * p + r16];
                if (!act) { af = bf16x8{}; bfr = bf16x8{}; }
                f32x4_ x = __builtin_amdgcn_mfma_f32_16x16x32_bf16(af, bfr, (f32x4_){0.f, 0.f, 0.f, 0.f}, 0, 0, 0);
                LAS bf16* xs = XS + p * 16 * 24;
#pragma unroll
                for (int q = 0; q < 4; ++q) xs[(4 * g + q) * 24 + r16] = (bf16)f2bf(x[q]);
                LDS_WAIT(); asm volatile("" ::: "memory");
                af = *(const LAS bf16x8*)(Tb + (32 * p + 16 + r16) * LDT + 32 * p + 16 + 8 * g1);
#pragma unroll
                for (int j = 0; j < 8; ++j) bfr[j] = (short)xs[(8 * g1 + j) * 24 + r16];
                if (!act) { af = bf16x8{}; bfr = bf16x8{}; }
                const f32x4_ tt = __builtin_amdgcn_mfma_f32_16x16x32_bf16(af, bfr, (f32x4_){0.f, 0.f, 0.f, 0.f}, 0, 0, 0);
#pragma unroll
                for (int q = 0; q < 4; ++q) Tb[(32 * p + 16 + 4 * g + q) * LDT + 32 * p + r16] = (bf16)f2bf(-tt[q]);
            }
            __syncthreads();
            if (w == 0) {
                f32x16 y = f32x16{};
#pragma unroll
                for (int s = 0; s < 2; ++s) y = MFMA32(frag_rk(Lb, LDT, 32, 16 * s, lane), frag_kr(Tb, LDT, 16 * s, 0, lane), y);
                cstore(y, YS, 40, 0, 0, lane, 1.f);
                LDS_WAIT(); asm volatile("" ::: "memory");
                f32x16 z = f32x16{};
#pragma unroll
                for (int s = 0; s < 2; ++s) z = MFMA32(frag_rk(Tb, LDT, 32, 32 + 16 * s, lane), frag_kr(YS, 40, 16 * s, 0, lane), z);
                cstore(z, Tb, LDT, 32, 0, lane, -1.f);
            }
            __syncthreads();
            f32x16 accU = f32x16{};
            {   f32x16 accW = f32x16{};
                const int ns = tr == 0 ? 2 : 4;
                for (int s = 0; s < ns; ++s) {
                    const bf16x8 ta = frag_rk(Tb, LDT, 32 * tr, 16 * s, lane);
                    accU = MFMA32(ta, frag_kr(Vb, LD, 16 * s, 32 * tc, lane), accU);
                    bf16x8 tw; const LAS float* bs = bes + 16 * s + 8 * hi;
#pragma unroll
                    for (int j = 0; j < 8; ++j) tw[j] = (short)f2bf(bf2f((unsigned short)ta[j]) * bs[j]);
                    accW = MFMA32(tw, frag_kr(Kb, LD, 16 * s, 32 * tc, lane), accW); }
                cstore(accW, Wb, LD, 32 * tr, 32 * tc, lane, 1.f);
            }
            __syncthreads();
            {   f32x16 ws = f32x16{};
#pragma unroll
                for (int s = 0; s < 8; ++s) ws = MFMA32(frag_rk(Wb, LD, 32 * tr, 16 * s, lane), frag_kr(Sb, LD, 16 * s, 32 * tc, lane), ws);
#pragma unroll
                for (int r = 0; r < 16; ++r) accU[r] -= ws[r];
                cstore(accU, Vb, LD, 32 * tr, 32 * tc, lane, 1.f);
                const int row = tid >> 3, c0 = (tid & 7) * 16; const float kv = ekl[row];
#pragma unroll
                for (int q = 0; q < 2; ++q) { LAS v4u* p = (LAS v4u*)(Kb + row * LD + c0 + 8 * q); v4u v = *p;
                    v.x = pk2(bflo(v.x) * kv, bfhi(v.x) * kv); v.y = pk2(bflo(v.y) * kv, bfhi(v.y) * kv); v.z = pk2(bflo(v.z) * kv, bfhi(v.z) * kv); v.w = pk2(bflo(v.w) * kv, bfhi(v.w) * kv); *p = v; }
            }
            __syncthreads();
            f32x16 o = f32x16{};
            {
#pragma unroll
                for (int s = 0; s < 8; ++s) o = MFMA32(frag_rk(Qb, LD, 32 * tr, 16 * s, lane), frag_kr(Sb, LD, 16 * s, 32 * tc, lane), o);
#pragma unroll
                for (int r = 0; r < 16; ++r) o[r] *= eg[32 * tr + crow(r, hi)];
                const int ns = tr == 0 ? 2 : 4;
                for (int s = 0; s < ns; ++s) o = MFMA32(frag_rk(Aq, LDT, 32 * tr, 16 * s, lane), frag_kr(Vb, LD, 16 * s, 32 * tc, lane), o);
                const float el = egl[0];
#pragma unroll
                for (int u = 0; u < 2; ++u) {
#pragma unroll
                    for (int r = 0; r < 16; ++r) accS[u][r] *= el;
#pragma unroll
                    for (int s = 0; s < 4; ++s) accS[u] = MFMA32(frag_kr(Kb, LD, 16 * s, 32 * sr, lane), frag_kr(Vb, LD, 16 * s, 32 * (sc0 + u), lane), accS[u]); }
            }
            const bool want = !(layer == DEPTH - 1 && step < 4);
            if (want) {
                if (dir == 0) {
#pragma unroll
                    for (int r = 0; r < 16; ++r) { const int i = 32 * tr + crow(r, hi); OS[(rowb + t0 + i) * 512 + h * 128 + 32 * tc + l31] = (bf16)f2bf(o[r]); }
                } else {
#pragma unroll
                    for (int r = 0; r < 16; ++r) { const int i = 32 * tr + crow(r, hi); o[r] += bf2f(OS[(rowb + t0 + 63 - i) * 512 + h * 128 + 32 * tc + l31]);
                        float q = o[r] * o[r]; q += __shfl_xor(q, 1); q += __shfl_xor(q, 2); q += __shfl_xor(q, 4); q += __shfl_xor(q, 8); q += __shfl_xor(q, 16);
                        if (l31 == 0) SS[i * 4 + tc] = q; }
                }
            }
            __syncthreads();
            cstore(accS[0], Sb, LD, 32 * sr, 32 * sc0, lane, 1.f); cstore(accS[1], Sb, LD, 32 * sr, 32 * (sc0 + 1), lane, 1.f);
            if (want && dir == 1) {
#pragma unroll
                for (int r = 0; r < 16; ++r) { const int i = 32 * tr + crow(r, hi); const f32x4 p4 = *(const LAS f32x4*)(SS + i * 4);
                    const float rs = rsqrtf(((p4.x + p4.y) + (p4.z + p4.w)) * (1.f / 128.f) + EPS); const int col = 32 * tc + l31;
                    bf16* zg = Z + (rowb + t0 + 63 - i) * ZLD + ZC_GG + h * 128 + col;
                    zg[0] = (bf16)f2bf(o[r] * rs * gn[col] * siluf_(bf2f(zg[0]))); }
            }
            if (step + 1 < 68) GDN_COMMIT();
            __syncthreads();
        }
    }
#undef GDN_T0
#undef GDN_PREFETCH
#undef GDN_COMMIT
}
}

namespace hg1 {
using gdn1::crow; using gdn1::frag_rk; using gdn1::frag_kr; using gdn1::cstore;
constexpr int LD = 136, LDV = 72;
constexpr int A_OFF = 0  , B_OFF = 43520, K_OFF = 60928, V_OFF = 78336, S_OFF = 87552  , AT_OFF = 105984, TOT_OFF = 115200  , EBL_OFF = 117248  , SS_OFF = 117760  ;
__device__ __forceinline__ int arow(int J) { return J == 0 ? 0 : (J == 1 ? 64 : (J == 2 ? 112 : 144)); }
__device__ __forceinline__ void chain(CArgs& a, LAS unsigned char* lds, int layer, int b, int h) {
    int tid0_ = threadIdx.x; asm volatile("" : "+v"(tid0_)); const int w = __builtin_amdgcn_readfirstlane(tid0_ >> 6);
    bf16* Z = (bf16*)(a.ws + WS_Z); bf16* OS = (bf16*)(a.ws + WS_OSH); const float* LB = (const float*)(a.ws + WS_LB);
    LAS bf16* Ab = (LAS bf16*)(lds + A_OFF); LAS bf16* Bm = (LAS bf16*)(lds + B_OFF); LAS bf16* Kt = (LAS bf16*)(lds + K_OFF); LAS bf16* Vb = (LAS bf16*)(lds + V_OFF);
    LAS bf16* Sb = (LAS bf16*)(lds + S_OFF); LAS bf16* At = (LAS bf16*)(lds + AT_OFF); LAS float* tot = (LAS float*)(lds + TOT_OFF); LAS float* ebl = (LAS float*)(lds + EBL_OFF); LAS float* SS = (LAS float*)(lds + SS_OFF);
    const float* hn = a.in[I_HNORM] + layer * 64;
    const size_t rowb = (size_t)b * TPB;
    const int mblk = w >> 1;
    const int sr = w >> 1, sc = w & 1;
    const int tr = (w >> 1) & 1, tc = w & 1;
    for (int dir = 0; dir < 2; ++dir) {
        f32x16 accS = f32x16{};
        const int zf = dir ? ZC_HFB : ZC_HFF;
        __syncthreads();
        { int tid_ = threadIdx.x; asm volatile("" : "+v"(tid_)); const int tid = tid_;
          for (int i = tid; i < 128 * LDV / 2; i += 512) ((LAS unsigned*)Sb)[i] = 0u;
          for (int i = tid; i < 64 * LDV / 2; i += 512) ((LAS unsigned*)At)[i] = 0u; }
        unsigned short pxq[16], pxf[16]; v4u pv;
#define HG_T0(step) (64 * ((step) < 4 ? (dir ? 3 - (step) : (step)) : 4 + (dir ? 63 - ((step) - 4) : (step) - 4)))
#define HG_PREFETCH(step) do { const int t0n = HG_T0(step); const int d_ = tid & 127; \
            _Pragma("unroll") for (int ii = 0; ii < 16; ++ii) { const int i = 16 * mblk + ii; const bf16* zr = Z + (rowb + t0n + (dir ? 63 - i : i)) * ZLD + h * 128 + d_; pxq[ii] = zr[ZC_HQ]; pxf[ii] = zr[zf]; } \
            { const int i = tid >> 3, ch = tid & 7; pv = *(const GAS v4u*)(Z + (rowb + t0n + (dir ? 63 - i : i)) * ZLD + ZC_HI + h * 64 + ch * 8); } } while (0)
        { int tid_ = threadIdx.x; asm volatile("" : "+v"(tid_)); const int tid = tid_; HG_PREFETCH(0); }
        __syncthreads();
        for (int step = 0; step < 68; ++step) {
            int tid_ = threadIdx.x; asm volatile("" : "+v"(tid_)); const int tid = tid_, lane = tid & 63, l31 = lane & 31, hi = lane >> 5;
            const int t0 = HG_T0(step);
            const int d = tid & 127;
            float lc[16], qv[16], kv[16];
            {   const float lbv = LB[layer * 1024 + dir * 512 + h * 128 + d], olb = 1.0f - lbv; float run = 0.f;
#pragma unroll
                for (int ii = 0; ii < 16; ++ii) { const float x = fmaxf(bf2f(pxf[ii]), -80.f); const float ex = __expf(-x);
                    const float sg = 1.0f / (1.0f + ex); run += __logf(lbv + olb * sg); lc[ii] = run;
                    kv[ii] = olb * (ex * sg);
                    qv[ii] = bf2f(pxq[ii]) * 0.08838834764831845f; }
                tot[mblk * 128 + d] = run;
#pragma unroll
                for (int ii = 0; ii < 16; ++ii) Bm[(16 * mblk + ii) * LD + d] = (bf16)f2bf(kv[ii] * __expf(fminf(-lc[ii], 80.f)));
                *(LAS v4u*)(Vb + (tid >> 3) * LDV + (tid & 7) * 8) = pv;
            }
            if (step + 1 < 68) HG_PREFETCH(step + 1);
            __syncthreads();
            {   const float r1 = tot[d], r2 = r1 + tot[128 + d], r3 = r2 + tot[256 + d], bl = r3 + tot[384 + d];
                const float rm = mblk == 0 ? 0.f : (mblk == 1 ? r1 : (mblk == 2 ? r2 : r3));
                if (mblk == 0) ebl[d] = __expf(bl);
#pragma unroll
                for (int ii = 0; ii < 16; ++ii) Kt[(16 * mblk + ii) * LD + d] = (bf16)f2bf(kv[ii] * __expf((bl - rm) - lc[ii]));
#pragma unroll
                for (int J = 0; J < 4; ++J) if (J <= mblk) { const float off = rm - (J == 0 ? 0.f : (J == 1 ? r1 : (J == 2 ? r2 : r3)));
#pragma unroll
                    for (int ii = 0; ii < 16; ++ii) Ab[(arow(J) + 16 * (mblk - J) + ii) * LD + d] = (bf16)f2bf(qv[ii] * __expf(off + lc[ii])); }
            }
            __syncthreads();
            for (int idx = w; idx < 10; idx += 8) {
                const int I = idx >= 6 ? 3 : (idx >= 3 ? 2 : (idx >= 1 ? 1 : 0)), J = idx - (I * (I + 1)) / 2;
                const int r16 = lane & 15, g = lane >> 4;
                f32x4 acc = (f32x4){0.f, 0.f, 0.f, 0.f};
                const LAS bf16* ap = Ab + (arow(J) + 16 * (I - J) + r16) * LD + 8 * g; const LAS bf16* bp = Bm + (16 * J + r16) * LD + 8 * g;
#pragma unroll
                for (int s = 0; s < 4; ++s) acc = __builtin_amdgcn_mfma_f32_16x16x32_bf16(*(const LAS bf16x8*)(ap + 32 * s), *(const LAS bf16x8*)(bp + 32 * s), acc, 0, 0, 0);
#pragma unroll
                for (int q = 0; q < 4; ++q) { const int ri = 4 * g + q; const float v = (I != J || ri >= r16) ? acc[q] : 0.f; At[(16 * I + ri) * LDV + 16 * J + r16] = (bf16)f2bf(v); }
            }
            __syncthreads();
            f32x16 o = f32x16{};
            if (w < 4) {
#pragma unroll
                for (int s = 0; s < 8; ++s) o = MFMA32(frag_rk(Ab, LD, 32 * tr, 16 * s, lane), frag_kr(Sb, LDV, 16 * s, 32 * tc, lane), o);
                const int ns = tr == 0 ? 2 : 4;
                for (int s = 0; s < ns; ++s) o = MFMA32(frag_rk(At, LDV, 32 * tr, 16 * s, lane), frag_kr(Vb, LDV, 16 * s, 32 * tc, lane), o);
            }
            {
#pragma unroll
                for (int r = 0; r < 16; ++r) accS[r] *= ebl[32 * sr + crow(r, hi)];
#pragma unroll
                for (int s = 0; s < 4; ++s) accS = MFMA32(frag_kr(Kt, LD, 16 * s, 32 * sr, lane), frag_kr(Vb, LDV, 16 * s, 32 * sc, lane), accS);
            }
            const bool want = !(layer == DEPTH - 1 && step < 4);
            if (want && w < 4) {
                if (dir == 0) {
#pragma unroll
                    for (int r = 0; r < 16; ++r) { const int i = 32 * tr + crow(r, hi); OS[(rowb + t0 + i) * 256 + h * 64 + 32 * tc + l31] = (bf16)f2bf(o[r]); }
                } else {
#pragma unroll
                    for (int r = 0; r < 16; ++r) { const int i = 32 * tr + crow(r, hi); o[r] += bf2f(OS[(rowb + t0 + 63 - i) * 256 + h * 64 + 32 * tc + l31]);
                        float q = o[r] * o[r]; q += __shfl_xor(q, 1); q += __shfl_xor(q, 2); q += __shfl_xor(q, 4); q += __shfl_xor(q, 8); q += __shfl_xor(q, 16);
                        if (l31 == 0) SS[i * 2 + tc] = q; }
                }
            }
            __syncthreads();
            cstore(accS, Sb, LDV, 32 * sr, 32 * sc, lane, 1.f);
            if (want && dir == 1 && w < 4) {
#pragma unroll
                for (int r = 0; r < 16; ++r) { const int i = 32 * tr + crow(r, hi);
                    const float rs = rsqrtf((SS[i * 2] + SS[i * 2 + 1]) * (1.f / 64.f) + EPS); const int col = 32 * tc + l31;
                    bf16* zg = Z + (rowb + t0 + 63 - i) * ZLD + ZC_HG + h * 64 + col;
                    zg[0] = (bf16)f2bf(o[r] * rs * hn[col] * siluf_(bf2f(zg[0]))); }
            }
            __syncthreads();
        }
    }
#undef HG_T0
#undef HG_PREFETCH
}
}

#ifndef PH_MASK
#define PH_MASK 0xFFFFF
#endif
#define PH_ON(i) (((PH_MASK) >> (i)) & 1)
constexpr int PH_PER_LAYER = 9, N_PHASES = 2 + DEPTH * PH_PER_LAYER;
enum PhaseKind { PK_GEMM_IN = 0, PK_MLA_UP, PK_MLA_ROPE, PK_MIX, PK_GEMM_OUT, PK_POST1, PK_MLP1, PK_MLP2, PK_POST2 };
constexpr int ATT_UNITS_LAT = NB * 4 * 16, ATT_UNITS_CTX = NB * 4;
__device__ __forceinline__ CArgs& kargs() { CArgs* p = (CArgs*)__builtin_amdgcn_kernarg_segment_ptr(); asm volatile("" : "+s"(p)); return *p; }

__global__ void __launch_bounds__(NWAVES * 64, 2) fwd_kernel(Args args_unused) {
    extern __shared__ __attribute__((aligned(16))) unsigned char lds_[];
    LAS unsigned char* lds = (LAS unsigned char*)lds_;
    {   const int tid = threadIdx.x;
        for (int u = tid; u < (LDS_BYTES - LDSCTL_OFF) / 4; u += NWAVES * 64) ((LAS unsigned*)(lds + LDSCTL_OFF))[u] = 0u; }
    __syncthreads();
    XcdBarrier bar; { unsigned char* ws = kargs().ws; bar.bar = (unsigned*)(ws + WS_CTL) + CW_BAR; bar.x = 0; bar.st = nullptr;
        if (MK_ONE_LAUNCH) bar = xcd_barrier_post(bar.bar, (volatile LAS unsigned*)(lds + MISC_OFF) + 8); }
    const int ph_lo = kargs().ph_lo, ph_hi = kargs().ph_hi;
    for (int ph = ph_lo; ph < ph_hi; ++ph) {
        CArgs& a = kargs();
        int tid_ = threadIdx.x; asm volatile("" : "+v"(tid_));
        const int tid = tid_, lane = tid & 63, wave = __builtin_amdgcn_readfirstlane(tid >> 6);
        const int G = gridDim.x, bx = blockIdx.x, vcu = (G % 8 == 0) ? (bx % 8) * (G / 8) + bx / 8 : bx;
        const int gw = vcu * NWAVES + wave, NGW = G * NWAVES;
        if (ph == 0) { if constexpr (PH_ON(0)) p0a_prologue(a, lds, vcu, G, wave, lane, tid); }
        else if (ph == 1) { if constexpr (PH_ON(1)) p0b_prenorm(a, gw, NGW, lane); }
        else {
            const int layer = (ph - 2) / PH_PER_LAYER, kind = (ph - 2) % PH_PER_LAYER;
            if (kind == PK_GEMM_IN || kind == PK_MLA_UP || kind == PK_GEMM_OUT || kind == PK_MLP1 || kind == PK_MLP2) {
                {
                    bf16* HB = (bf16*)(a.ws + WS_HB); bf16* Z = (bf16*)(a.ws + WS_Z);
                    const unsigned char* wb = a.ws + WS_W + (size_t)layer * W_LAYER;
                    pg8::StaticOrder S;
#define RUN_GEMM(Aop, Bop, N_, K_, LDA_, Out, LDC_, ACT_) do { int kk_ = K_; asm volatile("" : "+s"(kk_)); const pg8::Gemm g{Aop, (const bf16*)(Bop), MT, N_, kk_, LDA_}; const pg8::EpiBf16 E{Out, LDC_, ACT_}; S.init(MT, N_, G, bx); \
                        pg8::gemm_phase<pg8::EpiBf16, pg8::StaticOrder, true, true>(lds, g, S, E); } while (0)
                    if (kind == PK_GEMM_IN)     { if constexpr (PH_ON(2)) RUN_GEMM(HB, wb + W_IN, ZLD, DM, DM, Z, ZLD, 0); }
                    else if (kind == PK_MLA_UP) { if constexpr (PH_ON(3)) RUN_GEMM(Z + ZC_CQ, wb + W_UQ, 512, 256, ZLD, HB, DM, 0);
                                                  if constexpr (PH_ON(11)) RUN_GEMM(Z + ZC_CKV, wb + W_UKV, 512, 128, ZLD, HB + 512, DM, 0); }
                    else if (kind == PK_GEMM_OUT) { if constexpr (PH_ON(6)) RUN_GEMM(Z + ZC_GG, wb + W_OUT, DM, DM, ZLD, HB, DM, 0); }
                    else if (kind == PK_MLP1)   { if constexpr (PH_ON(8)) RUN_GEMM(HB, wb + W_1, DFF, DM, DM, Z, DFF, 2); }
                    else                        { if constexpr (PH_ON(9)) RUN_GEMM(Z, wb + W_2, DM, DFF, DFF, HB, DM, 0); }
#undef RUN_GEMM
                    if (kind == PK_MLA_UP) { if constexpr (PH_ON(3)) gdn_halo_copy(a, gw, NGW, lane); }
                }
            } else if (kind == PK_MLA_ROPE) { if constexpr (PH_ON(4)) { gdn_conv_pass(a, lds, layer, vcu, G); __syncthreads(); mla_rope_pass(a, lds, wave, gw, NGW, lane); } }
            else if (kind == PK_MIX) {
                if constexpr (PH_ON(5)) {
#ifndef MIX_PARTS
#define MIX_PARTS 7
#endif
                    if (bx < 32) { if constexpr (MIX_PARTS & 1) gdn1::chain(a, lds, layer, bx >> 2, bx & 3); }
                    else if (bx < 64) { if constexpr (MIX_PARTS & 2) hg1::chain(a, lds, layer, (bx - 32) >> 2, (bx - 32) & 3); }
                    __syncthreads();
                    volatile LAS unsigned* MISC = (volatile LAS unsigned*)(lds + MISC_OFF);
                    const bf16* HB = (const bf16*)(a.ws + WS_HB); bf16* Z = (bf16*)(a.ws + WS_Z); unsigned* qhead = (unsigned*)(a.ws + WS_CTL) + CW_ATTQ + 64 * layer;
                    const int nunits = ATT_UNITS_LAT + (layer == DEPTH - 1 ? 0 : ATT_UNITS_CTX);
                    for (;;) {
                        if (tid == 0) MISC[0] = __hip_atomic_fetch_add(qhead, 1u, __ATOMIC_RELAXED, __HIP_MEMORY_SCOPE_AGENT);
                        __syncthreads();
                        const int u = (int)MISC[0];
                        __syncthreads();
                        if (u >= nunits) break;
                        int b, h, qb;
                        if (u < ATT_UNITS_LAT) { b = u >> 6; h = (u >> 4) & 3; qb = 1 + (u & 15); } else { const int uu = u - ATT_UNITS_LAT; b = uu >> 2; h = uu & 3; qb = 0; }
                        if constexpr (MIX_PARTS & 4) att::attn_unit(b, h, qb, HB, Z, lds);
                    }
                }
            }
            else if (kind == PK_POST1) { if constexpr (PH_ON(7)) post_pass(a, layer, 0, gw, NGW, lane); }
            else { if constexpr (PH_ON(10)) post_pass(a, layer, 1, gw, NGW, lane); }
        }
        if (ph + 1 < ph_hi) xcd_barrier(bar);
    }
}

extern "C" void kernel_launch(void* const* d_in, const int* in_sizes, int n_in, void* d_out, int out_size, void* d_ws, size_t ws_size, hipStream_t stream) {
    static int grid = 0;
    if (grid == 0) {
        if (n_in != 24 || in_sizes[0] != NB * SEQ * DM || out_size != NB * SEQ * DM || ws_size < WS_END) {
            fprintf(stderr, "kernel_launch: unexpected shapes (n_in %d, in0 %d, out %d, ws %zu, need %zu); nothing launched\n", n_in, n_in > 0 ? in_sizes[0] : -1, out_size, ws_size, (size_t)WS_END); grid = -1; return; }
        int dev = 0, cus = 0, per_cu = 0;
        if (hipGetDevice(&dev) != hipSuccess || hipDeviceGetAttribute(&cus, hipDeviceAttributeMultiprocessorCount, dev) != hipSuccess) { fprintf(stderr, "kernel_launch: device query failed\n"); grid = -1; return; }
        if (hipFuncSetAttribute((const void*)fwd_kernel, hipFuncAttributeMaxDynamicSharedMemorySize, LDS_BYTES) != hipSuccess) { fprintf(stderr, "kernel_launch: hipFuncSetAttribute failed\n"); grid = -1; return; }
        if (hipOccupancyMaxActiveBlocksPerMultiprocessor(&per_cu, (const void*)fwd_kernel, NWAVES * 64, LDS_BYTES) != hipSuccess || per_cu < 1)
            fprintf(stderr, "kernel_launch: note: occupancy query reports %d workgroups per CU\n", per_cu);
        (void)hipGetLastError();
        grid = cus;
        if (grid < 192) { fprintf(stderr, "kernel_launch: %d CUs < 192: unsupported\n", grid); grid = -1; return; }
    }
    if (grid < 0) return;
    if (hipMemsetAsync((char*)d_ws + WS_CTL, 0, CTL_ZERO_BYTES, stream) != hipSuccess) { fprintf(stderr, "kernel_launch: memset failed\n"); return; }
    Args a{};
    for (int i = 0; i < 24; ++i) a.in[i] = (const float*)d_in[i];
    a.out = (float*)d_out; a.ws = (unsigned char*)d_ws;
#if MK_ONE_LAUNCH
    a.ph_lo = 0; a.ph_hi = N_PHASES;
    hipLaunchKernelGGL(fwd_kernel, dim3(grid), dim3(NWAVES * 64), LDS_BYTES, stream, a);
#else
    for (int ph = 0; ph < N_PHASES; ++ph) { a.ph_lo = ph; a.ph_hi = ph + 1; hipLaunchKernelGGL(fwd_kernel, dim3(grid), dim3(NWAVES * 64), LDS_BYTES, stream, a); }
#endif
    const hipError_t le = hipPeekAtLastError();
    if (le != hipSuccess) fprintf(stderr, "kernel_launch: launch failed: %s\n", hipGetErrorName(le));
}
```

```cpp
#include <hip/hip_runtime.h>
#include <hip/hip_bf16.h>
#include <cstdio>
#include <cstdint>
#include <cmath>

#ifndef MK_ONE_LAUNCH
#define MK_ONE_LAUNCH 1
#endif

constexpr int NB = 8, SEQ = 4096, CTXL = 256, TPB = SEQ + CTXL  , MT = NB * TPB  ;
constexpr int DM = 1024, DFF = 4096, DEPTH = 2, DIN = 4528, ZLD = 4608;
constexpr float EPS = 1e-6f;
constexpr int ZC_GQ = 0, ZC_GK = 512, ZC_GV = 1024, ZC_GG = 1536, ZC_CQ = 2048, ZC_HG = 2304, ZC_CKV = 2560, ZC_KR = 2688,
              ZC_GB = 2720, ZC_GA = 2728, ZC_HQ = 2752, ZC_HFF = 3264, ZC_HFB = 3776, ZC_HI = 4288, ZC_END = 4544;
__host__ __device__ __forceinline__ int zcol_src(int n) {
    if (n < 2048) return n;
    if (n < 2304) return 2064 + (n - 2048);
    if (n < 2560) return 4272 + (n - 2304);
    if (n < 2688) return 2320 + (n - 2560);
    if (n < 2720) return 2448 + (n - 2688);
    if (n < 2728) return 2048 + (n - 2720);
    if (n < 2736) return 2056 + (n - 2728);
    if (n < 2752) return -1;
    if (n < 3264) return 2480 + (n - 2752);
    if (n < 3776) return 2992 + (n - 3264);
    if (n < 4288) return 3504 + (n - 3776);
    if (n < 4544) return 4016 + (n - 4288);
    return -1;
}
constexpr int HB_Q = 0, HB_K = 384, HB_V = 768;
constexpr float ATT_C2 = 0.10206207261596577f * 1.4426950408889634f;

constexpr size_t MiB = 1u << 20;
constexpr size_t WS_CTL = 0, CTL_ZERO_BYTES = 1 * MiB;
constexpr size_t WS_MODS = 1 * MiB;
constexpr size_t WS_ROPE = WS_MODS + 512 * 1024;
constexpr size_t WS_LB = WS_ROPE + 512 * 1024 + 0;
constexpr size_t WS_W = 3 * MiB;
constexpr size_t W_IN = 0, W_OUT = W_IN + (size_t)ZLD * DM * 2, W_1 = W_OUT + (size_t)DM * DM * 2, W_2 = W_1 + (size_t)DFF * DM * 2,
                 W_UQ = W_2 + (size_t)DM * DFF * 2, W_UKV = W_UQ + 512 * 256 * 2, W_LAYER = W_UKV + 512 * 128 * 2;
constexpr size_t WS_XC = 58 * MiB;
constexpr size_t WS_HB = 66 * MiB;
constexpr size_t WS_OSG = 134 * MiB;
constexpr size_t WS_OSH = 168 * MiB;
constexpr size_t WS_Z = 185 * MiB;
constexpr size_t WS_HALO = 492 * MiB;
constexpr size_t WS_BG = 499 * MiB;
constexpr size_t WS_END = 502 * MiB;
static_assert(WS_LB + 8192 <= WS_W && WS_W + 2 * W_LAYER <= WS_XC && WS_XC + (size_t)NB * CTXL * DM * 4 <= WS_HB && WS_HB + (size_t)MT * DM * 2 <= WS_OSG &&
              WS_OSG + (size_t)MT * 512 * 2 <= WS_OSH && WS_OSH + (size_t)MT * 256 * 2 <= WS_Z && WS_Z + (size_t)MT * ZLD * 2 <= WS_HALO && WS_HALO + (size_t)(MT / 64) * 4 * 1536 * 2 <= WS_BG && WS_BG + (size_t)MT * 16 * 4 <= WS_END && WS_END <= 512 * MiB, "d_ws map");
constexpr int CW_BAR = 4096;
constexpr int CW_HOFF_G = 65536, CW_HOFF_H = 81920;
constexpr int CW_ATTQ = 16384;

constexpr int RING_BYTES = 131072, LDSCTL_OFF = 146432, MISC_OFF = LDSCTL_OFF + 320, LDS_BYTES = 147456;
constexpr int NWAVES = 8;

#define GAS __attribute__((address_space(1)))
#define LAS __attribute__((address_space(3)))
typedef unsigned short bf16;
typedef unsigned v4u __attribute__((ext_vector_type(4)));
typedef unsigned v2u __attribute__((ext_vector_type(2)));
typedef float f32x4 __attribute__((ext_vector_type(4)));
typedef float f32x16 __attribute__((ext_vector_type(16)));
typedef short bf16x8 __attribute__((ext_vector_type(8)));
typedef short s16x4 __attribute__((ext_vector_type(4)));
typedef GAS unsigned gu32;
#define RLX_AGENT __ATOMIC_RELAXED, __HIP_MEMORY_SCOPE_AGENT
#define LDS_WAIT() asm volatile("s_waitcnt lgkmcnt(0)" ::: "memory")
#define VM_WAIT() asm volatile("s_waitcnt vmcnt(0)" ::: "memory")
#define LBAR() asm volatile("s_waitcnt lgkmcnt(0)\n\ts_barrier" ::: "memory")
typedef float f32x2_t __attribute__((ext_vector_type(2))); typedef __bf16 bf16x2_t __attribute__((ext_vector_type(2)));
__device__ __forceinline__ unsigned f2bf(float f) { return (unsigned)__builtin_bit_cast(unsigned short, (__bf16)f); }
__device__ __forceinline__ unsigned pk2(float lo, float hi) { f32x2_t v = {lo, hi}; bf16x2_t b = __builtin_convertvector(v, bf16x2_t); return __builtin_bit_cast(unsigned, b); }
__device__ __forceinline__ float bf2f(unsigned b) { return __builtin_bit_cast(float, b << 16); }
__device__ __forceinline__ float bflo(unsigned w) { return __builtin_bit_cast(float, w << 16); }
__device__ __forceinline__ float bfhi(unsigned w) { return __builtin_bit_cast(float, w & 0xffff0000u); }
__device__ __forceinline__ float wave_sum(float v) {
#pragma unroll
    for (int o = 1; o < 64; o <<= 1) v += __shfl_xor(v, o);
    return v;
}
__device__ __forceinline__ float sigmoidf_(float x) { return 1.0f / (1.0f + __expf(-x)); }
__device__ __forceinline__ float siluf_(float x) { return x / (1.0f + __expf(-x)); }

namespace pg8 {
#define PG8_LAS __attribute__((address_space(3)))
typedef unsigned short bf16_t;
typedef short bf16x8 __attribute__((ext_vector_type(8)));
typedef float f32x4 __attribute__((ext_vector_type(4)));
typedef unsigned u32x4 __attribute__((ext_vector_type(4)));
constexpr int BM = 256, BK = 64, HALF = 128, HTB = HALF * BK * 2  , STAGE_BYTES = 8 * HTB, NXCD = 8, WGM = 8;

__host__ __device__ __forceinline__ int lds_byte(int r, int c) { const int st = (r >> 4) * 2 + (c >> 5), rr = r & 15, cc = c & 31, ob = rr * 64 + cc * 2; return st * 1024 + (ob ^ (((ob >> 9) & 1) << 5)); }
__host__ __device__ __forceinline__ void stage_rc(int b, int& R, int& C) { const int st = b / 1024, sb = b % 1024, swz = sb ^ (((sb >> 9) & 1) << 5); R = (st >> 1) * 16 + swz / 64; C = (st & 1) * 32 + (swz % 64) / 2; }
__host__ __device__ __forceinline__ int perm32(int rho) { const int n = rho >> 4, i = rho & 15; return 8 * (i >> 2) + 4 * n + (i & 3); }

struct Unit { int pm, pn; };
struct Gemm { const bf16_t* A; const bf16_t* Bt; int M, N, K, lda; };

struct StaticOrder {
    int nM, nN, nwg, G, c;
    __host__ __device__ void init(int M, int N, int G_, int c_) { nM = M / BM; nN = N / BM; nwg = nM * nN; G = G_; c = c_; }
    __host__ __device__ bool next(int i, Unit& u) const {
        const long L = (long)i * G + c; if (L >= nwg) return false;
        int wgid = (int)L; { const int q = nwg / NXCD, r = nwg % NXCD, xcd = wgid % NXCD, off = wgid / NXCD; wgid = (xcd < r ? xcd * (q + 1) : r * (q + 1) + (xcd - r) * q) + off; }
        const int nig = WGM * nN, gid = wgid / nig, fm = gid * WGM, gsz = (nM - fm) < WGM ? (nM - fm) : WGM;
        u.pm = fm + ((wgid % nig) % gsz); u.pn = (wgid % nig) / gsz; return true;
    }
    __device__ __forceinline__ void a_ready(const Unit&) const {}
    __device__ __forceinline__ void done(const Unit&) const {}
};

__device__ __forceinline__ unsigned cvt_pk_bf16(float lo, float hi) { unsigned r; asm volatile("v_cvt_pk_bf16_f32 %0, %1, %2" : "=v"(r) : "v"(lo), "v"(hi)); return r; }
typedef float f32x2 __attribute__((ext_vector_type(2)));
struct EpiBf16 {
    static constexpr bool PERM = true, AFTER_DRAIN = false;
    bf16_t* O; int ldc; int act;
    __device__ __forceinline__ void operator()(const f32x4 (&acc)[2][2][4][2], const Unit& u, int wr, int wc, int fr, int fq) const {
        const int row0 = u.pm * BM + wr * 64 + fr; const int col0 = u.pn * BM + wc * 32 + 8 * fq;
        const bool sq = act == 2;
#pragma unroll
        for (int ai = 0; ai < 2; ++ai)
#pragma unroll
            for (int m = 0; m < 4; ++m) { bf16_t* rowp = O + (size_t)(row0 + ai * HALF + m * 16) * ldc + col0;
#pragma unroll
                for (int bj = 0; bj < 2; ++bj) { f32x4 v0 = acc[ai][bj][m][0], v1 = acc[ai][bj][m][1];
                    if (sq) {
#pragma unroll
                        for (int q = 0; q < 4; ++q) { const float a = v0[q] > 0.f ? v0[q] : 0.f, b = v1[q] > 0.f ? v1[q] : 0.f; v0[q] = a * a; v1[q] = b * b; } }
                    u32x4 w; w.x = cvt_pk_bf16(v0[0], v0[1]); w.y = cvt_pk_bf16(v0[2], v0[3]); w.z = cvt_pk_bf16(v1[0], v1[1]); w.w = cvt_pk_bf16(v1[2], v1[3]);
                    *(u32x4*)(rowp + bj * HALF) = w; } }
    }
};

template <class Epi, class Sched, bool ALIGN_EPI = false, bool SP2 = false>
__device__ __forceinline__ void gemm_phase(PG8_LAS unsigned char* lds, const Gemm g, const Sched& S, const Epi& E) {
    int tid_ = threadIdx.x; asm volatile("" : "+v"(tid_));
    const int tid = tid_, wid = __builtin_amdgcn_readfirstlane(tid >> 6), lane = tid & 63, wr = wid >> 2, wc = wid & 3, fr = lane & 15, fq = lane >> 4;
    const int K = g.K, nt = K / BK;
    unsigned voffA[2], voffB[2];
#pragma unroll
    for (int i = 0; i < 2; ++i) { int R, C; stage_rc(tid * 16 + i * 8192, R, C); const int Rb = Epi::PERM ? ((R & ~31) + perm32(R & 31)) : R;
        voffA[i] = (unsigned)(R * g.lda + C) * 2u; voffB[i] = (unsigned)(Rb * K + C) * 2u; }
    const size_t kstep = (size_t)(BK * 2);
    const size_t hstepA = (size_t)HALF * g.lda * 2, hstepB = (size_t)HALF * K * 2;
    const size_t tstepA = 2 * hstepA, tstepB = 2 * hstepB;
    const unsigned ldsw = (unsigned)wid * 1024u;
    const int aoff = lds_byte(wr * 64 + fr, fq * 8), boff = lds_byte(wc * 32 + fr, fq * 8);
#define PG8_SA(b, h) (((b) * 2 + (h)) * HTB)
#define PG8_SB(b, h) ((4 + (b) * 2 + (h)) * HTB)
#define PG8_STAGE(bufoff, gbase, voff) do { _Pragma("unroll") for (int _i = 0; _i < 2; ++_i) \
        __builtin_amdgcn_global_load_lds((const unsigned*)((const char*)(gbase) + (voff)[_i]), (PG8_LAS unsigned*)(lds + (bufoff) + ldsw + _i * 8192), 16, 0, 0); } while (0)
#define PG8_LDA(dst, b, h) do { _Pragma("unroll") for (int m = 0; m < 4; ++m) _Pragma("unroll") for (int k = 0; k < 2; ++k) dst[m][k] = *(const PG8_LAS bf16x8*)(lds + PG8_SA(b, h) + aoff + m * 2048 + k * 1024); } while (0)
#define PG8_LDB(dst, b, h) do { _Pragma("unroll") for (int n = 0; n < 2; ++n) _Pragma("unroll") for (int k = 0; k < 2; ++k) dst[n][k] = *(const PG8_LAS bf16x8*)(lds + PG8_SB(b, h) + boff + n * 2048 + k * 1024); } while (0)
#define PG8_MMA(ai, bj, At, Bt) do { __builtin_amdgcn_s_setprio(1); _Pragma("unroll") for (int m = 0; m < 4; ++m) _Pragma("unroll") for (int n = 0; n < 2; ++n) _Pragma("unroll") for (int k = 0; k < 2; ++k) \
        acc[ai][bj][m][n] = __builtin_amdgcn_mfma_f32_16x16x32_bf16(Bt[n][k], At[m][k], acc[ai][bj][m][n], 0, 0, 0); __builtin_amdgcn_s_setprio(0); } while (0)
#define PG8_WAIT_V(n) asm volatile("s_waitcnt vmcnt(" #n ")" ::: "memory")
#define PG8_WAIT_L(n) asm volatile("s_waitcnt lgkmcnt(" #n ")" ::: "memory")
#define PG8_BAR __builtin_amdgcn_s_barrier()
#define PG8_SCHED __builtin_amdgcn_sched_barrier(0)
    Unit cur, nxt; int ui = 0;
    if (!S.next(0, cur)) return;
    f32x4 acc[2][2][4][2];
#pragma unroll
    for (int a = 0; a < 2; ++a)
#pragma unroll
        for (int b = 0; b < 2; ++b)
#pragma unroll
            for (int m = 0; m < 4; ++m)
#pragma unroll
                for (int n = 0; n < 2; ++n) acc[a][b][m][n] = (f32x4){0.f, 0.f, 0.f, 0.f};
    bf16x8 At[4][2], B0[2][2], B1[2][2];
    const char* cA = (const char*)g.A + (size_t)cur.pm * tstepA; const char* cB = (const char*)g.Bt + (size_t)cur.pn * tstepB;
    S.a_ready(cur);
    if constexpr (SP2) {
        PG8_STAGE(PG8_SB(0, 0), cB, voffB); PG8_STAGE(PG8_SB(0, 1), cB + hstepB, voffB); PG8_STAGE(PG8_SA(0, 0), cA, voffA); PG8_STAGE(PG8_SA(0, 1), cA + hstepA, voffA);
        if (wr == 1) PG8_BAR;
        PG8_WAIT_V(2); PG8_BAR;
        PG8_STAGE(PG8_SB(1, 0), cB + kstep, voffB); PG8_STAGE(PG8_SA(1, 0), cA + kstep, voffA); PG8_STAGE(PG8_SB(1, 1), cB + hstepB + kstep, voffB);
        PG8_WAIT_V(6); PG8_BAR;
    } else {
        PG8_STAGE(PG8_SB(0, 0), cB, voffB); PG8_STAGE(PG8_SA(0, 0), cA, voffA); PG8_STAGE(PG8_SB(0, 1), cB + hstepB, voffB); PG8_STAGE(PG8_SA(0, 1), cA + hstepA, voffA);
        if (wr == 1) PG8_BAR;
        PG8_WAIT_V(4); PG8_BAR;
        PG8_STAGE(PG8_SB(1, 0), cB + kstep, voffB); PG8_STAGE(PG8_SA(1, 0), cA + kstep, voffA); PG8_STAGE(PG8_SB(1, 1), cB + hstepB + kstep, voffB);
        PG8_WAIT_V(6); PG8_BAR;
    }
    for (;;) {
        const bool has_next = S.next(ui + 1, nxt);
        const char* nA = has_next ? (const char*)g.A + (size_t)nxt.pm * tstepA : cA; const char* nB = has_next ? (const char*)g.Bt + (size_t)nxt.pn * tstepB : cB;

#pragma nounroll
        for (int t = 0; t < nt; t += 2) {
            const bool last = (t == nt - 2);
            const char* a1 = cA + (size_t)(t + 1) * kstep;
            const char* a2 = last ? nA : cA + (size_t)(t + 2) * kstep; const char* b2 = last ? nB : cB + (size_t)(t + 2) * kstep;
            const char* a3 = a2 + kstep; const char* b3 = b2 + kstep;
            if (last && has_next) S.a_ready(nxt);
            if constexpr (SP2) {
            PG8_LDB(B0, 0, 0); PG8_LDB(B1, 0, 1); PG8_SCHED; PG8_LDA(At, 0, 0); PG8_STAGE(PG8_SA(1, 1), a1 + hstepA, voffA);
            PG8_WAIT_V(8); PG8_WAIT_L(0); PG8_BAR; PG8_MMA(0, 0, At, B0); PG8_MMA(0, 1, At, B1); PG8_BAR; PG8_SCHED;
            PG8_LDA(At, 0, 1); PG8_STAGE(PG8_SB(0, 0), b2, voffB); PG8_STAGE(PG8_SB(0, 1), b2 + hstepB, voffB); PG8_STAGE(PG8_SA(0, 0), a2, voffA);
            PG8_WAIT_V(8); PG8_WAIT_L(0); PG8_BAR; PG8_MMA(1, 0, At, B0); PG8_MMA(1, 1, At, B1); PG8_BAR; PG8_SCHED;
            PG8_LDB(B0, 1, 0); PG8_LDB(B1, 1, 1); PG8_SCHED; PG8_LDA(At, 1, 0); PG8_STAGE(PG8_SA(0, 1), a2 + hstepA, voffA);
            PG8_WAIT_V(8); PG8_WAIT_L(0); PG8_BAR; PG8_MMA(0, 0, At, B0); PG8_MMA(0, 1, At, B1); PG8_BAR; PG8_SCHED;
            PG8_LDA(At, 1, 1); PG8_STAGE(PG8_SB(1, 0), b3, voffB); PG8_STAGE(PG8_SB(1, 1), b3 + hstepB, voffB); PG8_STAGE(PG8_SA(1, 0), a3, voffA);
            PG8_WAIT_V(8); PG8_WAIT_L(0); PG8_BAR; PG8_MMA(1, 0, At, B0); PG8_MMA(1, 1, At, B1); PG8_BAR; PG8_SCHED;
            } else {
            PG8_LDB(B0, 0, 0); PG8_SCHED; PG8_LDA(At, 0, 0); PG8_STAGE(PG8_SA(1, 1), a1 + hstepA, voffA);
            PG8_WAIT_L(8); PG8_BAR; PG8_WAIT_L(0); PG8_MMA(0, 0, At, B0); PG8_BAR; PG8_SCHED;
            PG8_LDB(B1, 0, 1); PG8_STAGE(PG8_SB(0, 0), b2, voffB);
            PG8_BAR; PG8_WAIT_L(0); PG8_MMA(0, 1, At, B1); PG8_BAR;
            PG8_LDA(At, 0, 1); PG8_STAGE(PG8_SA(0, 0), a2, voffA);
            PG8_BAR; PG8_WAIT_L(0); PG8_MMA(1, 0, At, B0); PG8_BAR; PG8_SCHED;
            PG8_STAGE(PG8_SB(0, 1), b2 + hstepB, voffB);
            PG8_WAIT_V(6); PG8_BAR; PG8_MMA(1, 1, At, B1); PG8_BAR;
            PG8_LDB(B0, 1, 0); PG8_SCHED; PG8_LDA(At, 1, 0); PG8_STAGE(PG8_SA(0, 1), a2 + hstepA, voffA);
            PG8_WAIT_L(8); PG8_BAR; PG8_WAIT_L(0); PG8_MMA(0, 0, At, B0); PG8_BAR; PG8_SCHED;
            PG8_LDB(B1, 1, 1); PG8_STAGE(PG8_SB(1, 0), b3, voffB);
            PG8_BAR; PG8_WAIT_L(0); PG8_MMA(0, 1, At, B1); PG8_BAR;
            PG8_LDA(At, 1, 1); PG8_STAGE(PG8_SA(1, 0), a3, voffA);
            PG8_BAR; PG8_WAIT_L(0); PG8_MMA(1, 0, At, B0); PG8_BAR; PG8_SCHED;
            PG8_STAGE(PG8_SB(1, 1), b3 + hstepB, voffB);
            PG8_WAIT_V(6); PG8_BAR; PG8_MMA(1, 1, At, B1); PG8_BAR;
            }
        }
        if constexpr (ALIGN_EPI) { if (wr == 0) PG8_BAR; }
        if constexpr (!Epi::AFTER_DRAIN) { E(acc, cur, wr, wc, fr, fq); S.done(cur); }
        if (!has_next) break;
#pragma unroll
        for (int a = 0; a < 2; ++a)
#pragma unroll
            for (int b = 0; b < 2; ++b)
#pragma unroll
                for (int m = 0; m < 4; ++m)
#pragma unroll
                    for (int n = 0; n < 2; ++n) acc[a][b][m][n] = (f32x4){0.f, 0.f, 0.f, 0.f};
        cur = nxt; cA = nA; cB = nB; ++ui;
        if constexpr (ALIGN_EPI) { if (wr == 1) PG8_BAR; }
    }
    PG8_WAIT_V(0);
    if constexpr (!ALIGN_EPI) { if (wr == 0) PG8_BAR; }
    PG8_BAR;
    if constexpr (Epi::AFTER_DRAIN) { E.fused(acc, cur, wr, wc, fr, fq, lds, wid, lane); S.done(cur); }
#undef PG8_SA
#undef PG8_SB
#undef PG8_STAGE
#undef PG8_LDA
#undef PG8_LDB
#undef PG8_MMA
#undef PG8_WAIT_V
#undef PG8_WAIT_L
#undef PG8_BAR
#undef PG8_SCHED
}
}
__device__ __forceinline__ unsigned long long rt() { return __builtin_amdgcn_s_memrealtime(); }
#define XB_TMO      128
#define XB_XCNT(j)  (256  + 64 * (j))
#define XB_XSUB(j)  (1280 + 64 * (j))
#define XB_XGEN(j)  (2304 + 64 * (j))
#define XB_TOP      3328
#define XB_TOPGEN   3392
#define XCD_BAR_WORDS 3456
#define XB_SPIN_CAP (1u << 22)

__device__ __forceinline__ unsigned xb_ld(unsigned* p)              { return __hip_atomic_load(p, __ATOMIC_RELAXED, __HIP_MEMORY_SCOPE_AGENT); }
__device__ __forceinline__ unsigned xb_add(unsigned* p, unsigned v) { return __hip_atomic_fetch_add(p, v, __ATOMIC_RELAXED, __HIP_MEMORY_SCOPE_AGENT); }
__device__ __forceinline__ unsigned xb_xcc_id() { return (unsigned)__builtin_amdgcn_s_getreg((3 << 11) | 20) & 0xFu; }
#define XB_SPIN(cond, bar) do { unsigned _sp = 0; while (cond) { __builtin_amdgcn_s_sleep(1); \
    if ((++_sp & 255u) == 0u) { if (xb_ld(&(bar)[XB_TMO])) break; if (_sp > XB_SPIN_CAP) { atomicAdd(&(bar)[XB_TMO], 1u); break; } } } } while (0)

struct XcdBarrier {
    unsigned* bar; unsigned x;
    volatile LAS unsigned* st;
};

__device__ __forceinline__ XcdBarrier xcd_barrier_post(unsigned* bar, volatile LAS unsigned* st) {
    XcdBarrier b; b.bar = bar; b.x = xb_xcc_id(); b.st = st;
    if (threadIdx.x == 0) (void)xb_add(&bar[XB_XCNT(b.x)], 1u);
    return b;
}
__device__ __forceinline__ void xcd_barrier_complete(unsigned* bar, unsigned x, unsigned& nloc, unsigned& nx) {
    const unsigned G = gridDim.x * gridDim.y * gridDim.z;
    unsigned sum, cnt, mine, sp = 0u;
    for (;;) {
        sum = 0u; cnt = 0u; mine = 0u;
#pragma unroll
        for (unsigned j = 0; j < 16; ++j) { const unsigned c = xb_ld(&bar[XB_XCNT(j)]); sum += c; cnt += (c > 0u) ? 1u : 0u; mine = (j == x) ? c : mine; }
        if (sum == G) break;
        __builtin_amdgcn_s_sleep(1);
        if ((++sp & 255u) == 0u) { if (xb_ld(&bar[XB_TMO])) break; if (sp > XB_SPIN_CAP) { atomicAdd(&bar[XB_TMO], 1u); break; } }
    }
    nloc = mine > 0u ? mine : 1u; nx = cnt > 0u ? cnt : 1u;
}

__device__ __forceinline__ void xcd_barrier(const XcdBarrier& b) {
    asm volatile("s_waitcnt vmcnt(0)" ::: "memory");
    __syncthreads();
    if (threadIdx.x == 0) {
        unsigned* bar = b.bar;
        __builtin_amdgcn_s_waitcnt(0);
        unsigned nloc = b.st[0], nx = b.st[1];
        if (nloc == 0u) { xcd_barrier_complete(bar, b.x, nloc, nx); b.st[0] = nloc; b.st[1] = nx; }
        const unsigned old = xb_add(&bar[XB_XSUB(b.x)], 1u);
        const unsigned gen = old / nloc;
        if (old + 1u == (gen + 1u) * nloc) {
            __builtin_amdgcn_fence(__ATOMIC_RELEASE, "agent");
            asm volatile("s_waitcnt vmcnt(0)" ::: "memory");
            const unsigned og = xb_add(&bar[XB_TOP], 1u);
            const unsigned tg = og / nx;
            if (og + 1u == (tg + 1u) * nx) xb_add(&bar[XB_TOPGEN], 1u);
            else XB_SPIN(xb_ld(&bar[XB_TOPGEN]) == tg, bar);
            __builtin_amdgcn_fence(__ATOMIC_ACQUIRE, "agent");
            xb_add(&bar[XB_XGEN(b.x)], 1u);
            asm volatile("s_waitcnt vmcnt(0)" ::: "memory");
        } else {
            XB_SPIN(xb_ld(&bar[XB_XGEN(b.x)]) == gen, bar);
            __builtin_amdgcn_fence(__ATOMIC_ACQUIRE, "agent");
            asm volatile("s_waitcnt vmcnt(0)" ::: "memory");
        }
    }
    __syncthreads();
}

struct Args {
    const float* in[24];
    float* out; unsigned char* ws;
    int ph_lo, ph_hi;
};
typedef const __attribute__((address_space(4))) Args CArgs;
enum InIdx { I_X = 0, I_C, I_CTX, I_CCTX, I_WADA, I_BADA, I_NMIXPRE, I_NMIXPOST, I_NMLPPRE, I_NMLPPOST, I_WIN, I_WOUT, I_GCONV, I_GALOG, I_GDT, I_GNORM,
             I_QNORM, I_KVNORM, I_WUQ, I_WUKV, I_LBLOG, I_HNORM, I_W1, I_W2 };

__device__ __forceinline__ const float* resid_in0(const float* x, const float* ctx, int row) {
    const int b = row / TPB, t = row - b * TPB;
    return t < CTXL ? ctx + ((size_t)b * CTXL + t) * DM : x + ((size_t)b * SEQ + (t - CTXL)) * DM;
}
__device__ __forceinline__ float* resid_ptr(float* out, float* xc, int row) {
    const int b = row / TPB, t = row - b * TPB;
    return t < CTXL ? xc + ((size_t)b * CTXL + t) * DM : out + ((size_t)b * SEQ + (t - CTXL)) * DM;
}
__device__ __forceinline__ int mod_row(int row) { const int b = row / TPB, t = row - b * TPB; return t < CTXL ? 8 : b; }

__device__ __forceinline__ void transpose_item(const float* W, int K, int ldsrc, int nsrc, bool zmap, const float* gain, bf16* WT, LAS float* scr, int item, int nblk, int lane) {
    const int kb = item / nblk, nb = item % nblk, k0 = 32 * kb, n0 = 64 * nb;
    const int np = n0 + lane; int src = zmap ? zcol_src(np) : np; if (src >= nsrc) src = -1;
#pragma unroll 8
    for (int kk = 0; kk < 32; ++kk) { float v = 0.f; if (src >= 0) { v = W[(size_t)(k0 + kk) * ldsrc + src]; if (gain) v *= gain[k0 + kk]; } scr[kk * 65 + lane] = v; }
    LDS_WAIT(); asm volatile("" ::: "memory");
    const int c = lane & 3;
#pragma unroll
    for (int j = 0; j < 4; ++j) { const int n = (lane >> 2) + 16 * j; const LAS float* s = scr + (8 * c) * 65 + n;
        v4u o; o.x = pk2(s[0 * 65], s[1 * 65]); o.y = pk2(s[2 * 65], s[3 * 65]); o.z = pk2(s[4 * 65], s[5 * 65]); o.w = pk2(s[6 * 65], s[7 * 65]);
        *(GAS v4u*)(WT + (size_t)(n0 + n) * K + k0 + 8 * c) = o; }
    LDS_WAIT(); asm volatile("" ::: "memory");
}
__device__ __forceinline__ void p0a_prologue(CArgs& a, LAS unsigned char* lds, int vcu, int G, int wave, int lane, int tid) {
    LAS float* scr = (LAS float*)(lds + wave * 8320);
    const int gw = vcu * NWAVES + wave, NGW = G * NWAVES;
    constexpr int I_IN = (DM / 32) * (ZLD / 64), I_OUT = (DM / 32) * (DM / 64), I_1 = (DM / 32) * (DFF / 64), I_2 = (DFF / 32) * (DM / 64), I_UQ = (256 / 32) * (512 / 64), I_UKV = (128 / 32) * (512 / 64);
    constexpr int PER_LAYER = I_IN + I_OUT + I_1 + I_2 + I_UQ + I_UKV;
    for (int it = gw; it < DEPTH * PER_LAYER; it += NGW) {
        const int l = it / PER_LAYER; int r = it - l * PER_LAYER;
        unsigned char* wb = a.ws + WS_W + (size_t)l * W_LAYER;
        if (r < I_IN) { transpose_item(a.in[I_WIN] + (size_t)l * DM * DIN, DM, DIN, DIN, true, nullptr, (bf16*)(wb + W_IN), scr, r, ZLD / 64, lane); continue; } r -= I_IN;
        if (r < I_OUT) { transpose_item(a.in[I_WOUT] + (size_t)l * DM * DM, DM, DM, DM, false, nullptr, (bf16*)(wb + W_OUT), scr, r, DM / 64, lane); continue; } r -= I_OUT;
        if (r < I_1) { transpose_item(a.in[I_W1] + (size_t)l * DM * DFF, DM, DFF, DFF, false, nullptr, (bf16*)(wb + W_1), scr, r, DFF / 64, lane); continue; } r -= I_1;
        if (r < I_2) { transpose_item(a.in[I_W2] + (size_t)l * DFF * DM, DFF, DM, DM, false, nullptr, (bf16*)(wb + W_2), scr, r, DM / 64, lane); continue; } r -= I_2;
        if (r < I_UQ) { transpose_item(a.in[I_WUQ] + (size_t)l * 256 * 384, 256, 384, 384, false, a.in[I_QNORM] + l * 256, (bf16*)(wb + W_UQ), scr, r, 512 / 64, lane); continue; } r -= I_UQ;
        transpose_item(a.in[I_WUKV] + (size_t)l * 128 * 512, 128, 512, 512, false, a.in[I_KVNORM] + l * 128, (bf16*)(wb + W_UKV), scr, r, 512 / 64, lane);
    }
    {
        const int gt = vcu * (NWAVES * 64) + tid, NGT = G * NWAVES * 64;
        float* rc = (float*)(a.ws + WS_ROPE); float* rs = rc + SEQ * 16;
        for (int i = gt; i < SEQ * 16; i += NGT) { const int t = i >> 4, j = i & 15, f = j & 7;
            const float inv = exp2f(-(float)f * 0.125f * 13.287712379549449f);
            const float pos = (float)(j < 8 ? (t >> 6) : (t & 63)); const float ang = pos * inv;
            rc[i] = cosf(ang); rs[i] = sinf(ang); }
        float* lb = (float*)(a.ws + WS_LB);
        for (int i = gt; i < 2 * 1024; i += NGT) { const int l = i >> 10, j = i & 1023;
            const float l0 = a.in[I_LBLOG][j], l1 = a.in[I_LBLOG][1024 + j];
            lb[i] = l == 0 ? 0.f : 1.0f / (1.0f + expf(l0 - l1)); }
    }
    if (wave == 0 && vcu < 192) {
        LAS float* sc = (LAS float*)(lds + 69632);
        for (int i = lane; i < 9 * 1024; i += 64) { const int r = i >> 10, k = i & 1023; const float v = r < 8 ? a.in[I_C][r * 1024 + k] : a.in[I_CCTX][k]; sc[i] = siluf_(v); }
        LDS_WAIT(); asm volatile("" ::: "memory");
        const int l = vcu / 96, n = (vcu % 96) * 64 + lane;
        const float* w = a.in[I_WADA] + (size_t)l * DM * 6 * DM + n;
        float acc[9];
#pragma unroll
        for (int r = 0; r < 9; ++r) acc[r] = 0.f;
#pragma unroll 8
        for (int k = 0; k < DM; ++k) { const float wv = w[(size_t)k * 6 * DM];
#pragma unroll
            for (int r = 0; r < 9; ++r) acc[r] += sc[r * 1024 + k] * wv; }
        const float bv = a.in[I_BADA][l * 6 * DM + n];
        float* mods = (float*)(a.ws + WS_MODS) + (size_t)l * 9 * 6 * DM;
#pragma unroll
        for (int r = 0; r < 9; ++r) mods[(size_t)r * 6 * DM + n] = acc[r] + bv;
    }
}

__device__ __forceinline__ void norm_mod_store(const f32x4 (&v)[4], const float* gain, const float* sh, const float* sc, bf16* orow, int lane) {
    float ss = 0.f;
#pragma unroll
    for (int j = 0; j < 4; ++j) ss += (v[j].x * v[j].x + v[j].y * v[j].y) + (v[j].z * v[j].z + v[j].w * v[j].w);
    const float rstd = rsqrtf(wave_sum(ss) * (1.f / DM) + EPS);
    GAS v2u* o8 = (GAS v2u*)orow + lane;
#pragma unroll
    for (int j = 0; j < 4; ++j) { const int c = 4 * lane + 256 * j;
        const f32x4 g = *(const f32x4*)(gain + c), s1 = *(const f32x4*)(sh + c), s2 = *(const f32x4*)(sc + c);
        f32x4 h; h.x = v[j].x * rstd * g.x * (1.f + s2.x) + s1.x; h.y = v[j].y * rstd * g.y * (1.f + s2.y) + s1.y; h.z = v[j].z * rstd * g.z * (1.f + s2.z) + s1.z; h.w = v[j].w * rstd * g.w * (1.f + s2.w) + s1.w;
        v2u w; w.x = pk2(h.x, h.y); w.y = pk2(h.z, h.w); o8[64 * j] = w; }
}
__device__ __forceinline__ void p0b_prenorm(CArgs& a, int gw, int NGW, int lane) {
    const float* mods = (const float*)(a.ws + WS_MODS);
    bf16* HB = (bf16*)(a.ws + WS_HB);
    for (int row = gw; row < MT; row += NGW) {
        const GAS f32x4* xr = (const GAS f32x4*)resid_in0(a.in[I_X], a.in[I_CTX], row) + lane;
        f32x4 v[4];
#pragma unroll
        for (int j = 0; j < 4; ++j) v[j] = xr[64 * j];
        const float* m = mods + (size_t)mod_row(row) * 6 * DM;
        norm_mod_store(v, a.in[I_NMIXPRE], m, m + DM, HB + (size_t)row * DM, lane);
    }
}
__device__ __forceinline__ void post_pass(CArgs& a, int layer, int which, int gw, int NGW, int lane) {
    const float* mods = (const float*)(a.ws + WS_MODS) + (size_t)layer * 9 * 6 * DM;
    bf16* HB = (bf16*)(a.ws + WS_HB); float* xc = (float*)(a.ws + WS_XC);
    const float* gpost = (which == 0 ? a.in[I_NMIXPOST] : a.in[I_NMLPPOST]) + layer * DM;
    const bool has_next = (which == 0) || (layer + 1 < DEPTH);
    const float* gnext = which == 0 ? a.in[I_NMLPPRE] + layer * DM : a.in[I_NMIXPRE] + (layer + 1) * DM;
    for (int row = gw; row < MT; row += NGW) {
        const int mr = mod_row(row);
        if (layer == DEPTH - 1 && mr == 8) continue;
        const float* m = mods + (size_t)mr * 6 * DM;
        const float* gate = m + (which == 0 ? 2 : 5) * DM;
        const GAS v2u* yr = (const GAS v2u*)(HB + (size_t)row * DM) + lane;
        const float* xin = (layer == 0 && which == 0) ? resid_in0(a.in[I_X], a.in[I_CTX], row) : resid_ptr(a.out, xc, row);
        float* xout = resid_ptr(a.out, xc, row);
        f32x4 y[4], x[4]; float ss = 0.f;
#pragma unroll
        for (int j = 0; j < 4; ++j) { const v2u w = yr[64 * j]; y[j] = (f32x4){bflo(w.x), bfhi(w.x), bflo(w.y), bfhi(w.y)}; x[j] = *((const GAS f32x4*)xin + lane + 64 * j);
            ss += (y[j].x * y[j].x + y[j].y * y[j].y) + (y[j].z * y[j].z + y[j].w * y[j].w); }
        const float rstd = rsqrtf(wave_sum(ss) * (1.f / DM) + EPS);
#pragma unroll
        for (int j = 0; j < 4; ++j) { const int c = 4 * lane + 256 * j; const f32x4 gp = *(const f32x4*)(gpost + c), gt = *(const f32x4*)(gate + c);
            x[j].x += gt.x * (y[j].x * rstd * gp.x); x[j].y += gt.y * (y[j].y * rstd * gp.y); x[j].z += gt.z * (y[j].z * rstd * gp.z); x[j].w += gt.w * (y[j].w * rstd * gp.w);
            *((GAS f32x4*)xout + lane + 64 * j) = x[j]; }
        if (has_next) {
            const float* mn = which == 0 ? m : (const float*)(a.ws + WS_MODS) + ((size_t)(layer + 1) * 9 + mr) * 6 * DM;
            const float* sh = mn + (which == 0 ? 3 : 0) * DM; const float* sc = mn + (which == 0 ? 4 : 1) * DM;
            norm_mod_store(x, gnext, sh, sc, HB + (size_t)row * DM, lane);
        }
    }
}
__device__ __forceinline__ void mla_rope_pass(CArgs& a, LAS unsigned char* lds, int wave, int gw, int NGW, int lane) {
    bf16* HB = (bf16*)(a.ws + WS_HB); const bf16* Z = (const bf16*)(a.ws + WS_Z);
    const float* rc = (const float*)(a.ws + WS_ROPE); const float* rs = rc + SEQ * 16;
    LAS bf16* raw = (LAS bf16*)(lds + wave * 2304);
    for (int row = gw; row < MT; row += NGW) {
        const int b = row / TPB, t = row - b * TPB; const bool lat = t >= CTXL; const int tp = t - CTXL;
        const GAS v4u* hr = (const GAS v4u*)(HB + (size_t)row * DM);
        const v4u r0 = hr[lane], r1 = hr[64 + lane];
        const bf16* zr = Z + (size_t)row * ZLD;
        const v2u cq = *((const GAS v2u*)(zr + ZC_CQ) + lane); const unsigned ckv = *((const GAS unsigned*)(zr + ZC_CKV) + lane);
        float s1 = bflo(cq.x) * bflo(cq.x) + bfhi(cq.x) * bfhi(cq.x) + bflo(cq.y) * bflo(cq.y) + bfhi(cq.y) * bfhi(cq.y);
        float s2 = bflo(ckv) * bflo(ckv) + bfhi(ckv) * bfhi(ckv);
        const float sq = rsqrtf(wave_sum(s1) * (1.f / 256.f) + EPS) * ATT_C2, skv = rsqrtf(wave_sum(s2) * (1.f / 128.f) + EPS);
        *((LAS v4u*)raw + lane) = r0; *((LAS v4u*)raw + 64 + lane) = r1;
        if (lane < 16) *((LAS unsigned*)(raw + 1024) + lane) = *((const GAS unsigned*)(zr + ZC_KR) + lane);
        VM_WAIT(); LDS_WAIT(); asm volatile("" ::: "memory");
        unsigned ow[8];
#pragma unroll
        for (int e2 = 0; e2 < 8; ++e2) { float o2[2];
#pragma unroll
            for (int q = 0; q < 2; ++q) { const int c = lane * 16 + e2 * 2 + q; float val;
                if (c < 384) { const int h = c / 96, d = c - h * 96;
                    if (d < 64 || !lat) val = bf2f(raw[c]) * sq;
                    else { const int i = (d - 64) & 15, hf = (d - 64) >> 4; const float t1 = bf2f(raw[h * 96 + 64 + i]), t2 = bf2f(raw[h * 96 + 80 + i]), cs = rc[tp * 16 + i], sn = rs[tp * 16 + i];
                           val = (hf == 0 ? t1 * cs - t2 * sn : t1 * sn + t2 * cs) * sq; } }
                else if (c < 768) { const int cc = c - 384, h = cc / 96, d = cc - h * 96;
                    if (d < 64) val = bf2f(raw[512 + h * 128 + d]) * skv;
                    else if (!lat) val = bf2f(raw[1024 + d - 64]);
                    else { const int i = (d - 64) & 15, hf = (d - 64) >> 4; const float t1 = bf2f(raw[1024 + i]), t2 = bf2f(raw[1040 + i]), cs = rc[tp * 16 + i], sn = rs[tp * 16 + i];
                           val = hf == 0 ? t1 * cs - t2 * sn : t1 * sn + t2 * cs; } }
                else { const int cc = c - 768, h = cc >> 6, dv = cc & 63; val = bf2f(raw[512 + h * 128 + 64 + dv]) * skv; }
                o2[q] = val; }
            ow[e2] = pk2(o2[0], o2[1]); }
        GAS v4u* orow = (GAS v4u*)(HB + (size_t)row * DM) + 2 * lane;
        orow[0] = (v4u){ow[0], ow[1], ow[2], ow[3]}; orow[1] = (v4u){ow[4], ow[5], ow[6], ow[7]};
        LDS_WAIT(); asm volatile("" ::: "memory");
    }
}

namespace att {
constexpr int KT_BYTES = 12288, VT_BYTES = 8192, SLOT = KT_BYTES + VT_BYTES, WS_OFF = 2 * SLOT;
__device__ __forceinline__ int crow(int r, int hi) { return (r & 3) + 8 * (r >> 2) + 4 * hi; }
#define ATT_WAIT_BAR() asm volatile("s_waitcnt vmcnt(0) lgkmcnt(0)\n\ts_barrier" ::: "memory")
__device__ __forceinline__ float rowmax32(const f32x16& p0, const f32x16& p1) {
    float m = fmaxf(p0[0], p1[0]);
#pragma unroll
    for (int r = 1; r < 16; ++r) m = fmaxf(m, fmaxf(p0[r], p1[r]));
    return fmaxf(m, __shfl_xor(m, 32));
}
__device__ __forceinline__ unsigned cvtpk(float lo, float hi) { unsigned r; asm volatile("v_cvt_pk_bf16_f32 %0, %1, %2" : "=v"(r) : "v"(lo), "v"(hi)); return r; }
__device__ __forceinline__ void att_dma(const bf16* HB, LAS unsigned char* lds, int rowb, int h, int t, int slot, int wid, int lane) {
    const bf16* kv = HB + (size_t)(rowb + 64 * t) * DM;
#pragma unroll
    for (int i = 0; i < 3; ++i) { const int p = wid + 8 * i;
        if (p < 12) __builtin_amdgcn_global_load_lds((const unsigned*)(kv + (size_t)lane * DM + HB_K + h * 96 + p * 8), (LAS unsigned*)(lds + slot * SLOT + p * 1024), 16, 0, 0);
        else if (p < 20) { const int pv_ = p - 12, dh = pv_ >> 2, rg = pv_ & 3;
            __builtin_amdgcn_global_load_lds((const unsigned*)(kv + (size_t)(16 * rg + (lane >> 2)) * DM + HB_V + h * 64 + dh * 32 + (lane & 3) * 8), (LAS unsigned*)(lds + slot * SLOT + KT_BYTES + pv_ * 1024), 16, 0, 0); } }
}
__device__ __forceinline__ void attn_unit(int b, int h, int qb, const bf16* HB, bf16* Z, LAS unsigned char* lds) {
    int tid_ = threadIdx.x; asm volatile("" : "+v"(tid_)); const int tid = tid_, lane = tid & 63, r32 = lane & 31, hi = lane >> 5; const int wid = __builtin_amdgcn_readfirstlane(tid >> 6);
    const int rowb = b * TPB; const int row0 = rowb + 256 * qb + 32 * wid;
    const int NT = qb == 0 ? CTXL / 64 : TPB / 64;
    LAS float* wsf = (LAS float*)(lds + WS_OFF + wid * 256);
    const unsigned lds0 = (unsigned)(uintptr_t)lds;
    att_dma(HB, lds, rowb, h, 0, 0, wid, lane);
    bf16x8 qr[6];
#pragma unroll
    for (int d0 = 0; d0 < 6; ++d0) qr[d0] = *(const bf16x8*)(HB + (size_t)(row0 + r32) * DM + HB_Q + h * 96 + d0 * 16 + hi * 8);
    float mref = -1e30f, lsum = 0.f; f32x16 o[2]; o[0] = f32x16{}; o[1] = f32x16{};
    ATT_WAIT_BAR();
    for (int t = 0; t < NT; ++t) {
        const int slot = t & 1;
        if (t + 1 < NT) att_dma(HB, lds, rowb, h, t + 1, slot ^ 1, wid, lane);
        f32x16 p0 = f32x16{}, p1 = f32x16{};
        { const LAS unsigned char* kb = lds + slot * SLOT + hi * 1024 + r32 * 16;
#pragma unroll
          for (int d0 = 0; d0 < 6; ++d0) { const bf16x8 k0 = *(const LAS bf16x8*)(kb + d0 * 2048), k1 = *(const LAS bf16x8*)(kb + d0 * 2048 + 512);
              p0 = __builtin_amdgcn_mfma_f32_32x32x16_bf16(k0, qr[d0], p0, 0, 0, 0); p1 = __builtin_amdgcn_mfma_f32_32x32x16_bf16(k1, qr[d0], p1, 0, 0, 0); } }
        const float rm = rowmax32(p0, p1);
        if (__any(rm > mref + 8.0f)) {
            const float mn = fmaxf(mref, rm), al = __builtin_amdgcn_exp2f(mref - mn); mref = mn; lsum *= al;
            if (hi == 0) wsf[r32] = al;
            LDS_WAIT(); asm volatile("" ::: "memory");
#pragma unroll
            for (int r = 0; r < 16; ++r) { const float f = wsf[crow(r, hi)]; o[0][r] *= f; o[1][r] *= f; }
            LDS_WAIT(); asm volatile("" ::: "memory");
        }
        float sacc = 0.f;
#pragma unroll
        for (int r = 0; r < 16; ++r) { p0[r] = __builtin_amdgcn_exp2f(p0[r] - mref); p1[r] = __builtin_amdgcn_exp2f(p1[r] - mref); sacc += p0[r] + p1[r]; }
        lsum += sacc;
        v4u pw[4];
#pragma unroll
        for (int k = 0; k < 2; ++k) { pw[k] = (v4u){cvtpk(p0[8 * k], p0[8 * k + 1]), cvtpk(p0[8 * k + 2], p0[8 * k + 3]), cvtpk(p0[8 * k + 4], p0[8 * k + 5]), cvtpk(p0[8 * k + 6], p0[8 * k + 7])};
            pw[2 + k] = (v4u){cvtpk(p1[8 * k], p1[8 * k + 1]), cvtpk(p1[8 * k + 2], p1[8 * k + 3]), cvtpk(p1[8 * k + 4], p1[8 * k + 5]), cvtpk(p1[8 * k + 6], p1[8 * k + 7])}; }
        { const int vb = (int)(lds0 + slot * SLOT + KT_BYTES) + ((lane >> 4) & 1) * 32 + (lane & 3) * 8 + (4 * hi + ((lane & 15) >> 2)) * 64;
#pragma unroll
          for (int d0 = 0; d0 < 2; ++d0) { s16x4 lo[4], hh[4];
#pragma unroll
              for (int ks = 0; ks < 4; ++ks) {
                  asm volatile("ds_read_b64_tr_b16 %0,%1 offset:%c2" : "=&v"(lo[ks]) : "v"(vb), "i"(d0 * 4096 + ks * 1024) : "memory");
                  asm volatile("ds_read_b64_tr_b16 %0,%1 offset:%c2" : "=&v"(hh[ks]) : "v"(vb), "i"(d0 * 4096 + ks * 1024 + 512) : "memory"); }
              asm volatile("s_waitcnt lgkmcnt(0)" ::: "memory"); __builtin_amdgcn_sched_barrier(0);
#pragma unroll
              for (int ks = 0; ks < 4; ++ks) { const bf16x8 vf = (bf16x8){lo[ks][0], lo[ks][1], lo[ks][2], lo[ks][3], hh[ks][0], hh[ks][1], hh[ks][2], hh[ks][3]};
                  o[d0] = __builtin_amdgcn_mfma_f32_32x32x16_bf16(__builtin_bit_cast(bf16x8, pw[ks]), vf, o[d0], 0, 0, 0); } } }
        ATT_WAIT_BAR();
    }
    lsum += __shfl_xor(lsum, 32);
    if (hi == 0) wsf[32 + r32] = lsum;
    LDS_WAIT(); asm volatile("" ::: "memory");
#pragma unroll
    for (int r = 0; r < 16; ++r) { const int q = crow(r, hi); const float inv = 1.0f / wsf[32 + q];
        bf16* op = Z + (size_t)(row0 + q) * ZLD + ZC_CQ + h * 64 + r32;
        op[0] = (bf16)f2bf(o[0][r] * inv); op[32] = (bf16)f2bf(o[1][r] * inv); }
    ATT_WAIT_BAR();
}
}

__device__ __forceinline__ float softplusf_(float x) { return x > 20.f ? x : log1pf(__expf(x)); }
__device__ __forceinline__ int chunk32_t0(int step, int dir, int& lo, int& hi) {
    if (step < 8) { lo = 0; hi = CTXL; return 32 * (dir ? 7 - step : step); }
    lo = CTXL; hi = TPB; return CTXL + 32 * (dir ? 127 - (step - 8) : step - 8);
}
namespace gdn0 {
constexpr int RAW_OFF = 0, QF_OFF = 28672, KF_OFF = QF_OFF + 16384, VF_OFF = KF_OFF + 16384, CW_OFF = 77824, RED_OFF = 86016, RED2_OFF = 90112, OSUM_OFF = 94208, SCA_OFF = 110592;
__device__ __forceinline__ void chain(CArgs& a, LAS unsigned char* lds, int layer, int b, int h) {
    int tid_ = threadIdx.x; asm volatile("" : "+v"(tid_)); const int tid = tid_, lane = tid & 63, wave = tid >> 6;
    bf16* Z = (bf16*)(a.ws + WS_Z); bf16* OS = (bf16*)(a.ws + WS_OSG);
    LAS bf16* RAW = (LAS bf16*)(lds + RAW_OFF); LAS float* QF = (LAS float*)(lds + QF_OFF); LAS float* KF = (LAS float*)(lds + KF_OFF); LAS float* VF = (LAS float*)(lds + VF_OFF);
    LAS float* CW = (LAS float*)(lds + CW_OFF); LAS float* RED = (LAS float*)(lds + RED_OFF); LAS float* RED2 = (LAS float*)(lds + RED2_OFF); LAS float* OSUM = (LAS float*)(lds + OSUM_OFF);
    LAS float* BETA = (LAS float*)(lds + SCA_OFF); LAS float* AV = BETA + 32;
    __syncthreads();
    for (int i = tid; i < 5 * 384; i += 512) { const int j = i / 384, c = i - j * 384; CW[i] = a.in[I_GCONV][(size_t)layer * 5 * 1536 + j * 1536 + (c >> 7) * 512 + h * 128 + (c & 127)]; }
    const float* gn = a.in[I_GNORM] + layer * 128;
    const int e = tid & 127, dg = tid >> 7; const size_t rowb = (size_t)b * TPB;
    for (int dir = 0; dir < 2; ++dir) {
        float S[32];
#pragma unroll
        for (int j = 0; j < 32; ++j) S[j] = 0.f;
        const float A_ = expf(a.in[I_GALOG][layer * 8 + dir * 4 + h]), dtb = a.in[I_GDT][layer * 8 + dir * 4 + h];
        for (int step = 0; step < 136; ++step) {
            int lo, hi; const int t0 = chunk32_t0(step, dir, lo, hi);
            __syncthreads();
            for (int idx = tid; idx < 36 * 48; idx += 512) { const int rr = idx / 48, ch = idx - rr * 48, t = t0 - 2 + rr; v4u v = (v4u){0u, 0u, 0u, 0u};
                if (t >= lo && t < hi) v = *(const GAS v4u*)(Z + (rowb + t) * ZLD + (ch >> 4) * 512 + h * 128 + (ch & 15) * 8);
                *(LAS v4u*)(RAW + rr * 384 + ch * 8) = v; }
            if (tid < 32) { const bf16* zr = Z + (rowb + t0 + tid) * ZLD; const float zb = bf2f(zr[ZC_GB + dir * 4 + h]), za = bf2f(zr[ZC_GA + dir * 4 + h]);
                BETA[tid] = sigmoidf_(zb); AV[tid] = __expf(-A_ * softplusf_(za + dtb)); }
            __syncthreads();
            for (int idx = tid; idx < 32 * 384; idx += 512) { const int i = idx / 384, c = idx - i * 384; float acc = 0.f;
#pragma unroll
                for (int j = 0; j < 5; ++j) acc += CW[j * 384 + c] * bf2f(RAW[(i + j) * 384 + c]);
                const float y = siluf_(acc); LAS float* dst = c < 128 ? QF : (c < 256 ? KF : VF); dst[i * 128 + (c & 127)] = y; }
            __syncthreads();
            for (int pp = 0; pp < 8; ++pp) { const int p = wave * 8 + pp, tok = p >> 1, which = p & 1; LAS float* ptr = (which ? KF : QF) + tok * 128;
                const float x0 = ptr[lane], x1 = ptr[lane + 64]; const float sc = rsqrtf(wave_sum(x0 * x0 + x1 * x1) + 1e-6f) * (which ? 1.0f : 0.08838834764831845f);
                ptr[lane] = x0 * sc; ptr[lane + 64] = x1 * sc; }
            __syncthreads();
            for (int ii = 0; ii < 32; ++ii) {
                const int i = dir ? 31 - ii : ii, p = ii & 1;
                const LAS f32x4* kr = (const LAS f32x4*)(KF + i * 128 + dg * 32); const LAS f32x4* qr = (const LAS f32x4*)(QF + i * 128 + dg * 32);
                float kk[32]; float part = 0.f;
#pragma unroll
                for (int j = 0; j < 8; ++j) { const f32x4 v = kr[j]; kk[4 * j] = v.x; kk[4 * j + 1] = v.y; kk[4 * j + 2] = v.z; kk[4 * j + 3] = v.w; }
#pragma unroll
                for (int j = 0; j < 32; ++j) part += kk[j] * S[j];
                RED[p * 512 + dg * 128 + e] = part;
                __syncthreads();
                if (ii > 0 && dg == 0) { const int ip = dir ? 32 - ii : ii - 1; const LAS float* r2 = RED2 + (p ^ 1) * 512 + e; const float o = (r2[0] + r2[128]) + (r2[256] + r2[384]);
                    const size_t oi = (rowb + t0 + ip) * 512 + h * 128 + e;
                    if (dir == 0) OS[oi] = (bf16)f2bf(o); else OSUM[ip * 128 + e] = o + bf2f(OS[oi]); }
                const LAS float* r1 = RED + p * 512 + e; const float kS = (r1[0] + r1[128]) + (r1[256] + r1[384]);
                const float av = AV[i], delta = BETA[i] * (VF[i * 128 + e] - av * kS);
                float opart = 0.f;
#pragma unroll
                for (int j = 0; j < 8; ++j) { const f32x4 q4 = qr[j];
                    S[4 * j] = av * S[4 * j] + kk[4 * j] * delta; S[4 * j + 1] = av * S[4 * j + 1] + kk[4 * j + 1] * delta; S[4 * j + 2] = av * S[4 * j + 2] + kk[4 * j + 2] * delta; S[4 * j + 3] = av * S[4 * j + 3] + kk[4 * j + 3] * delta;
                    opart += (q4.x * S[4 * j] + q4.y * S[4 * j + 1]) + (q4.z * S[4 * j + 2] + q4.w * S[4 * j + 3]); }
                RED2[p * 512 + dg * 128 + e] = opart;
            }
            __syncthreads();
            if (dg == 0) { const int ip = dir ? 0 : 31; const LAS float* r2 = RED2 + 1 * 512 + e; const float o = (r2[0] + r2[128]) + (r2[256] + r2[384]);
                const size_t oi = (rowb + t0 + ip) * 512 + h * 128 + e;
                if (dir == 0) OS[oi] = (bf16)f2bf(o); else OSUM[ip * 128 + e] = o + bf2f(OS[oi]); }
            if (dir == 1) {
                __syncthreads();
                for (int tt = 0; tt < 4; ++tt) { const int tok = wave * 4 + tt; const float x0 = OSUM[tok * 128 + lane], x1 = OSUM[tok * 128 + lane + 64];
                    const float rs = rsqrtf(wave_sum(x0 * x0 + x1 * x1) * (1.f / 128.f) + EPS);
                    bf16* zg = Z + (rowb + t0 + tok) * ZLD + ZC_GG + h * 128;
                    const float g0 = bf2f(zg[lane]), g1 = bf2f(zg[lane + 64]);
                    zg[lane] = (bf16)f2bf(x0 * rs * gn[lane] * siluf_(g0)); zg[lane + 64] = (bf16)f2bf(x1 * rs * gn[lane + 64] * siluf_(g1)); }
            }
        }
    }
}
}
namespace hg0 {
constexpr int QF_OFF = 0, FF_OFF = 16384, KF_OFF = 32768, VF_OFF = 49152, RED_OFF = 57344, OSUM_OFF = 61440;
__device__ __forceinline__ void chain(CArgs& a, LAS unsigned char* lds, int layer, int b, int h) {
    int tid_ = threadIdx.x; asm volatile("" : "+v"(tid_)); const int tid = tid_, lane = tid & 63, wave = tid >> 6;
    bf16* Z = (bf16*)(a.ws + WS_Z); bf16* OS = (bf16*)(a.ws + WS_OSH); const float* LB = (const float*)(a.ws + WS_LB);
    LAS float* QF = (LAS float*)(lds + QF_OFF); LAS float* FF = (LAS float*)(lds + FF_OFF); LAS float* KF = (LAS float*)(lds + KF_OFF); LAS float* VF = (LAS float*)(lds + VF_OFF);
    LAS float* RED = (LAS float*)(lds + RED_OFF); LAS float* OSUM = (LAS float*)(lds + OSUM_OFF);
    const float* hn = a.in[I_HNORM] + layer * 64;
    const int e = tid & 63, dg = tid >> 6; const size_t rowb = (size_t)b * TPB;
    for (int dir = 0; dir < 2; ++dir) {
        float S[16];
#pragma unroll
        for (int j = 0; j < 16; ++j) S[j] = 0.f;
        const int zf = dir ? ZC_HFB : ZC_HFF;
        for (int step = 0; step < 136; ++step) {
            int lo, hi; const int t0 = chunk32_t0(step, dir, lo, hi);
            __syncthreads();
            for (int idx = tid; idx < 32 * 128; idx += 512) { const int i = idx >> 7, d = idx & 127; const bf16* zr = Z + (rowb + t0 + i) * ZLD;
                const float xq = bf2f(zr[ZC_HQ + h * 128 + d]), xf = bf2f(zr[zf + h * 128 + d]), lbv = LB[layer * 1024 + dir * 512 + h * 128 + d];
                const float sg = 1.0f / (1.0f + __expf(-xf)), sgn = 1.0f / (1.0f + __expf(xf));
                QF[idx] = xq * 0.08838834764831845f; FF[idx] = lbv + (1.0f - lbv) * sg; KF[idx] = (1.0f - lbv) * sgn; }
            for (int idx = tid; idx < 32 * 64; idx += 512) { const int i = idx >> 6; VF[idx] = bf2f(Z[(rowb + t0 + i) * ZLD + ZC_HI + h * 64 + (idx & 63)]); }
            __syncthreads();
            for (int ii = 0; ii < 32; ++ii) {
                const int i = dir ? 31 - ii : ii, p = ii & 1;
                const LAS f32x4* fr = (const LAS f32x4*)(FF + i * 128 + dg * 16); const LAS f32x4* kr = (const LAS f32x4*)(KF + i * 128 + dg * 16); const LAS f32x4* qr = (const LAS f32x4*)(QF + i * 128 + dg * 16);
                const float v = VF[i * 64 + e]; float opart = 0.f;
#pragma unroll
                for (int j = 0; j < 4; ++j) { const f32x4 f4 = fr[j], k4 = kr[j], q4 = qr[j];
                    S[4 * j] = f4.x * S[4 * j] + k4.x * v; S[4 * j + 1] = f4.y * S[4 * j + 1] + k4.y * v; S[4 * j + 2] = f4.z * S[4 * j + 2] + k4.z * v; S[4 * j + 3] = f4.w * S[4 * j + 3] + k4.w * v;
                    opart += (q4.x * S[4 * j] + q4.y * S[4 * j + 1]) + (q4.z * S[4 * j + 2] + q4.w * S[4 * j + 3]); }
                RED[p * 512 + dg * 64 + e] = opart;
                __syncthreads();
                if (dg == 0) { const LAS float* r = RED + p * 512 + e; const float o = ((r[0] + r[64]) + (r[128] + r[192])) + ((r[256] + r[320]) + (r[384] + r[448]));
                    const size_t oi = (rowb + t0 + i) * 256 + h * 64 + e;
                    if (dir == 0) OS[oi] = (bf16)f2bf(o); else OSUM[i * 64 + e] = o + bf2f(OS[oi]); }
            }
            if (dir == 1) {
                __syncthreads();
                for (int tt = 0; tt < 4; ++tt) { const int tok = wave * 4 + tt; const float x = OSUM[tok * 64 + lane];
                    const float rs = rsqrtf(wave_sum(x * x) * (1.f / 64.f) + EPS);
                    bf16* zg = Z + (rowb + t0 + tok) * ZLD + ZC_HG + h * 64;
                    const float g = bf2f(zg[lane]);
                    zg[lane] = (bf16)f2bf(x * rs * hn[lane] * siluf_(g)); }
            }
        }
    }
}
}

constexpr int NCHUNK = MT / 64;
__device__ __forceinline__ void gdn_halo_copy(CArgs& a, int gw, int NGW, int lane) {
    const bf16* Z = (const bf16*)(a.ws + WS_Z); bf16* HL = (bf16*)(a.ws + WS_HALO);
    for (int it = gw; it < NCHUNK * 4; it += NGW) {
        const int cg = it >> 2, slot = it & 3, b = cg / 68, c = cg - b * 68;
        const int lo = c < 4 ? 0 : CTXL, hi = c < 4 ? CTXL : TPB;
        const int t = 64 * c + (slot < 2 ? slot - 2 : 62 + slot);
        const bool ok = t >= lo && t < hi;
        const GAS v4u* src = (const GAS v4u*)(Z + ((size_t)b * TPB + (ok ? t : 64 * c)) * ZLD);
        GAS v4u* dst = (GAS v4u*)(HL + (size_t)it * 1536);
#pragma unroll
        for (int j = 0; j < 3; ++j) { v4u v = src[lane + 64 * j]; if (!ok) v = (v4u){0u, 0u, 0u, 0u}; dst[lane + 64 * j] = v; }
    }
}
__device__ __forceinline__ void gdn_conv_pass(CArgs& a, LAS unsigned char* lds, int layer, int vcu, int G) {
    int tid_ = threadIdx.x; asm volatile("" : "+v"(tid_)); const int tid = tid_, lane = tid & 63, wave = tid >> 6;
    bf16* Z = (bf16*)(a.ws + WS_Z); const bf16* HL = (const bf16*)(a.ws + WS_HALO); float* BG = (float*)(a.ws + WS_BG);
    LAS bf16* RAW = (LAS bf16*)lds;
    for (int u = vcu; u < NCHUNK * 4; u += G) {
        const int cg = u >> 2, h = u & 3; const size_t row0 = (size_t)cg * 64;
        __syncthreads();
        for (int idx = tid; idx < 68 * 48; idx += 512) { const int rr = idx / 48, ch = idx - rr * 48; const int colz = (ch >> 4) * 512 + h * 128 + (ch & 15) * 8;
            const bf16* src = (rr >= 2 && rr < 66) ? Z + (row0 + rr - 2) * ZLD + colz : HL + ((size_t)cg * 4 + (rr < 2 ? rr : rr - 64)) * 1536 + colz;
            *(LAS v4u*)(RAW + rr * 384 + ch * 8) = *(const GAS v4u*)src; }
        if (tid < 128) { const int i = tid & 63, dir = tid >> 6; const bf16* zr = Z + (row0 + i) * ZLD;
            const float zb = bf2f(zr[ZC_GB + dir * 4 + h]), za = bf2f(zr[ZC_GA + dir * 4 + h]);
            const float A_ = expf(a.in[I_GALOG][layer * 8 + dir * 4 + h]), dtb = a.in[I_GDT][layer * 8 + dir * 4 + h];
            float* o = BG + ((row0 + i) * 4 + h) * 4 + dir * 2; o[0] = sigmoidf_(zb); o[1] = -A_ * softplusf_(za + dtb); }
        float cw[5][6];
#pragma unroll
        for (int j = 0; j < 5; ++j)
#pragma unroll
            for (int m = 0; m < 6; ++m) cw[j][m] = a.in[I_GCONV][(size_t)layer * 5 * 1536 + j * 1536 + (m >> 1) * 512 + h * 128 + (m & 1) * 64 + lane];
        __syncthreads();
        for (int i = wave; i < 64; i += 8) {
            float y[6];
#pragma unroll
            for (int m = 0; m < 6; ++m) { float acc = 0.f;
#pragma unroll
                for (int j = 0; j < 5; ++j) acc += cw[j][m] * bf2f(RAW[(i + j) * 384 + m * 64 + lane]);
                y[m] = siluf_(acc); }
            const float sq = rsqrtf(wave_sum(y[0] * y[0] + y[1] * y[1]) + 1e-6f) * 0.08838834764831845f, sk = rsqrtf(wave_sum(y[2] * y[2] + y[3] * y[3]) + 1e-6f);
            bf16* zr = Z + (row0 + i) * ZLD + h * 128 + lane;
            zr[ZC_GQ] = (bf16)f2bf(y[0] * sq); zr[ZC_GQ + 64] = (bf16)f2bf(y[1] * sq); zr[ZC_GK] = (bf16)f2bf(y[2] * sk); zr[ZC_GK + 64] = (bf16)f2bf(y[3] * sk);
            zr[ZC_GV] = (bf16)f2bf(y[4]); zr[ZC_GV + 64] = (bf16)f2bf(y[5]); }
    }
}

namespace gdn1 {
typedef short v4i16 __attribute__((ext_vector_type(4)));
constexpr int LD = 136, LDT = 72;
constexpr int KB_OFF = 0, QB_OFF = 17408, VB_OFF = 34816, SB_OFF = 52224, WB_OFF = 87040, TB_OFF = 104448, AQ_OFF = 113664, LB_OFF = 122880, LDG_OFF = 132096  ,
              XS_OFF = 136448  , YS_OFF = 137984  , SC_OFF = 140544  , SS_OFF = 141888  , END_OFF = 142912;
__device__ __forceinline__ int crow(int r, int hi) { return (r & 3) + 8 * (r >> 2) + 4 * hi; }
__device__ __forceinline__ s16x4 trr(const LAS bf16* p) { return __builtin_bit_cast(s16x4, __builtin_amdgcn_ds_read_tr16_b64_v4i16((LAS v4i16*)p)); }
__device__ __forceinline__ bf16x8 frag_rk(const LAS bf16* base, int ld, int row0, int k0, int lane) { return *(const LAS bf16x8*)(base + (row0 + (lane & 31)) * ld + k0 + 8 * (lane >> 5)); }
__device__ __forceinline__ bf16x8 frag_kr(const LAS bf16* base, int ld, int k0, int x0, int lane) {
    const LAS bf16* p = base + (k0 + 8 * (lane >> 5) + ((lane & 15) >> 2)) * ld + x0 + 16 * ((lane >> 4) & 1) + 4 * (lane & 3);
    const s16x4 lo = trr(p), hi = trr(p + 4 * ld);
    return (bf16x8){lo[0], lo[1], lo[2], lo[3], hi[0], hi[1], hi[2], hi[3]}; }
__device__ __forceinline__ void cstore(const f32x16& acc, LAS bf16* base, int ld, int row0, int col0, int lane, float sgn) {
    const int hi = lane >> 5, l31 = lane & 31;
#pragma unroll
    for (int r = 0; r < 16; ++r) base[(row0 + crow(r, hi)) * ld + col0 + l31] = (bf16)f2bf(sgn * acc[r]); }
#define MFMA32(a, b, c) __builtin_amdgcn_mfma_f32_32x32x16_bf16(a, b, c, 0, 0, 0)

__device__ __forceinline__ void chain(CArgs& a, LAS unsigned char* lds, int layer, int b, int h, int dir) {
    int tid0_ = threadIdx.x; asm volatile("" : "+v"(tid0_)); const int w = __builtin_amdgcn_readfirstlane(tid0_ >> 6);
    bf16* Z = (bf16*)(a.ws + WS_Z); bf16* OS = (bf16*)(a.ws + WS_OSG);
    unsigned* hcnt = (unsigned*)(a.ws + WS_CTL) + CW_HOFF_G + (layer * 32 + b * 4 + h) * 68; unsigned* hrdy = hcnt + 8192; LAS unsigned* HFW = (LAS unsigned*)(lds + END_OFF); const float* BG = (const float*)(a.ws + WS_BG);
    LAS bf16* Kb = (LAS bf16*)(lds + KB_OFF); LAS bf16* Qb = (LAS bf16*)(lds + QB_OFF); LAS bf16* Vb = (LAS bf16*)(lds + VB_OFF); LAS bf16* Sb = (LAS bf16*)(lds + SB_OFF);
    LAS bf16* Wb = (LAS bf16*)(lds + WB_OFF); LAS bf16* Tb = (LAS bf16*)(lds + TB_OFF); LAS bf16* Aq = (LAS bf16*)(lds + AQ_OFF); LAS bf16* Lb = (LAS bf16*)(lds + LB_OFF);
    LAS float* Ldg = (LAS float*)(lds + LDG_OFF); LAS bf16* XS = (LAS bf16*)(lds + XS_OFF); LAS bf16* YS = (LAS bf16*)(lds + YS_OFF);
    LAS float* bet = (LAS float*)(lds + SC_OFF); LAS float* gc = bet + 64; LAS float* eg = bet + 128; LAS float* ekl = bet + 192; LAS float* bes = bet + 256; LAS float* egl = bet + 320;
    LAS float* SS = (LAS float*)(lds + SS_OFF);
    const size_t rowb = (size_t)b * TPB;
    const int tr = w >> 2, tc = w & 3;
    const int sr = w >> 1, sc0 = 2 * (w & 1);
    const float gnv = a.in[I_GNORM][layer * 128 + 32 * tc + (tid0_ & 31)];
    {
        f32x16 accS[2]; accS[0] = f32x16{}; accS[1] = f32x16{};
        __syncthreads();
        { int tid_ = threadIdx.x; asm volatile("" : "+v"(tid_)); const int tid = tid_;
        for (int i = tid; i < 128 * LD / 2; i += 512) ((LAS unsigned*)Sb)[i] = 0u;
        for (int i = tid; i < 64 * LDT / 2; i += 512) ((LAS unsigned*)Tb)[i] = 0u; }
        v4u pf[6]; float pbg0 = 0.f, pbg1 = 0.f; int pub = -1;
#define GDN_T0(step) (64 * ((step) < 4 ? (dir ? 3 - (step) : (step)) : 4 + (dir ? 63 - ((step) - 4) : (step) - 4)))
#define GDN_PREFETCH(step) do { const int t0n = GDN_T0(step); const bf16* zb_ = Z + (rowb + t0n) * ZLD + h * 128; \
            _Pragma("unroll") for (int m = 0; m < 6; ++m) { const int idx = tid + 512 * m, mat = idx >> 10, rem = idx & 1023, i = rem >> 4, ch = rem & 15; \
                pf[m] = *(const GAS v4u*)(zb_ + (unsigned)((dir ? 63 - i : i) * ZLD + mat * 512 + ch * 8)); } \
            if (w == 7) { const float* p = BG + (rowb + t0n) * 16 + h * 4 + dir * 2 + (unsigned)((dir ? 63 - lane : lane) * 16); pbg0 = p[0]; pbg1 = p[1]; } } while (0)
#define GDN_COMMIT() do { \
            _Pragma("unroll") for (int m = 0; m < 6; ++m) { const int idx = tid + 512 * m, mat = idx >> 10, rem = idx & 1023, i = rem >> 4, ch = rem & 15; \
                *(LAS v4u*)((mat == 0 ? Qb : (mat == 1 ? Kb : Vb)) + i * LD + ch * 8) = pf[m]; } \
            if (w == 7) { float v = pbg1; \
                _Pragma("unroll") for (int o = 1; o < 64; o <<= 1) { const float t = __shfl_up(v, o); if (lane >= o) v += t; } \
                const float gl = __shfl(v, 63); const float e = __expf(v); \
                bet[lane] = pbg0; gc[lane] = v; eg[lane] = e; ekl[lane] = __expf(gl - v); bes[lane] = pbg0 * e; if (lane == 0) egl[0] = __expf(gl); } } while (0)
        { int tid_ = threadIdx.x; asm volatile("" : "+v"(tid_)); const int tid = tid_, lane = tid & 63;
          GDN_PREFETCH(0);
          GDN_COMMIT(); }
        __syncthreads();
        for (int step = 0; step < 68; ++step) {
            int tid_ = threadIdx.x; asm volatile("" : "+v"(tid_)); const int tid = tid_, lane = tid & 63, l31 = lane & 31, hi = lane >> 5;
            const int t0 = GDN_T0(step);
            const bool want = !(layer == DEPTH - 1 && step < 4);
            const int cix = t0 >> 6;
            unsigned hst = 0u;
            if (w == 7 && lane == 0) {
                if (pub >= 0) { __builtin_amdgcn_fence(__ATOMIC_RELEASE, "agent"); asm volatile("s_waitcnt vmcnt(0)" ::: "memory"); __hip_atomic_store(hrdy + pub, 1u, RLX_AGENT); }
                if (want) hst = __hip_atomic_fetch_add(hcnt + cix, 1u, RLX_AGENT);
            }
            if (step + 1 < 68) GDN_PREFETCH(step + 1);
            {   const int ti = (w >> 1) & 1, tj = w & 1; const LAS bf16* src = w < 4 ? Kb : Qb;
                f32x16 acc = f32x16{};
                if (!(ti == 0 && tj == 1)) {
#pragma unroll
                    for (int s = 0; s < 8; ++s) acc = MFMA32(frag_rk(src, LD, 32 * ti, 16 * s, lane), frag_rk(Kb, LD, 32 * tj, 16 * s, lane), acc); }
                const int j = 32 * tj + l31; const float gcj = gc[j];
#pragma unroll
                for (int r = 0; r < 16; ++r) { const int i = 32 * ti + crow(r, hi); const float e = __expf(gc[i] - gcj);
                    if (w < 4) { const float val = i > j ? bet[i] * acc[r] * e : 0.f; Lb[i * LDT + j] = (bf16)f2bf(val);
                        if ((i >> 4) == (j >> 4)) Ldg[((i >> 4) * 16 + (i & 15)) * 17 + (j & 15)] = val; }
                    else { const float val = i >= j ? acc[r] * e : 0.f; Aq[i * LDT + j] = (bf16)f2bf(val); } }
            }
            if (w == 7 && lane == 0) {
                if (hst != 0u) { unsigned sp = 0; while (__hip_atomic_load(hrdy + cix, RLX_AGENT) == 0u && ++sp < (1u << 22)) __builtin_amdgcn_s_sleep(2);
                    __builtin_amdgcn_fence(__ATOMIC_ACQUIRE, "agent"); asm volatile("s_waitcnt vmcnt(0)" ::: "memory"); }
                HFW[0] = hst; }
            LBAR();
            const bool second = HFW[0] != 0u;
            unsigned short osv[16], gtv[16];
            if (want && second) {
                const bf16* ob_ = OS + (rowb + t0) * 512 + h * 128 + 32 * tc; const bf16* gb_ = Z + (rowb + t0) * ZLD + ZC_GG + h * 128 + 32 * tc;
#pragma unroll
                for (int r = 0; r < 16; ++r) { const int i = 32 * tr + crow(r, hi), tk = dir ? 63 - i : i; osv[r] = ob_[(unsigned)(tk * 512 + l31)]; gtv[r] = gb_[(unsigned)(tk * ZLD + l31)]; }
            }
            if (w < 4) {
                const int c = lane & 15; float t[16];
#pragma unroll
                for (int i = 0; i < 16; ++i) { float s = (i == c) ? 1.f : 0.f;
#pragma unroll
                    for (int j = 0; j < i; ++j) s -= Ldg[(w * 16 + i) * 17 + j] * t[j];
                    t[i] = s; }
                if (lane < 16) {
#pragma unroll
                    for (int i = 0; i < 16; ++i) Tb[(16 * w + i) * LDT + 16 * w + c] = (bf16)f2bf(t[i]); }
            } else {
                const int t2 = tid - 256, row = t2 >> 2, c0 = (t2 & 3) * 32; const float bv = bet[row];
#pragma unroll
                for (int q = 0; q < 4; ++q) { LAS v4u* p = (LAS v4u*)(Vb + row * LD + c0 + 8 * q); v4u v = *p;
                    v.x = pk2(bflo(v.x) * bv, bfhi(v.x) * bv); v.y = pk2(bflo(v.y) * bv, bfhi(v.y) * bv); v.z = pk2(bflo(v.z) * bv, bfhi(v.z) * bv); v.w = pk2(bflo(v.w) * bv, bfhi(v.w) * bv); *p = v; }
            }
            LBAR();
            if (w < 2) {
                const int p = w, r16 = lane & 15, g = lane >> 4, g1 = g & 1; const bool act = g < 2;
                typedef float f32x4_ __attribute__((ext_vector_type(4)));
                bf16x8 af = *(const LAS bf16x8*)(Lb + (32 * p + 16 + r16) * LDT + 32 * p + 8 * g1), bfr;
#pragma unroll
                for (int j = 0; j < 8; ++j) bfr[j] = (short)Tb[(32 * p + 8 * g1 + j) * LDT + 32 * p + r16];
                if (!act) { af = bf16x8{}; bfr = bf16x8{}; }
                f32x4_ x = __builtin_amdgcn_mfma_f32_16x16x32_bf16(af, bfr, (f32x4_){0.f, 0.f, 0.f, 0.f}, 0, 0, 0);
                LAS bf16* xs = XS + p * 16 * 24;
#pragma unroll
                for (int q = 0; q < 4; ++q) xs[(4 * g + q) * 24 + r16] = (bf16)f2bf(x[q]);
                LDS_WAIT(); asm volatile("" ::: "memory");
                af = *(const LAS bf16x8*)(Tb + (32 * p + 16 + r16) * LDT + 32 * p + 16 + 8 * g1);
#pragma unroll
                for (int j = 0; j < 8; ++j) bfr[j] = (short)xs[(8 * g1 + j) * 24 + r16];
                if (!act) { af = bf16x8{}; bfr = bf16x8{}; }
                const f32x4_ tt = __builtin_amdgcn_mfma_f32_16x16x32_bf16(af, bfr, (f32x4_){0.f, 0.f, 0.f, 0.f}, 0, 0, 0);
#pragma unroll
                for (int q = 0; q < 4; ++q) Tb[(32 * p + 16 + 4 * g + q) * LDT + 32 * p + r16] = (bf16)f2bf(-tt[q]);
            }
            LBAR();
            if (w == 0) {
                f32x16 y = f32x16{};
#pragma unroll
                for (int s = 0; s < 2; ++s) y = MFMA32(frag_rk(Lb, LDT, 32, 16 * s, lane), frag_kr(Tb, LDT, 16 * s, 0, lane), y);
                cstore(y, YS, 40, 0, 0, lane, 1.f);
                LDS_WAIT(); asm volatile("" ::: "memory");
                f32x16 z = f32x16{};
#pragma unroll
                for (int s = 0; s < 2; ++s) z = MFMA32(frag_rk(Tb, LDT, 32, 32 + 16 * s, lane), frag_kr(YS, 40, 16 * s, 0, lane), z);
                cstore(z, Tb, LDT, 32, 0, lane, -1.f);
            }
            LBAR();
            f32x16 accU = f32x16{};
            {   f32x16 accW = f32x16{};
                const int ns = tr == 0 ? 2 : 4;
                for (int s = 0; s < ns; ++s) {
                    const bf16x8 ta = frag_rk(Tb, LDT, 32 * tr, 16 * s, lane);
                    accU = MFMA32(ta, frag_kr(Vb, LD, 16 * s, 32 * tc, lane), accU);
                    bf16x8 tw; const LAS float* bs = bes + 16 * s + 8 * hi;
#pragma unroll
                    for (int j = 0; j < 8; ++j) tw[j] = (short)f2bf(bf2f((unsigned short)ta[j]) * bs[j]);
                    accW = MFMA32(tw, frag_kr(Kb, LD, 16 * s, 32 * tc, lane), accW); }
                cstore(accW, Wb, LD, 32 * tr, 32 * tc, lane, 1.f);
            }
            LBAR();
            {   f32x16 ws = f32x16{};
#pragma unroll
                for (int s = 0; s < 8; ++s) ws = MFMA32(frag_rk(Wb, LD, 32 * tr, 16 * s, lane), frag_kr(Sb, LD, 16 * s, 32 * tc, lane), ws);
#pragma unroll
                for (int r = 0; r < 16; ++r) accU[r] -= ws[r];
                cstore(accU, Vb, LD, 32 * tr, 32 * tc, lane, 1.f);
                const int row = tid >> 3, c0 = (tid & 7) * 16; const float kv = ekl[row];
#pragma unroll
                for (int q = 0; q < 2; ++q) { LAS v4u* p = (LAS v4u*)(Kb + row * LD + c0 + 8 * q); v4u v = *p;
                    v.x = pk2(bflo(v.x) * kv, bfhi(v.x) * kv); v.y = pk2(bflo(v.y) * kv, bfhi(v.y) * kv); v.z = pk2(bflo(v.z) * kv, bfhi(v.z) * kv); v.w = pk2(bflo(v.w) * kv, bfhi(v.w) * kv); *p = v; }
            }
            LBAR();
            f32x16 o = f32x16{};
            {
#pragma unroll
                for (int s = 0; s < 8; ++s) o = MFMA32(frag_rk(Qb, LD, 32 * tr, 16 * s, lane), frag_kr(Sb, LD, 16 * s, 32 * tc, lane), o);
#pragma unroll
                for (int r = 0; r < 16; ++r) o[r] *= eg[32 * tr + crow(r, hi)];
                const int ns = tr == 0 ? 2 : 4;
                for (int s = 0; s < ns; ++s) o = MFMA32(frag_rk(Aq, LDT, 32 * tr, 16 * s, lane), frag_kr(Vb, LD, 16 * s, 32 * tc, lane), o);
                const float el = egl[0];
#pragma unroll
                for (int u = 0; u < 2; ++u) {
#pragma unroll
                    for (int r = 0; r < 16; ++r) accS[u][r] *= el;
#pragma unroll
                    for (int s = 0; s < 4; ++s) accS[u] = MFMA32(frag_kr(Kb, LD, 16 * s, 32 * sr, lane), frag_kr(Vb, LD, 16 * s, 32 * (sc0 + u), lane), accS[u]); }
            }
            if (want) {
                if (!second) { bf16* ob_ = OS + (rowb + t0) * 512 + h * 128 + 32 * tc;
#pragma unroll
                    for (int r = 0; r < 16; ++r) { const int i = 32 * tr + crow(r, hi), tk = dir ? 63 - i : i; ob_[(unsigned)(tk * 512 + l31)] = (bf16)f2bf(o[r]); }
                } else {
#pragma unroll
                    for (int r = 0; r < 16; ++r) { const int i = 32 * tr + crow(r, hi); o[r] += bf2f(osv[r]);
                        float q = o[r] * o[r]; q += __shfl_xor(q, 1); q += __shfl_xor(q, 2); q += __shfl_xor(q, 4); q += __shfl_xor(q, 8); q += __shfl_xor(q, 16);
                        SS[i * 4 + tc] = q; }
                }
            }
            LBAR();
            cstore(accS[0], Sb, LD, 32 * sr, 32 * sc0, lane, 1.f); cstore(accS[1], Sb, LD, 32 * sr, 32 * (sc0 + 1), lane, 1.f);
            if (want && second) { bf16* gb_ = Z + (rowb + t0) * ZLD + ZC_GG + h * 128 + 32 * tc;
#pragma unroll
                for (int r = 0; r < 16; ++r) { const int i = 32 * tr + crow(r, hi), tk = dir ? 63 - i : i; const f32x4 p4 = *(const LAS f32x4*)(SS + i * 4);
                    const float rs = rsqrtf(((p4.x + p4.y) + (p4.z + p4.w)) * (1.f / 128.f) + EPS);
                    gb_[(unsigned)(tk * ZLD + l31)] = (bf16)f2bf(o[r] * rs * gnv * siluf_(bf2f(gtv[r]))); }
            }
            if (step + 1 < 68) GDN_COMMIT();
            if (want && !second) { VM_WAIT(); pub = cix; } else pub = -1;
            LBAR();
        }
        if (w == 7 && (tid0_ & 63) == 0 && pub >= 0) { __builtin_amdgcn_fence(__ATOMIC_RELEASE, "agent"); asm volatile("s_waitcnt vmcnt(0)" ::: "memory"); __hip_atomic_store(hrdy + pub, 1u, RLX_AGENT); }
    }
#undef GDN_T0
#undef GDN_PREFETCH
#undef GDN_COMMIT
}
}

namespace hg1 {
using gdn1::crow; using gdn1::frag_rk; using gdn1::frag_kr; using gdn1::cstore;
constexpr int LD = 136, LDV = 72;
constexpr int A_OFF = 0  , B_OFF = 43520, K_OFF = 60928, V_OFF = 78336, S_OFF = 87552  , AT_OFF = 105984, TOT_OFF = 115200  , EBL_OFF = 117248  , SS_OFF = 117760  ;
__device__ __forceinline__ int arow(int J) { return J == 0 ? 0 : (J == 1 ? 64 : (J == 2 ? 112 : 144)); }
__device__ __forceinline__ void chain(CArgs& a, LAS unsigned char* lds, int layer, int b, int h, int dir) {
    int tid0_ = threadIdx.x; asm volatile("" : "+v"(tid0_)); const int w = __builtin_amdgcn_readfirstlane(tid0_ >> 6);
    bf16* Z = (bf16*)(a.ws + WS_Z); bf16* OS = (bf16*)(a.ws + WS_OSH);
    unsigned* hcnt = (unsigned*)(a.ws + WS_CTL) + CW_HOFF_H + (layer * 32 + b * 4 + h) * 68; unsigned* hrdy = hcnt + 8192; LAS unsigned* HFW = (LAS unsigned*)(lds + SS_OFF + 512); const float* LB = (const float*)(a.ws + WS_LB);
    LAS bf16* Ab = (LAS bf16*)(lds + A_OFF); LAS bf16* Bm = (LAS bf16*)(lds + B_OFF); LAS bf16* Kt = (LAS bf16*)(lds + K_OFF); LAS bf16* Vb = (LAS bf16*)(lds + V_OFF);
    LAS bf16* Sb = (LAS bf16*)(lds + S_OFF); LAS bf16* At = (LAS bf16*)(lds + AT_OFF); LAS float* tot = (LAS float*)(lds + TOT_OFF); LAS float* ebl = (LAS float*)(lds + EBL_OFF); LAS float* SS = (LAS float*)(lds + SS_OFF);
    const size_t rowb = (size_t)b * TPB;
    const int mblk = w >> 1;
    const int sr = w >> 1, sc = w & 1;
    const int tr = (w >> 1) & 1, tc = w & 1;
    const float hnv = a.in[I_HNORM][layer * 64 + 32 * tc + (tid0_ & 31)];
    {
        f32x16 accS = f32x16{};
        const int zf = dir ? ZC_HFB : ZC_HFF;
        __syncthreads();
        { int tid_ = threadIdx.x; asm volatile("" : "+v"(tid_)); const int tid = tid_;
          for (int i = tid; i < 128 * LDV / 2; i += 512) ((LAS unsigned*)Sb)[i] = 0u;
          for (int i = tid; i < 64 * LDV / 2; i += 512) ((LAS unsigned*)At)[i] = 0u; }
        unsigned short pxq[16], pxf[16]; v4u pv; int pub = -1;
#define HG_T0(step) (64 * ((step) < 4 ? (dir ? 3 - (step) : (step)) : 4 + (dir ? 63 - ((step) - 4) : (step) - 4)))
#define HG_PREFETCH(step) do { const int t0n = HG_T0(step); const bf16* zb_ = Z + (rowb + t0n) * ZLD + h * 128 + (tid & 127); \
            _Pragma("unroll") for (int ii = 0; ii < 16; ++ii) { const int i = 16 * mblk + ii; const unsigned off_ = (unsigned)((dir ? 63 - i : i) * ZLD); pxq[ii] = zb_[off_ + ZC_HQ]; pxf[ii] = zb_[off_ + zf]; } \
            { const int i = tid >> 3, ch = tid & 7; pv = *(const GAS v4u*)(Z + (rowb + t0n) * ZLD + ZC_HI + h * 64 + (unsigned)((dir ? 63 - i : i) * ZLD + ch * 8)); } } while (0)
        { int tid_ = threadIdx.x; asm volatile("" : "+v"(tid_)); const int tid = tid_; HG_PREFETCH(0); }
        __syncthreads();
        for (int step = 0; step < 68; ++step) {
            int tid_ = threadIdx.x; asm volatile("" : "+v"(tid_)); const int tid = tid_, lane = tid & 63, l31 = lane & 31, hi = lane >> 5;
            const int t0 = HG_T0(step);
            const bool want = !(layer == DEPTH - 1 && step < 4);
            const int cix = t0 >> 6;
            unsigned hst = 0u;
            if (w == 7 && lane == 0) {
                if (pub >= 0) { __builtin_amdgcn_fence(__ATOMIC_RELEASE, "agent"); asm volatile("s_waitcnt vmcnt(0)" ::: "memory"); __hip_atomic_store(hrdy + pub, 1u, RLX_AGENT); }
                if (want) hst = __hip_atomic_fetch_add(hcnt + cix, 1u, RLX_AGENT);
            }
            const int d = tid & 127;
            float lc[16], qv[16], kv[16];
            {   const float lbv = LB[layer * 1024 + dir * 512 + h * 128 + d], olb = 1.0f - lbv; float run = 0.f;
#pragma unroll
                for (int ii = 0; ii < 16; ++ii) { const float x = fmaxf(bf2f(pxf[ii]), -80.f); const float ex = __expf(-x);
                    const float sg = 1.0f / (1.0f + ex); run += __logf(lbv + olb * sg); lc[ii] = run;
                    kv[ii] = olb * (ex * sg);
                    qv[ii] = bf2f(pxq[ii]) * 0.08838834764831845f; }
                tot[mblk * 128 + d] = run;
#pragma unroll
                for (int ii = 0; ii < 16; ++ii) Bm[(16 * mblk + ii) * LD + d] = (bf16)f2bf(kv[ii] * __expf(fminf(-lc[ii], 80.f)));
                *(LAS v4u*)(Vb + (tid >> 3) * LDV + (tid & 7) * 8) = pv;
            }
            if (step + 1 < 68) HG_PREFETCH(step + 1);
            if (w == 7 && lane == 0) {
                if (hst != 0u) { unsigned sp = 0; while (__hip_atomic_load(hrdy + cix, RLX_AGENT) == 0u && ++sp < (1u << 22)) __builtin_amdgcn_s_sleep(2);
                    __builtin_amdgcn_fence(__ATOMIC_ACQUIRE, "agent"); asm volatile("s_waitcnt vmcnt(0)" ::: "memory"); }
                HFW[0] = hst; }
            LBAR();
            const bool second = HFW[0] != 0u;
            unsigned short osv[16], gtv[16];
            if (want && second && w < 4) {
                const bf16* ob_ = OS + (rowb + t0) * 256 + h * 64 + 32 * tc; const bf16* gb_ = Z + (rowb + t0) * ZLD + ZC_HG + h * 64 + 32 * tc;
#pragma unroll
                for (int r = 0; r < 16; ++r) { const int i = 32 * tr + crow(r, hi), tk = dir ? 63 - i : i; osv[r] = ob_[(unsigned)(tk * 256 + l31)]; gtv[r] = gb_[(unsigned)(tk * ZLD + l31)]; }
            }
            {   const float r1 = tot[d], r2 = r1 + tot[128 + d], r3 = r2 + tot[256 + d], bl = r3 + tot[384 + d];
                const float rm = mblk == 0 ? 0.f : (mblk == 1 ? r1 : (mblk == 2 ? r2 : r3));
                if (mblk == 0) ebl[d] = __expf(bl);
#pragma unroll
                for (int ii = 0; ii < 16; ++ii) Kt[(16 * mblk + ii) * LD + d] = (bf16)f2bf(kv[ii] * __expf((bl - rm) - lc[ii]));
#pragma unroll
                for (int J = 0; J < 4; ++J) if (J <= mblk) { const float off = rm - (J == 0 ? 0.f : (J == 1 ? r1 : (J == 2 ? r2 : r3)));
#pragma unroll
                    for (int ii = 0; ii < 16; ++ii) Ab[(arow(J) + 16 * (mblk - J) + ii) * LD + d] = (bf16)f2bf(qv[ii] * __expf(off + lc[ii])); }
            }
            LBAR();
            for (int idx = w; idx < 10; idx += 8) {
                const int I = idx >= 6 ? 3 : (idx >= 3 ? 2 : (idx >= 1 ? 1 : 0)), J = idx - (I * (I + 1)) / 2;
                const int r16 = lane & 15, g = lane >> 4;
                f32x4 acc = (f32x4){0.f, 0.f, 0.f, 0.f};
                const LAS bf16* ap = Ab + (arow(J) + 16 * (I - J) + r16) * LD + 8 * g; const LAS bf16* bp = Bm + (16 * J + r16) * LD + 8 * g;
#pragma unroll
                for (int s = 0; s < 4; ++s) acc = __builtin_amdgcn_mfma_f32_16x16x32_bf16(*(const LAS bf16x8*)(ap + 32 * s), *(const LAS bf16x8*)(bp + 32 * s), acc, 0, 0, 0);
#pragma unroll
                for (int q = 0; q < 4; ++q) { const int ri = 4 * g + q; const float v = (I != J || ri >= r16) ? acc[q] : 0.f; At[(16 * I + ri) * LDV + 16 * J + r16] = (bf16)f2bf(v); }
            }
            LBAR();
            f32x16 o = f32x16{};
            if (w < 4) {
#pragma unroll
                for (int s = 0; s < 8; ++s) o = MFMA32(frag_rk(Ab, LD, 32 * tr, 16 * s, lane), frag_kr(Sb, LDV, 16 * s, 32 * tc, lane), o);
                const int ns = tr == 0 ? 2 : 4;
                for (int s = 0; s < ns; ++s) o = MFMA32(frag_rk(At, LDV, 32 * tr, 16 * s, lane), frag_kr(Vb, LDV, 16 * s, 32 * tc, lane), o);
            }
            {
#pragma unroll
                for (int r = 0; r < 16; ++r) accS[r] *= ebl[32 * sr + crow(r, hi)];
#pragma unroll
                for (int s = 0; s < 4; ++s) accS = MFMA32(frag_kr(Kt, LD, 16 * s, 32 * sr, lane), frag_kr(Vb, LDV, 16 * s, 32 * sc, lane), accS);
            }
            if (want && w < 4) {
                if (!second) { bf16* ob_ = OS + (rowb + t0) * 256 + h * 64 + 32 * tc;
#pragma unroll
                    for (int r = 0; r < 16; ++r) { const int i = 32 * tr + crow(r, hi), tk = dir ? 63 - i : i; ob_[(unsigned)(tk * 256 + l31)] = (bf16)f2bf(o[r]); }
                } else {
#pragma unroll
                    for (int r = 0; r < 16; ++r) { const int i = 32 * tr + crow(r, hi); o[r] += bf2f(osv[r]);
                        float q = o[r] * o[r]; q += __shfl_xor(q, 1); q += __shfl_xor(q, 2); q += __shfl_xor(q, 4); q += __shfl_xor(q, 8); q += __shfl_xor(q, 16);
                        SS[i * 2 + tc] = q; }
                }
            }
            LBAR();
            cstore(accS, Sb, LDV, 32 * sr, 32 * sc, lane, 1.f);
            if (want && second && w < 4) { bf16* gb_ = Z + (rowb + t0) * ZLD + ZC_HG + h * 64 + 32 * tc;
#pragma unroll
                for (int r = 0; r < 16; ++r) { const int i = 32 * tr + crow(r, hi), tk = dir ? 63 - i : i;
                    const float rs = rsqrtf((SS[i * 2] + SS[i * 2 + 1]) * (1.f / 64.f) + EPS);
                    gb_[(unsigned)(tk * ZLD + l31)] = (bf16)f2bf(o[r] * rs * hnv * siluf_(bf2f(gtv[r]))); }
            }
            if (want && !second) { VM_WAIT(); pub = cix; } else pub = -1;
            LBAR();
        }
        if (w == 7 && (tid0_ & 63) == 0 && pub >= 0) { __builtin_amdgcn_fence(__ATOMIC_RELEASE, "agent"); asm volatile("s_waitcnt vmcnt(0)" ::: "memory"); __hip_atomic_store(hrdy + pub, 1u, RLX_AGENT); }
    }
#undef HG_T0
#undef HG_PREFETCH
}
}

#ifndef PH_MASK
#define PH_MASK 0xFFFFF
#endif
#define PH_ON(i) (((PH_MASK) >> (i)) & 1)
constexpr int PH_PER_LAYER = 9, N_PHASES = 2 + DEPTH * PH_PER_LAYER;
enum PhaseKind { PK_GEMM_IN = 0, PK_MLA_UP, PK_MLA_ROPE, PK_MIX, PK_GEMM_OUT, PK_POST1, PK_MLP1, PK_MLP2, PK_POST2 };
constexpr int ATT_UNITS_LAT = NB * 4 * 16, ATT_UNITS_CTX = NB * 4;
__device__ __forceinline__ CArgs& kargs() { CArgs* p = (CArgs*)__builtin_amdgcn_kernarg_segment_ptr(); asm volatile("" : "+s"(p)); return *p; }

__global__ void __launch_bounds__(NWAVES * 64, 2) fwd_kernel(Args args_unused) {
    extern __shared__ __attribute__((aligned(16))) unsigned char lds_[];
    LAS unsigned char* lds = (LAS unsigned char*)lds_;
    {   const int tid = threadIdx.x;
        for (int u = tid; u < (LDS_BYTES - LDSCTL_OFF) / 4; u += NWAVES * 64) ((LAS unsigned*)(lds + LDSCTL_OFF))[u] = 0u; }
    __syncthreads();
    XcdBarrier bar; { unsigned char* ws = kargs().ws; bar.bar = (unsigned*)(ws + WS_CTL) + CW_BAR; bar.x = 0; bar.st = nullptr;
        if (MK_ONE_LAUNCH) bar = xcd_barrier_post(bar.bar, (volatile LAS unsigned*)(lds + MISC_OFF) + 8); }
    const int ph_lo = kargs().ph_lo, ph_hi = kargs().ph_hi;
    for (int ph = ph_lo; ph < ph_hi; ++ph) {
        CArgs& a = kargs();
        int tid_ = threadIdx.x; asm volatile("" : "+v"(tid_));
        const int tid = tid_, lane = tid & 63, wave = __builtin_amdgcn_readfirstlane(tid >> 6);
        const int G = gridDim.x, bx = blockIdx.x, vcu = (G % 8 == 0) ? (bx % 8) * (G / 8) + bx / 8 : bx;
        const int gw = vcu * NWAVES + wave, NGW = G * NWAVES;
        if (ph == 0) { if constexpr (PH_ON(0)) p0a_prologue(a, lds, vcu, G, wave, lane, tid); }
        else if (ph == 1) { if constexpr (PH_ON(1)) p0b_prenorm(a, gw, NGW, lane); }
        else {
            const int layer = (ph - 2) / PH_PER_LAYER, kind = (ph - 2) % PH_PER_LAYER;
            if (kind == PK_GEMM_IN || kind == PK_MLA_UP || kind == PK_GEMM_OUT || kind == PK_MLP1 || kind == PK_MLP2) {
                {
                    bf16* HB = (bf16*)(a.ws + WS_HB); bf16* Z = (bf16*)(a.ws + WS_Z);
                    const unsigned char* wb = a.ws + WS_W + (size_t)layer * W_LAYER;
                    pg8::StaticOrder S;
#define RUN_GEMM(Aop, Bop, N_, K_, LDA_, Out, LDC_, ACT_) do { int kk_ = K_; asm volatile("" : "+s"(kk_)); const pg8::Gemm g{Aop, (const bf16*)(Bop), MT, N_, kk_, LDA_}; const pg8::EpiBf16 E{Out, LDC_, ACT_}; S.init(MT, N_, G, bx); \
                        pg8::gemm_phase<pg8::EpiBf16, pg8::StaticOrder, true, true>(lds, g, S, E); } while (0)
                    if (kind == PK_GEMM_IN)     { if constexpr (PH_ON(2)) RUN_GEMM(HB, wb + W_IN, ZLD, DM, DM, Z, ZLD, 0); }
                    else if (kind == PK_MLA_UP) { if constexpr (PH_ON(3)) RUN_GEMM(Z + ZC_CQ, wb + W_UQ, 512, 256, ZLD, HB, DM, 0);
                                                  if constexpr (PH_ON(11)) RUN_GEMM(Z + ZC_CKV, wb + W_UKV, 512, 128, ZLD, HB + 512, DM, 0); }
                    else if (kind == PK_GEMM_OUT) { if constexpr (PH_ON(6)) RUN_GEMM(Z + ZC_GG, wb + W_OUT, DM, DM, ZLD, HB, DM, 0); }
                    else if (kind == PK_MLP1)   { if constexpr (PH_ON(8)) RUN_GEMM(HB, wb + W_1, DFF, DM, DM, Z, DFF, 2); }
                    else                        { if constexpr (PH_ON(9)) RUN_GEMM(Z, wb + W_2, DM, DFF, DFF, HB, DM, 0); }
#undef RUN_GEMM
                    if (kind == PK_MLA_UP) { if constexpr (PH_ON(3)) gdn_halo_copy(a, gw, NGW, lane); }
                }
            } else if (kind == PK_MLA_ROPE) { if constexpr (PH_ON(4)) { gdn_conv_pass(a, lds, layer, vcu, G); __syncthreads(); mla_rope_pass(a, lds, wave, gw, NGW, lane); } }
            else if (kind == PK_MIX) {
                if constexpr (PH_ON(5)) {
#ifndef MIX_PARTS
#define MIX_PARTS 7
#endif
                    if (bx < 64) { if constexpr (MIX_PARTS & 1) gdn1::chain(a, lds, layer, bx >> 3, (bx >> 1) & 3, bx & 1); }
                    else if (bx < 128) { if constexpr (MIX_PARTS & 2) hg1::chain(a, lds, layer, (bx - 64) >> 3, ((bx - 64) >> 1) & 3, bx & 1); }
                    __syncthreads();
                    volatile LAS unsigned* MISC = (volatile LAS unsigned*)(lds + MISC_OFF);
                    const bf16* HB = (const bf16*)(a.ws + WS_HB); bf16* Z = (bf16*)(a.ws + WS_Z); unsigned* qhead = (unsigned*)(a.ws + WS_CTL) + CW_ATTQ + 64 * layer;
                    const int nunits = ATT_UNITS_LAT + (layer == DEPTH - 1 ? 0 : ATT_UNITS_CTX);
                    for (;;) {
                        if (tid == 0) MISC[0] = __hip_atomic_fetch_add(qhead, 1u, __ATOMIC_RELAXED, __HIP_MEMORY_SCOPE_AGENT);
                        __syncthreads();
                        const int u = (int)MISC[0];
                        __syncthreads();
                        if (u >= nunits) break;
                        int b, h, qb;
                        if (u < ATT_UNITS_LAT) { b = u >> 6; h = (u >> 4) & 3; qb = 1 + (u & 15); } else { const int uu = u - ATT_UNITS_LAT; b = uu >> 2; h = uu & 3; qb = 0; }
                        if constexpr (MIX_PARTS & 4) att::attn_unit(b, h, qb, HB, Z, lds);
                    }
                }
            }
            else if (kind == PK_POST1) { if constexpr (PH_ON(7)) post_pass(a, layer, 0, gw, NGW, lane); }
            else { if constexpr (PH_ON(10)) post_pass(a, layer, 1, gw, NGW, lane); }
        }
        if (ph + 1 < ph_hi) xcd_barrier(bar);
    }
}

extern "C" void kernel_launch(void* const* d_in, const int* in_sizes, int n_in, void* d_out, int out_size, void* d_ws, size_t ws_size, hipStream_t stream) {
    static int grid = 0;
    if (grid == 0) {
        if (n_in != 24 || in_sizes[0] != NB * SEQ * DM || out_size != NB * SEQ * DM || ws_size < WS_END) {
            fprintf(stderr, "kernel_launch: unexpected shapes (n_in %d, in0 %d, out %d, ws %zu, need %zu); nothing launched\n", n_in, n_in > 0 ? in_sizes[0] : -1, out_size, ws_size, (size_t)WS_END); grid = -1; return; }
        int dev = 0, cus = 0, per_cu = 0;
        if (hipGetDevice(&dev) != hipSuccess || hipDeviceGetAttribute(&cus, hipDeviceAttributeMultiprocessorCount, dev) != hipSuccess) { fprintf(stderr, "kernel_launch: device query failed\n"); grid = -1; return; }
        if (hipFuncSetAttribute((const void*)fwd_kernel, hipFuncAttributeMaxDynamicSharedMemorySize, LDS_BYTES) != hipSuccess) { fprintf(stderr, "kernel_launch: hipFuncSetAttribute failed\n"); grid = -1; return; }
        if (hipOccupancyMaxActiveBlocksPerMultiprocessor(&per_cu, (const void*)fwd_kernel, NWAVES * 64, LDS_BYTES) != hipSuccess || per_cu < 1)
            fprintf(stderr, "kernel_launch: note: occupancy query reports %d workgroups per CU\n", per_cu);
        (void)hipGetLastError();
        grid = cus;
        if (grid < 192) { fprintf(stderr, "kernel_launch: %d CUs < 192: unsupported\n", grid); grid = -1; return; }
    }
    if (grid < 0) return;
    if (hipMemsetAsync((char*)d_ws + WS_CTL, 0, CTL_ZERO_BYTES, stream) != hipSuccess) { fprintf(stderr, "kernel_launch: memset failed\n"); return; }
    Args a{};
    for (int i = 0; i < 24; ++i) a.in[i] = (const float*)d_in[i];
    a.out = (float*)d_out; a.ws = (unsigned char*)d_ws;
#if MK_ONE_LAUNCH
    a.ph_lo = 0; a.ph_hi = N_PHASES;
    hipLaunchKernelGGL(fwd_kernel, dim3(grid), dim3(NWAVES * 64), LDS_BYTES, stream, a);
#else
    for (int ph = 0; ph < N_PHASES; ++ph) { a.ph_lo = ph; a.ph_hi = ph + 1; hipLaunchKernelGGL(fwd_kernel, dim3(grid), dim3(NWAVES * 64), LDS_BYTES, stream, a); }
#endif
    const hipError_t le = hipPeekAtLastError();
    if (le != hipSuccess) fprintf(stderr, "kernel_launch: launch failed: %s\n", hipGetErrorName(le));
}
```

```cpp
#include <hip/hip_runtime.h>
#include <hip/hip_bf16.h>
#include <cstdio>
#include <cstdint>
#include <cmath>

#ifndef MK_ONE_LAUNCH
#define MK_ONE_LAUNCH 1
#endif

constexpr int NB = 8, SEQ = 4096, CTXL = 256, TPB = SEQ + CTXL  , MT = NB * TPB  ;
constexpr int DM = 1024, DFF = 4096, DEPTH = 2, DIN = 4528, ZLD = 4608;
constexpr float EPS = 1e-6f;
constexpr int ZC_GQ = 0, ZC_GK = 512, ZC_GV = 1024, ZC_GG = 1536, ZC_CQ = 2048, ZC_HG = 2304, ZC_CKV = 2560, ZC_KR = 2688,
              ZC_GB = 2720, ZC_GA = 2728, ZC_HQ = 2752, ZC_HFF = 3264, ZC_HFB = 3776, ZC_HI = 4288, ZC_END = 4544;
__host__ __device__ __forceinline__ int zcol_src(int n) {
    if (n < 2048) return n;
    if (n < 2304) return 2064 + (n - 2048);
    if (n < 2560) return 4272 + (n - 2304);
    if (n < 2688) return 2320 + (n - 2560);
    if (n < 2720) return 2448 + (n - 2688);
    if (n < 2728) return 2048 + (n - 2720);
    if (n < 2736) return 2056 + (n - 2728);
    if (n < 2752) return -1;
    if (n < 3264) return 2480 + (n - 2752);
    if (n < 3776) return 2992 + (n - 3264);
    if (n < 4288) return 3504 + (n - 3776);
    if (n < 4544) return 4016 + (n - 4288);
    return -1;
}
constexpr int HB_Q = 0, HB_K = 384, HB_V = 768;
constexpr float ATT_C2 = 0.10206207261596577f * 1.4426950408889634f;

constexpr size_t MiB = 1u << 20;
constexpr size_t WS_CTL = 0, CTL_ZERO_BYTES = 1 * MiB;
constexpr size_t WS_MODS = 1 * MiB;
constexpr size_t WS_ROPE = WS_MODS + 512 * 1024;
constexpr size_t WS_LB = WS_ROPE + 512 * 1024 + 0;
constexpr size_t WS_W = 3 * MiB;
constexpr size_t W_IN = 0, W_OUT = W_IN + (size_t)ZLD * DM * 2, W_1 = W_OUT + (size_t)DM * DM * 2, W_2 = W_1 + (size_t)DFF * DM * 2,
                 W_UQ = W_2 + (size_t)DM * DFF * 2, W_UKV = W_UQ + 512 * 256 * 2, W_LAYER = W_UKV + 512 * 128 * 2;
constexpr size_t WS_XC = 58 * MiB;
constexpr size_t WS_HB = 66 * MiB;
constexpr size_t WS_OSG = 134 * MiB;
constexpr size_t WS_OSH = 168 * MiB;
constexpr size_t WS_Z = 185 * MiB;
constexpr size_t WS_HALO = 492 * MiB;
constexpr size_t WS_BG = 499 * MiB;
constexpr size_t WS_END = 502 * MiB;
static_assert(WS_LB + 8192 <= WS_W && WS_W + 2 * W_LAYER <= WS_XC && WS_XC + (size_t)NB * CTXL * DM * 4 <= WS_HB && WS_HB + (size_t)MT * DM * 2 <= WS_OSG &&
              WS_OSG + (size_t)MT * 512 * 2 <= WS_OSH && WS_OSH + (size_t)MT * 256 * 2 <= WS_Z && WS_Z + (size_t)MT * ZLD * 2 <= WS_HALO && WS_HALO + (size_t)(MT / 64) * 4 * 1536 * 2 <= WS_BG && WS_BG + (size_t)MT * 16 * 4 <= WS_END && WS_END <= 512 * MiB, "d_ws map");
constexpr int CW_BAR = 4096;
constexpr int CW_HOFF_G = 65536, CW_HOFF_H = 81920;
constexpr int CW_ATTQ = 16384;

constexpr int RING_BYTES = 131072, LDSCTL_OFF = 146432, MISC_OFF = LDSCTL_OFF + 320, LDS_BYTES = 147456;
constexpr int NWAVES = 8;

#define GAS __attribute__((address_space(1)))
#define LAS __attribute__((address_space(3)))
typedef unsigned short bf16;
typedef unsigned v4u __attribute__((ext_vector_type(4)));
typedef unsigned v2u __attribute__((ext_vector_type(2)));
typedef float f32x4 __attribute__((ext_vector_type(4)));
typedef float f32x16 __attribute__((ext_vector_type(16)));
typedef short bf16x8 __attribute__((ext_vector_type(8)));
typedef short s16x4 __attribute__((ext_vector_type(4)));
typedef GAS unsigned gu32;
#define RLX_AGENT __ATOMIC_RELAXED, __HIP_MEMORY_SCOPE_AGENT
#define LDS_WAIT() asm volatile("s_waitcnt lgkmcnt(0)" ::: "memory")
#define VM_WAIT() asm volatile("s_waitcnt vmcnt(0)" ::: "memory")
#define LBAR() asm volatile("s_waitcnt lgkmcnt(0)\n\ts_barrier" ::: "memory")
typedef float f32x2_t __attribute__((ext_vector_type(2))); typedef __bf16 bf16x2_t __attribute__((ext_vector_type(2)));
__device__ __forceinline__ unsigned f2bf(float f) { return (unsigned)__builtin_bit_cast(unsigned short, (__bf16)f); }
__device__ __forceinline__ unsigned pk2(float lo, float hi) { f32x2_t v = {lo, hi}; bf16x2_t b = __builtin_convertvector(v, bf16x2_t); return __builtin_bit_cast(unsigned, b); }
__device__ __forceinline__ float bf2f(unsigned b) { return __builtin_bit_cast(float, b << 16); }
__device__ __forceinline__ float bflo(unsigned w) { return __builtin_bit_cast(float, w << 16); }
__device__ __forceinline__ float bfhi(unsigned w) { return __builtin_bit_cast(float, w & 0xffff0000u); }
template <int K> __device__ __forceinline__ float swz_xor(float v) { return __builtin_bit_cast(float, __builtin_amdgcn_ds_swizzle(__builtin_bit_cast(int, v), (K << 10) | 0x1F)); }
__device__ __forceinline__ float add_xor32(float v) { const unsigned u = __builtin_bit_cast(unsigned, v); auto r = __builtin_amdgcn_permlane32_swap(u, u, false, false); return __builtin_bit_cast(float, (unsigned)r[0]) + __builtin_bit_cast(float, (unsigned)r[1]); }
__device__ __forceinline__ float max_xor32(float v) { const unsigned u = __builtin_bit_cast(unsigned, v); auto r = __builtin_amdgcn_permlane32_swap(u, u, false, false); return fmaxf(__builtin_bit_cast(float, (unsigned)r[0]), __builtin_bit_cast(float, (unsigned)r[1])); }
template <int CTRL, int ROWMASK, bool BC> __device__ __forceinline__ float dpp_f(float v) { return __builtin_bit_cast(float, __builtin_amdgcn_update_dpp(0, __builtin_bit_cast(int, v), CTRL, ROWMASK, 0xF, BC)); }
__device__ __forceinline__ float row_sum16(float v) { v += dpp_f<0xB1, 0xF, true>(v); v += dpp_f<0x4E, 0xF, true>(v); v += dpp_f<0x141, 0xF, true>(v); v += dpp_f<0x140, 0xF, true>(v); return v; }
__device__ __forceinline__ float half_sum32(float v) { v = row_sum16(v); return v + swz_xor<16>(v); }
__device__ __forceinline__ float wave_sum(float v) { return add_xor32(half_sum32(v)); }
__device__ __forceinline__ float wave_incl_scan(float v) {
    v += dpp_f<0x111, 0xF, true>(v); v += dpp_f<0x112, 0xF, true>(v); v += dpp_f<0x114, 0xF, true>(v); v += dpp_f<0x118, 0xF, true>(v);
    v += dpp_f<0x142, 0xA, false>(v); v += dpp_f<0x143, 0xC, false>(v); return v; }
__device__ __forceinline__ float sigmoidf_(float x) { return __builtin_amdgcn_rcpf(1.0f + __expf(-x)); }
__device__ __forceinline__ float softplusf_(float x) { return x > 20.f ? x : __logf(1.0f + __expf(x)); }
__device__ __forceinline__ float siluf_(float x) { return x * __builtin_amdgcn_rcpf(1.0f + __expf(-x)); }

namespace pg8 {
#define PG8_LAS __attribute__((address_space(3)))
typedef unsigned short bf16_t;
typedef short bf16x8 __attribute__((ext_vector_type(8)));
typedef float f32x4 __attribute__((ext_vector_type(4)));
typedef unsigned u32x4 __attribute__((ext_vector_type(4)));
constexpr int BM = 256, BK = 64, HALF = 128, HTB = HALF * BK * 2  , STAGE_BYTES = 8 * HTB, NXCD = 8, WGM = 8;

__host__ __device__ __forceinline__ int lds_byte(int r, int c) { const int st = (r >> 4) * 2 + (c >> 5), rr = r & 15, cc = c & 31, ob = rr * 64 + cc * 2; return st * 1024 + (ob ^ (((ob >> 9) & 1) << 5)); }
__host__ __device__ __forceinline__ void stage_rc(int b, int& R, int& C) { const int st = b / 1024, sb = b % 1024, swz = sb ^ (((sb >> 9) & 1) << 5); R = (st >> 1) * 16 + swz / 64; C = (st & 1) * 32 + (swz % 64) / 2; }
__host__ __device__ __forceinline__ int perm32(int rho) { const int n = rho >> 4, i = rho & 15; return 8 * (i >> 2) + 4 * n + (i & 3); }

struct Unit { int pm, pn; };
struct Gemm { const bf16_t* A; const bf16_t* Bt; int M, N, K, lda; };

struct StaticOrder {
    int nM, nN, nwg, G, c, skip;
    __host__ __device__ void init(int M, int N, int G_, int c_, int skip_ = 0) { nM = M / BM; nN = N / BM; nwg = nM * nN; G = G_; c = c_; skip = skip_; }
    __host__ __device__ bool next(int i, Unit& u) const {
        const long L = (long)i * G + c; if (L >= nwg) return false;
        int wgid = (int)L; { const int q = nwg / NXCD, r = nwg % NXCD, xcd = wgid % NXCD, off = wgid / NXCD; wgid = (xcd < r ? xcd * (q + 1) : r * (q + 1) + (xcd - r) * q) + off; }
        const int nig = WGM * nN, gid = wgid / nig, fm = gid * WGM, gsz = (nM - fm) < WGM ? (nM - fm) : WGM;
        u.pm = fm + ((wgid % nig) % gsz); u.pn = (wgid % nig) / gsz; if (skip) u.pm += u.pm / 16 + 1; return true;
    }
    __device__ __forceinline__ void a_ready(const Unit&) const {}
    __device__ __forceinline__ void done(const Unit&) const {}
};

__device__ __forceinline__ unsigned cvt_pk_bf16(float lo, float hi) { unsigned r; asm volatile("v_cvt_pk_bf16_f32 %0, %1, %2" : "=v"(r) : "v"(lo), "v"(hi)); return r; }
typedef float f32x2 __attribute__((ext_vector_type(2)));
struct EpiBf16 {
    static constexpr bool PERM = true, AFTER_DRAIN = false;
    bf16_t* O; int ldc; int act;
    __device__ __forceinline__ void operator()(const f32x4 (&acc)[2][2][4][2], const Unit& u, int wr, int wc, int fr, int fq) const {
        const int row0 = u.pm * BM + wr * 64 + fr; const int col0 = u.pn * BM + wc * 32 + 8 * fq;
        const bool sq = act == 2;
#pragma unroll
        for (int ai = 0; ai < 2; ++ai)
#pragma unroll
            for (int m = 0; m < 4; ++m) { bf16_t* rowp = O + (size_t)(row0 + ai * HALF + m * 16) * ldc + col0;
#pragma unroll
                for (int bj = 0; bj < 2; ++bj) { f32x4 v0 = acc[ai][bj][m][0], v1 = acc[ai][bj][m][1];
                    if (sq) {
#pragma unroll
                        for (int q = 0; q < 4; ++q) { const float a = v0[q] > 0.f ? v0[q] : 0.f, b = v1[q] > 0.f ? v1[q] : 0.f; v0[q] = a * a; v1[q] = b * b; } }
                    u32x4 w; w.x = cvt_pk_bf16(v0[0], v0[1]); w.y = cvt_pk_bf16(v0[2], v0[3]); w.z = cvt_pk_bf16(v1[0], v1[1]); w.w = cvt_pk_bf16(v1[2], v1[3]);
                    *(u32x4*)(rowp + bj * HALF) = w; } }
    }
};

template <class Epi, class Sched, bool ALIGN_EPI = false, bool SP2 = false>
__device__ __forceinline__ void gemm_phase(PG8_LAS unsigned char* lds, const Gemm g, const Sched& S, const Epi& E) {
    int tid_ = threadIdx.x; asm volatile("" : "+v"(tid_));
    const int tid = tid_, wid = __builtin_amdgcn_readfirstlane(tid >> 6), lane = tid & 63, wr = wid >> 2, wc = wid & 3, fr = lane & 15, fq = lane >> 4;
    const int K = g.K, nt = K / BK;
    unsigned voffA[2], voffB[2];
#pragma unroll
    for (int i = 0; i < 2; ++i) { int R, C; stage_rc(tid * 16 + i * 8192, R, C); const int Rb = Epi::PERM ? ((R & ~31) + perm32(R & 31)) : R;
        voffA[i] = (unsigned)(R * g.lda + C) * 2u; voffB[i] = (unsigned)(Rb * K + C) * 2u; }
    const size_t kstep = (size_t)(BK * 2);
    const size_t hstepA = (size_t)HALF * g.lda * 2, hstepB = (size_t)HALF * K * 2;
    const size_t tstepA = 2 * hstepA, tstepB = 2 * hstepB;
    const unsigned ldsw = (unsigned)wid * 1024u;
    const int aoff = lds_byte(wr * 64 + fr, fq * 8), boff = lds_byte(wc * 32 + fr, fq * 8);
#define PG8_SA(b, h) (((b) * 2 + (h)) * HTB)
#define PG8_SB(b, h) ((4 + (b) * 2 + (h)) * HTB)
#define PG8_STAGE(bufoff, gbase, voff) do { _Pragma("unroll") for (int _i = 0; _i < 2; ++_i) \
        __builtin_amdgcn_global_load_lds((const unsigned*)((const char*)(gbase) + (voff)[_i]), (PG8_LAS unsigned*)(lds + (bufoff) + ldsw + _i * 8192), 16, 0, 0); } while (0)
#define PG8_LDA(dst, b, h) do { _Pragma("unroll") for (int m = 0; m < 4; ++m) _Pragma("unroll") for (int k = 0; k < 2; ++k) dst[m][k] = *(const PG8_LAS bf16x8*)(lds + PG8_SA(b, h) + aoff + m * 2048 + k * 1024); } while (0)
#define PG8_LDB(dst, b, h) do { _Pragma("unroll") for (int n = 0; n < 2; ++n) _Pragma("unroll") for (int k = 0; k < 2; ++k) dst[n][k] = *(const PG8_LAS bf16x8*)(lds + PG8_SB(b, h) + boff + n * 2048 + k * 1024); } while (0)
#define PG8_MMA(ai, bj, At, Bt) do { __builtin_amdgcn_s_setprio(1); _Pragma("unroll") for (int m = 0; m < 4; ++m) _Pragma("unroll") for (int n = 0; n < 2; ++n) _Pragma("unroll") for (int k = 0; k < 2; ++k) \
        acc[ai][bj][m][n] = __builtin_amdgcn_mfma_f32_16x16x32_bf16(Bt[n][k], At[m][k], acc[ai][bj][m][n], 0, 0, 0); __builtin_amdgcn_s_setprio(0); } while (0)
#define PG8_WAIT_V(n) asm volatile("s_waitcnt vmcnt(" #n ")" ::: "memory")
#define PG8_WAIT_L(n) asm volatile("s_waitcnt lgkmcnt(" #n ")" ::: "memory")
#define PG8_BAR __builtin_amdgcn_s_barrier()
#define PG8_SCHED __builtin_amdgcn_sched_barrier(0)
    Unit cur, nxt; int ui = 0;
    if (!S.next(0, cur)) return;
    f32x4 acc[2][2][4][2];
#pragma unroll
    for (int a = 0; a < 2; ++a)
#pragma unroll
        for (int b = 0; b < 2; ++b)
#pragma unroll
            for (int m = 0; m < 4; ++m)
#pragma unroll
                for (int n = 0; n < 2; ++n) acc[a][b][m][n] = (f32x4){0.f, 0.f, 0.f, 0.f};
    bf16x8 At[4][2], B0[2][2], B1[2][2];
    const char* cA = (const char*)g.A + (size_t)cur.pm * tstepA; const char* cB = (const char*)g.Bt + (size_t)cur.pn * tstepB;
    S.a_ready(cur);
    if constexpr (SP2) {
        PG8_STAGE(PG8_SB(0, 0), cB, voffB); PG8_STAGE(PG8_SB(0, 1), cB + hstepB, voffB); PG8_STAGE(PG8_SA(0, 0), cA, voffA); PG8_STAGE(PG8_SA(0, 1), cA + hstepA, voffA);
        if (wr == 1) PG8_BAR;
        PG8_WAIT_V(2); PG8_BAR;
        PG8_STAGE(PG8_SB(1, 0), cB + kstep, voffB); PG8_STAGE(PG8_SA(1, 0), cA + kstep, voffA); PG8_STAGE(PG8_SB(1, 1), cB + hstepB + kstep, voffB);
        PG8_WAIT_V(6); PG8_BAR;
    } else {
        PG8_STAGE(PG8_SB(0, 0), cB, voffB); PG8_STAGE(PG8_SA(0, 0), cA, voffA); PG8_STAGE(PG8_SB(0, 1), cB + hstepB, voffB); PG8_STAGE(PG8_SA(0, 1), cA + hstepA, voffA);
        if (wr == 1) PG8_BAR;
        PG8_WAIT_V(4); PG8_BAR;
        PG8_STAGE(PG8_SB(1, 0), cB + kstep, voffB); PG8_STAGE(PG8_SA(1, 0), cA + kstep, voffA); PG8_STAGE(PG8_SB(1, 1), cB + hstepB + kstep, voffB);
        PG8_WAIT_V(6); PG8_BAR;
    }
    for (;;) {
        const bool has_next = S.next(ui + 1, nxt);
        const char* nA = has_next ? (const char*)g.A + (size_t)nxt.pm * tstepA : cA; const char* nB = has_next ? (const char*)g.Bt + (size_t)nxt.pn * tstepB : cB;

#pragma nounroll
        for (int t = 0; t < nt; t += 2) {
            const bool last = (t == nt - 2);
            const char* a1 = cA + (size_t)(t + 1) * kstep;
            const char* a2 = last ? nA : cA + (size_t)(t + 2) * kstep; const char* b2 = last ? nB : cB + (size_t)(t + 2) * kstep;
            const char* a3 = a2 + kstep; const char* b3 = b2 + kstep;
            if (last && has_next) S.a_ready(nxt);
            if constexpr (SP2) {
            PG8_LDB(B0, 0, 0); PG8_LDB(B1, 0, 1); PG8_SCHED; PG8_LDA(At, 0, 0); PG8_STAGE(PG8_SA(1, 1), a1 + hstepA, voffA);
            PG8_WAIT_V(8); PG8_WAIT_L(0); PG8_BAR; PG8_MMA(0, 0, At, B0); PG8_MMA(0, 1, At, B1); PG8_BAR; PG8_SCHED;
            PG8_LDA(At, 0, 1); PG8_STAGE(PG8_SB(0, 0), b2, voffB); PG8_STAGE(PG8_SB(0, 1), b2 + hstepB, voffB); PG8_STAGE(PG8_SA(0, 0), a2, voffA);
            PG8_WAIT_V(8); PG8_WAIT_L(0); PG8_BAR; PG8_MMA(1, 0, At, B0); PG8_MMA(1, 1, At, B1); PG8_BAR; PG8_SCHED;
            PG8_LDB(B0, 1, 0); PG8_LDB(B1, 1, 1); PG8_SCHED; PG8_LDA(At, 1, 0); PG8_STAGE(PG8_SA(0, 1), a2 + hstepA, voffA);
            PG8_WAIT_V(8); PG8_WAIT_L(0); PG8_BAR; PG8_MMA(0, 0, At, B0); PG8_MMA(0, 1, At, B1); PG8_BAR; PG8_SCHED;
            PG8_LDA(At, 1, 1); PG8_STAGE(PG8_SB(1, 0), b3, voffB); PG8_STAGE(PG8_SB(1, 1), b3 + hstepB, voffB); PG8_STAGE(PG8_SA(1, 0), a3, voffA);
            PG8_WAIT_V(8); PG8_WAIT_L(0); PG8_BAR; PG8_MMA(1, 0, At, B0); PG8_MMA(1, 1, At, B1); PG8_BAR; PG8_SCHED;
            } else {
            PG8_LDB(B0, 0, 0); PG8_SCHED; PG8_LDA(At, 0, 0); PG8_STAGE(PG8_SA(1, 1), a1 + hstepA, voffA);
            PG8_WAIT_L(8); PG8_BAR; PG8_WAIT_L(0); PG8_MMA(0, 0, At, B0); PG8_BAR; PG8_SCHED;
            PG8_LDB(B1, 0, 1); PG8_STAGE(PG8_SB(0, 0), b2, voffB);
            PG8_BAR; PG8_WAIT_L(0); PG8_MMA(0, 1, At, B1); PG8_BAR;
            PG8_LDA(At, 0, 1); PG8_STAGE(PG8_SA(0, 0), a2, voffA);
            PG8_BAR; PG8_WAIT_L(0); PG8_MMA(1, 0, At, B0); PG8_BAR; PG8_SCHED;
            PG8_STAGE(PG8_SB(0, 1), b2 + hstepB, voffB);
            PG8_WAIT_V(6); PG8_BAR; PG8_MMA(1, 1, At, B1); PG8_BAR;
            PG8_LDB(B0, 1, 0); PG8_SCHED; PG8_LDA(At, 1, 0); PG8_STAGE(PG8_SA(0, 1), a2 + hstepA, voffA);
            PG8_WAIT_L(8); PG8_BAR; PG8_WAIT_L(0); PG8_MMA(0, 0, At, B0); PG8_BAR; PG8_SCHED;
            PG8_LDB(B1, 1, 1); PG8_STAGE(PG8_SB(1, 0), b3, voffB);
            PG8_BAR; PG8_WAIT_L(0); PG8_MMA(0, 1, At, B1); PG8_BAR;
            PG8_LDA(At, 1, 1); PG8_STAGE(PG8_SA(1, 0), a3, voffA);
            PG8_BAR; PG8_WAIT_L(0); PG8_MMA(1, 0, At, B0); PG8_BAR; PG8_SCHED;
            PG8_STAGE(PG8_SB(1, 1), b3 + hstepB, voffB);
            PG8_WAIT_V(6); PG8_BAR; PG8_MMA(1, 1, At, B1); PG8_BAR;
            }
        }
        if constexpr (ALIGN_EPI) { if (wr == 0) PG8_BAR; }
        if constexpr (!Epi::AFTER_DRAIN) { E(acc, cur, wr, wc, fr, fq); S.done(cur); }
        if (!has_next) break;
#pragma unroll
        for (int a = 0; a < 2; ++a)
#pragma unroll
            for (int b = 0; b < 2; ++b)
#pragma unroll
                for (int m = 0; m < 4; ++m)
#pragma unroll
                    for (int n = 0; n < 2; ++n) acc[a][b][m][n] = (f32x4){0.f, 0.f, 0.f, 0.f};
        cur = nxt; cA = nA; cB = nB; ++ui;
        if constexpr (ALIGN_EPI) { if (wr == 1) PG8_BAR; }
    }
    PG8_WAIT_V(0);
    if constexpr (!ALIGN_EPI) { if (wr == 0) PG8_BAR; }
    PG8_BAR;
    if constexpr (Epi::AFTER_DRAIN) { E.fused(acc, cur, wr, wc, fr, fq, lds, wid, lane); S.done(cur); }
#undef PG8_SA
#undef PG8_SB
#undef PG8_STAGE
#undef PG8_LDA
#undef PG8_LDB
#undef PG8_MMA
#undef PG8_WAIT_V
#undef PG8_WAIT_L
#undef PG8_BAR
#undef PG8_SCHED
}
}
__device__ __forceinline__ unsigned long long rt() { return __builtin_amdgcn_s_memrealtime(); }
#define XB_TMO      128
#define XB_XCNT(j)  (256  + 64 * (j))
#define XB_XSUB(j)  (1280 + 64 * (j))
#define XB_XGEN(j)  (2304 + 64 * (j))
#define XB_TOP      3328
#define XB_TOPGEN   3392
#define XCD_BAR_WORDS 3456
#define XB_SPIN_CAP (1u << 22)

__device__ __forceinline__ unsigned xb_ld(unsigned* p)              { return __hip_atomic_load(p, __ATOMIC_RELAXED, __HIP_MEMORY_SCOPE_AGENT); }
__device__ __forceinline__ unsigned xb_add(unsigned* p, unsigned v) { return __hip_atomic_fetch_add(p, v, __ATOMIC_RELAXED, __HIP_MEMORY_SCOPE_AGENT); }
__device__ __forceinline__ unsigned xb_xcc_id() { return (unsigned)__builtin_amdgcn_s_getreg((3 << 11) | 20) & 0xFu; }
#define XB_SPIN(cond, bar) do { unsigned _sp = 0; while (cond) { __builtin_amdgcn_s_sleep(1); \
    if ((++_sp & 255u) == 0u) { if (xb_ld(&(bar)[XB_TMO])) break; if (_sp > XB_SPIN_CAP) { atomicAdd(&(bar)[XB_TMO], 1u); break; } } } } while (0)

struct XcdBarrier {
    unsigned* bar; unsigned x;
    volatile LAS unsigned* st;
};

__device__ __forceinline__ XcdBarrier xcd_barrier_post(unsigned* bar, volatile LAS unsigned* st) {
    XcdBarrier b; b.bar = bar; b.x = xb_xcc_id(); b.st = st;
    if (threadIdx.x == 0) (void)xb_add(&bar[XB_XCNT(b.x)], 1u);
    return b;
}
__device__ __forceinline__ void xcd_barrier_complete(unsigned* bar, unsigned x, unsigned& nloc, unsigned& nx) {
    const unsigned G = gridDim.x * gridDim.y * gridDim.z;
    unsigned sum, cnt, mine, sp = 0u;
    for (;;) {
        sum = 0u; cnt = 0u; mine = 0u;
#pragma unroll
        for (unsigned j = 0; j < 16; ++j) { const unsigned c = xb_ld(&bar[XB_XCNT(j)]); sum += c; cnt += (c > 0u) ? 1u : 0u; mine = (j == x) ? c : mine; }
        if (sum == G) break;
        __builtin_amdgcn_s_sleep(1);
        if ((++sp & 255u) == 0u) { if (xb_ld(&bar[XB_TMO])) break; if (sp > XB_SPIN_CAP) { atomicAdd(&bar[XB_TMO], 1u); break; } }
    }
    nloc = mine > 0u ? mine : 1u; nx = cnt > 0u ? cnt : 1u;
}

__device__ __forceinline__ void xcd_barrier(const XcdBarrier& b) {
    asm volatile("s_waitcnt vmcnt(0)" ::: "memory");
    __syncthreads();
    if (threadIdx.x == 0) {
        unsigned* bar = b.bar;
        __builtin_amdgcn_s_waitcnt(0);
        unsigned nloc = b.st[0], nx = b.st[1];
        if (nloc == 0u) { xcd_barrier_complete(bar, b.x, nloc, nx); b.st[0] = nloc; b.st[1] = nx; }
        const unsigned old = xb_add(&bar[XB_XSUB(b.x)], 1u);
        const unsigned gen = old / nloc;
        if (old + 1u == (gen + 1u) * nloc) {
            __builtin_amdgcn_fence(__ATOMIC_RELEASE, "agent");
            asm volatile("s_waitcnt vmcnt(0)" ::: "memory");
            const unsigned og = xb_add(&bar[XB_TOP], 1u);
            const unsigned tg = og / nx;
            if (og + 1u == (tg + 1u) * nx) xb_add(&bar[XB_TOPGEN], 1u);
            else XB_SPIN(xb_ld(&bar[XB_TOPGEN]) == tg, bar);
            __builtin_amdgcn_fence(__ATOMIC_ACQUIRE, "agent");
            xb_add(&bar[XB_XGEN(b.x)], 1u);
            asm volatile("s_waitcnt vmcnt(0)" ::: "memory");
        } else {
            XB_SPIN(xb_ld(&bar[XB_XGEN(b.x)]) == gen, bar);
            __builtin_amdgcn_fence(__ATOMIC_ACQUIRE, "agent");
            asm volatile("s_waitcnt vmcnt(0)" ::: "memory");
        }
    }
    __syncthreads();
}

struct Args {
    const float* in[24];
    float* out; unsigned char* ws;
    int ph_lo, ph_hi;
};
typedef const __attribute__((address_space(4))) Args CArgs;
enum InIdx { I_X = 0, I_C, I_CTX, I_CCTX, I_WADA, I_BADA, I_NMIXPRE, I_NMIXPOST, I_NMLPPRE, I_NMLPPOST, I_WIN, I_WOUT, I_GCONV, I_GALOG, I_GDT, I_GNORM,
             I_QNORM, I_KVNORM, I_WUQ, I_WUKV, I_LBLOG, I_HNORM, I_W1, I_W2 };

__device__ __forceinline__ const float* resid_in0(const float* x, const float* ctx, int row) {
    const int b = row / TPB, t = row - b * TPB;
    return t < CTXL ? ctx + ((size_t)b * CTXL + t) * DM : x + ((size_t)b * SEQ + (t - CTXL)) * DM;
}
__device__ __forceinline__ float* resid_ptr(float* out, float* xc, int row) {
    const int b = row / TPB, t = row - b * TPB;
    return t < CTXL ? xc + ((size_t)b * CTXL + t) * DM : out + ((size_t)b * SEQ + (t - CTXL)) * DM;
}
__device__ __forceinline__ int mod_row(int row) { const int b = row / TPB, t = row - b * TPB; return t < CTXL ? 8 : b; }

__device__ __forceinline__ void transpose_item(const float* W, int K, int ldsrc, int nsrc, bool zmap, const float* gain, bf16* WT, LAS float* scr, int item, int nblk, int lane) {
    const int kb = item / nblk, nb = item % nblk, k0 = 32 * kb, n0 = 64 * nb;
    const int np = n0 + lane; int src = zmap ? zcol_src(np) : np; if (src >= nsrc) src = -1;
#pragma unroll 8
    for (int kk = 0; kk < 32; ++kk) { float v = 0.f; if (src >= 0) { v = W[(size_t)(k0 + kk) * ldsrc + src]; if (gain) v *= gain[k0 + kk]; } scr[kk * 65 + lane] = v; }
    LDS_WAIT(); asm volatile("" ::: "memory");
    const int c = lane & 3;
#pragma unroll
    for (int j = 0; j < 4; ++j) { const int n = (lane >> 2) + 16 * j; const LAS float* s = scr + (8 * c) * 65 + n;
        v4u o; o.x = pk2(s[0 * 65], s[1 * 65]); o.y = pk2(s[2 * 65], s[3 * 65]); o.z = pk2(s[4 * 65], s[5 * 65]); o.w = pk2(s[6 * 65], s[7 * 65]);
        *(GAS v4u*)(WT + (size_t)(n0 + n) * K + k0 + 8 * c) = o; }
    LDS_WAIT(); asm volatile("" ::: "memory");
}
__device__ __forceinline__ void p0a_prologue(CArgs& a, LAS unsigned char* lds, int vcu, int G, int wave, int lane, int tid) {
    LAS float* scr = (LAS float*)(lds + wave * 8320);
    const int gw = vcu * NWAVES + wave, NGW = G * NWAVES;
    constexpr int I_IN = (DM / 32) * (ZLD / 64), I_OUT = (DM / 32) * (DM / 64), I_1 = (DM / 32) * (DFF / 64), I_2 = (DFF / 32) * (DM / 64), I_UQ = (256 / 32) * (512 / 64), I_UKV = (128 / 32) * (512 / 64);
    constexpr int PER_LAYER = I_IN + I_OUT + I_1 + I_2 + I_UQ + I_UKV;
    for (int it = gw; it < DEPTH * PER_LAYER; it += NGW) {
        const int l = it / PER_LAYER; int r = it - l * PER_LAYER;
        unsigned char* wb = a.ws + WS_W + (size_t)l * W_LAYER;
        if (r < I_IN) { transpose_item(a.in[I_WIN] + (size_t)l * DM * DIN, DM, DIN, DIN, true, nullptr, (bf16*)(wb + W_IN), scr, r, ZLD / 64, lane); continue; } r -= I_IN;
        if (r < I_OUT) { transpose_item(a.in[I_WOUT] + (size_t)l * DM * DM, DM, DM, DM, false, nullptr, (bf16*)(wb + W_OUT), scr, r, DM / 64, lane); continue; } r -= I_OUT;
        if (r < I_1) { transpose_item(a.in[I_W1] + (size_t)l * DM * DFF, DM, DFF, DFF, false, nullptr, (bf16*)(wb + W_1), scr, r, DFF / 64, lane); continue; } r -= I_1;
        if (r < I_2) { transpose_item(a.in[I_W2] + (size_t)l * DFF * DM, DFF, DM, DM, false, nullptr, (bf16*)(wb + W_2), scr, r, DM / 64, lane); continue; } r -= I_2;
        if (r < I_UQ) { transpose_item(a.in[I_WUQ] + (size_t)l * 256 * 384, 256, 384, 384, false, a.in[I_QNORM] + l * 256, (bf16*)(wb + W_UQ), scr, r, 512 / 64, lane); continue; } r -= I_UQ;
        transpose_item(a.in[I_WUKV] + (size_t)l * 128 * 512, 128, 512, 512, false, a.in[I_KVNORM] + l * 128, (bf16*)(wb + W_UKV), scr, r, 512 / 64, lane);
    }
    {
        const int gt = vcu * (NWAVES * 64) + tid, NGT = G * NWAVES * 64;
        float* rc = (float*)(a.ws + WS_ROPE); float* rs = rc + SEQ * 16;
        for (int i = gt; i < SEQ * 16; i += NGT) { const int t = i >> 4, j = i & 15, f = j & 7;
            const float inv = exp2f(-(float)f * 0.125f * 13.287712379549449f);
            const float pos = (float)(j < 8 ? (t >> 6) : (t & 63)); const float ang = pos * inv;
            rc[i] = cosf(ang); rs[i] = sinf(ang); }
        float* lb = (float*)(a.ws + WS_LB);
        for (int i = gt; i < 2 * 1024; i += NGT) { const int l = i >> 10, j = i & 1023;
            const float l0 = a.in[I_LBLOG][j], l1 = a.in[I_LBLOG][1024 + j];
            lb[i] = l == 0 ? 0.f : 1.0f / (1.0f + expf(l0 - l1)); }
    }
    if (vcu < 192) {
        LAS float* sc = (LAS float*)(lds + 69632);
        LAS float* red = (LAS float*)(lds + 106496);
        __syncthreads();
        for (int i = tid; i < 9 * 1024; i += 512) { const int r = i >> 10, k = i & 1023; const float v = r < 8 ? a.in[I_C][r * 1024 + k] : a.in[I_CCTX][k]; sc[i] = siluf_(v); }
        __syncthreads();
        const int l = vcu / 96, n = (vcu % 96) * 64 + lane;
        const float* w = a.in[I_WADA] + (size_t)l * DM * 6 * DM + n + (size_t)(wave * 128) * 6 * DM;
        float acc[9];
#pragma unroll
        for (int r = 0; r < 9; ++r) acc[r] = 0.f;
#pragma unroll 16
        for (int k = 0; k < 128; ++k) { const float wv = w[(size_t)k * 6 * DM];
#pragma unroll
            for (int r = 0; r < 9; ++r) acc[r] += sc[r * 1024 + wave * 128 + k] * wv; }
#pragma unroll
        for (int r = 0; r < 9; ++r) red[(wave * 9 + r) * 64 + lane] = acc[r];
        __syncthreads();
        if (wave == 0) {
            const float bv = a.in[I_BADA][l * 6 * DM + n];
            float* mods = (float*)(a.ws + WS_MODS) + (size_t)l * 9 * 6 * DM;
#pragma unroll
            for (int r = 0; r < 9; ++r) { float t = bv;
#pragma unroll
                for (int q = 0; q < 8; ++q) t += red[(q * 9 + r) * 64 + lane];
                mods[(size_t)r * 6 * DM + n] = t; }
        }
    }
}

__device__ __forceinline__ void norm_mod_store(const f32x4 (&v)[4], const float* gain, const float* sh, const float* sc, bf16* orow, int lane) {
    float ss = 0.f;
#pragma unroll
    for (int j = 0; j < 4; ++j) ss += (v[j].x * v[j].x + v[j].y * v[j].y) + (v[j].z * v[j].z + v[j].w * v[j].w);
    const float rstd = rsqrtf(wave_sum(ss) * (1.f / DM) + EPS);
    GAS v2u* o8 = (GAS v2u*)orow + lane;
#pragma unroll
    for (int j = 0; j < 4; ++j) { const int c = 4 * lane + 256 * j;
        const f32x4 g = *(const f32x4*)(gain + c), s1 = *(const f32x4*)(sh + c), s2 = *(const f32x4*)(sc + c);
        f32x4 h; h.x = v[j].x * rstd * g.x * (1.f + s2.x) + s1.x; h.y = v[j].y * rstd * g.y * (1.f + s2.y) + s1.y; h.z = v[j].z * rstd * g.z * (1.f + s2.z) + s1.z; h.w = v[j].w * rstd * g.w * (1.f + s2.w) + s1.w;
        v2u w; w.x = pk2(h.x, h.y); w.y = pk2(h.z, h.w); o8[64 * j] = w; }
}
__device__ __forceinline__ void p0b_prenorm(CArgs& a, int gw, int NGW, int lane) {
    const float* mods = (const float*)(a.ws + WS_MODS);
    bf16* HB = (bf16*)(a.ws + WS_HB);
    for (int row0 = gw; row0 < MT; row0 += 2 * NGW) {
        f32x4 v[2][4]; int rw[2]; bool ok[2];
#pragma unroll
        for (int u = 0; u < 2; ++u) { rw[u] = row0 + u * NGW; ok[u] = rw[u] < MT; if (!ok[u]) rw[u] = row0;
            const GAS f32x4* xr = (const GAS f32x4*)resid_in0(a.in[I_X], a.in[I_CTX], rw[u]) + lane;
#pragma unroll
            for (int j = 0; j < 4; ++j) v[u][j] = xr[64 * j]; }
#pragma unroll
        for (int u = 0; u < 2; ++u) if (ok[u]) { const float* m = mods + (size_t)mod_row(rw[u]) * 6 * DM;
            norm_mod_store(v[u], a.in[I_NMIXPRE], m, m + DM, HB + (size_t)rw[u] * DM, lane); }
    }
}
__device__ __forceinline__ void post_pass(CArgs& a, int layer, int which, int gw, int NGW, int lane) {
    const float* mods = (const float*)(a.ws + WS_MODS) + (size_t)layer * 9 * 6 * DM;
    bf16* HB = (bf16*)(a.ws + WS_HB); float* xc = (float*)(a.ws + WS_XC);
    const float* gpost = (which == 0 ? a.in[I_NMIXPOST] : a.in[I_NMLPPOST]) + layer * DM;
    const bool has_next = (which == 0) || (layer + 1 < DEPTH);
    const float* gnext = which == 0 ? a.in[I_NMLPPRE] + layer * DM : a.in[I_NMIXPRE] + (layer + 1) * DM;
    for (int row0 = gw; row0 < MT; row0 += 2 * NGW) {
        int rw[2], mr[2]; bool ok[2]; const float* m[2]; f32x4 y[2][4], x[2][4]; float ss[2];
#pragma unroll
        for (int u = 0; u < 2; ++u) { rw[u] = row0 + u * NGW; ok[u] = rw[u] < MT; if (!ok[u]) rw[u] = row0; mr[u] = mod_row(rw[u]);
            if (layer == DEPTH - 1 && mr[u] == 8) ok[u] = false;
            m[u] = mods + (size_t)mr[u] * 6 * DM; }
#pragma unroll
        for (int u = 0; u < 2; ++u) if (ok[u]) {
            const GAS v2u* yr = (const GAS v2u*)(HB + (size_t)rw[u] * DM) + lane;
            const float* xin = (layer == 0 && which == 0) ? resid_in0(a.in[I_X], a.in[I_CTX], rw[u]) : resid_ptr(a.out, xc, rw[u]);
            ss[u] = 0.f;
#pragma unroll
            for (int j = 0; j < 4; ++j) { const v2u w = yr[64 * j]; y[u][j] = (f32x4){bflo(w.x), bfhi(w.x), bflo(w.y), bfhi(w.y)}; x[u][j] = *((const GAS f32x4*)xin + lane + 64 * j); } }
#pragma unroll
        for (int u = 0; u < 2; ++u) if (ok[u]) {
#pragma unroll
            for (int j = 0; j < 4; ++j) ss[u] += (y[u][j].x * y[u][j].x + y[u][j].y * y[u][j].y) + (y[u][j].z * y[u][j].z + y[u][j].w * y[u][j].w);
            const float rstd = rsqrtf(wave_sum(ss[u]) * (1.f / DM) + EPS);
            const float* gate = m[u] + (which == 0 ? 2 : 5) * DM; float* xout = resid_ptr(a.out, xc, rw[u]);
#pragma unroll
            for (int j = 0; j < 4; ++j) { const int c = 4 * lane + 256 * j; const f32x4 gp = *(const f32x4*)(gpost + c), gt = *(const f32x4*)(gate + c);
                x[u][j].x += gt.x * (y[u][j].x * rstd * gp.x); x[u][j].y += gt.y * (y[u][j].y * rstd * gp.y); x[u][j].z += gt.z * (y[u][j].z * rstd * gp.z); x[u][j].w += gt.w * (y[u][j].w * rstd * gp.w);
                *((GAS f32x4*)xout + lane + 64 * j) = x[u][j]; }
            if (has_next) {
                const float* mn = which == 0 ? m[u] : (const float*)(a.ws + WS_MODS) + ((size_t)(layer + 1) * 9 + mr[u]) * 6 * DM;
                const float* sh = mn + (which == 0 ? 3 : 0) * DM; const float* sc = mn + (which == 0 ? 4 : 1) * DM;
                norm_mod_store(x[u], gnext, sh, sc, HB + (size_t)rw[u] * DM, lane);
            }
        }
    }
}
__device__ __forceinline__ void mla_rope_pass(CArgs& a, LAS unsigned char* lds, int wave, int gw, int NGW, int lane) {
    bf16* HB = (bf16*)(a.ws + WS_HB); const bf16* Z = (const bf16*)(a.ws + WS_Z);
    const float* rc = (const float*)(a.ws + WS_ROPE); const float* rs = rc + SEQ * 16;
    LAS bf16* raw = (LAS bf16*)(lds + wave * 2432);
    LAS float* cs = (LAS float*)(raw + 1056);
    int role, src, hf = 0;
    if (lane < 24) { const int h = lane / 6, blk = lane - 6 * h; if (blk < 4) { role = 0; src = h * 96 + blk * 16; } else { role = 1; src = h * 96 + 64; hf = blk - 4; } }
    else if (lane < 48) { const int l2 = lane - 24, h = l2 / 6, blk = l2 - 6 * h; if (blk < 4) { role = 2; src = 512 + h * 128 + blk * 16; } else { role = 3; src = 1024; hf = blk - 4; } }
    else { const int l3 = lane - 48, h = l3 >> 2, blk = l3 & 3; role = 4; src = 512 + h * 128 + 64 + blk * 16; }
    for (int row = gw; row < MT; row += NGW) {
        const int b = row / TPB, t = row - b * TPB; const bool lat = t >= CTXL; const int tp = lat ? t - CTXL : 0;
        const GAS v4u* hr = (const GAS v4u*)(HB + (size_t)row * DM);
        const v4u r0 = hr[lane], r1 = hr[64 + lane];
        const bf16* zr = Z + (size_t)row * ZLD;
        const v2u cq = *((const GAS v2u*)(zr + ZC_CQ) + lane); const unsigned ckv = *((const GAS unsigned*)(zr + ZC_CKV) + lane);
        unsigned krw = 0u; float csv = 0.f;
        if (lane < 16) krw = *((const GAS unsigned*)(zr + ZC_KR) + lane);
        if (lane < 32) csv = (lane < 16 ? rc : rs)[tp * 16 + (lane & 15)];
        const float s1 = bflo(cq.x) * bflo(cq.x) + bfhi(cq.x) * bfhi(cq.x) + bflo(cq.y) * bflo(cq.y) + bfhi(cq.y) * bfhi(cq.y);
        const float s2 = bflo(ckv) * bflo(ckv) + bfhi(ckv) * bfhi(ckv);
        const float sq = rsqrtf(wave_sum(s1) * (1.f / 256.f) + EPS) * ATT_C2, skv = rsqrtf(wave_sum(s2) * (1.f / 128.f) + EPS);
        *((LAS v4u*)raw + lane) = r0; *((LAS v4u*)raw + 64 + lane) = r1;
        if (lane < 16) *((LAS unsigned*)(raw + 1024) + lane) = krw;
        if (lane < 32) cs[lane] = csv;
        VM_WAIT(); LDS_WAIT(); asm volatile("" ::: "memory");
        float v[16];
        { const v4u a0 = *(const LAS v4u*)(raw + src), a1 = *(const LAS v4u*)(raw + src + 8);
          const unsigned aw[8] = {a0.x, a0.y, a0.z, a0.w, a1.x, a1.y, a1.z, a1.w};
#pragma unroll
          for (int e = 0; e < 8; ++e) { v[2 * e] = bflo(aw[e]); v[2 * e + 1] = bfhi(aw[e]); } }
        if ((role == 1 || role == 3) && lat) {
            const v4u b0 = *(const LAS v4u*)(raw + src + 16), b1 = *(const LAS v4u*)(raw + src + 24);
            const unsigned bw[8] = {b0.x, b0.y, b0.z, b0.w, b1.x, b1.y, b1.z, b1.w};
#pragma unroll
            for (int e = 0; e < 16; ++e) { const float t1 = v[e], t2 = (e & 1) ? bfhi(bw[e >> 1]) : bflo(bw[e >> 1]), c = cs[e], sn = cs[16 + e];
                v[e] = hf == 0 ? t1 * c - t2 * sn : t1 * sn + t2 * c; }
        } else if ((role == 1 || role == 3) && hf == 1) {
            const v4u b0 = *(const LAS v4u*)(raw + src + 16), b1 = *(const LAS v4u*)(raw + src + 24);
            const unsigned bw[8] = {b0.x, b0.y, b0.z, b0.w, b1.x, b1.y, b1.z, b1.w};
#pragma unroll
            for (int e = 0; e < 8; ++e) { v[2 * e] = bflo(bw[e]); v[2 * e + 1] = bfhi(bw[e]); }
        }
        const float scl = role < 2 ? sq : (role == 3 ? 1.0f : skv);
        unsigned ow[8];
#pragma unroll
        for (int e = 0; e < 8; ++e) ow[e] = pk2(v[2 * e] * scl, v[2 * e + 1] * scl);
        GAS v4u* orow = (GAS v4u*)(HB + (size_t)row * DM) + 2 * lane;
        orow[0] = (v4u){ow[0], ow[1], ow[2], ow[3]}; orow[1] = (v4u){ow[4], ow[5], ow[6], ow[7]};
        LDS_WAIT(); asm volatile("" ::: "memory");
    }
}

namespace att {
constexpr int KT_BYTES = 12288, VT_BYTES = 8192, SLOT = KT_BYTES + VT_BYTES, WS_OFF = 2 * SLOT;
__device__ __forceinline__ int crow(int r, int hi) { return (r & 3) + 8 * (r >> 2) + 4 * hi; }
#define ATT_WAIT_BAR() asm volatile("s_waitcnt vmcnt(0) lgkmcnt(0)\n\ts_barrier" ::: "memory")
__device__ __forceinline__ float rowmax32(const f32x16& p0, const f32x16& p1) {
    float m = fmaxf(p0[0], p1[0]);
#pragma unroll
    for (int r = 1; r < 16; ++r) m = fmaxf(m, fmaxf(p0[r], p1[r]));
    return max_xor32(m);
}
__device__ __forceinline__ unsigned cvtpk(float lo, float hi) { unsigned r; asm volatile("v_cvt_pk_bf16_f32 %0, %1, %2" : "=v"(r) : "v"(lo), "v"(hi)); return r; }
__device__ __forceinline__ void att_dma(const bf16* HB, LAS unsigned char* lds, int rowb, int h, int t, int slot, int wid, int lane) {
    const bf16* kv = HB + (size_t)(rowb + 64 * t) * DM;
#pragma unroll
    for (int i = 0; i < 3; ++i) { const int p = wid + 8 * i;
        if (p < 12) __builtin_amdgcn_global_load_lds((const unsigned*)(kv + (size_t)lane * DM + HB_K + h * 96 + p * 8), (LAS unsigned*)(lds + slot * SLOT + p * 1024), 16, 0, 0);
        else if (p < 20) { const int pv_ = p - 12, dh = pv_ >> 2, rg = pv_ & 3;
            __builtin_amdgcn_global_load_lds((const unsigned*)(kv + (size_t)(16 * rg + (lane >> 2)) * DM + HB_V + h * 64 + dh * 32 + (lane & 3) * 8), (LAS unsigned*)(lds + slot * SLOT + KT_BYTES + pv_ * 1024), 16, 0, 0); } }
}
__device__ __forceinline__ void attn_unit(int b, int h, int qb, const bf16* HB, bf16* Z, LAS unsigned char* lds) {
    int tid_ = threadIdx.x; asm volatile("" : "+v"(tid_)); const int tid = tid_, lane = tid & 63, r32 = lane & 31, hi = lane >> 5; const int wid = __builtin_amdgcn_readfirstlane(tid >> 6);
    const int rowb = b * TPB; const int row0 = rowb + 256 * qb + 32 * wid;
    const int NT = qb == 0 ? CTXL / 64 : TPB / 64;
    LAS float* wsf = (LAS float*)(lds + WS_OFF + wid * 256);
    const unsigned lds0 = (unsigned)(uintptr_t)lds;
    att_dma(HB, lds, rowb, h, 0, 0, wid, lane);
    bf16x8 qr[6];
#pragma unroll
    for (int d0 = 0; d0 < 6; ++d0) qr[d0] = *(const bf16x8*)(HB + (size_t)(row0 + r32) * DM + HB_Q + h * 96 + d0 * 16 + hi * 8);
    float mref = -1e30f, lsum = 0.f; f32x16 o[2]; o[0] = f32x16{}; o[1] = f32x16{};
    ATT_WAIT_BAR();
    for (int t = 0; t < NT; ++t) {
        const int slot = t & 1;
        if (t + 1 < NT) att_dma(HB, lds, rowb, h, t + 1, slot ^ 1, wid, lane);
        f32x16 p0 = f32x16{}, p1 = f32x16{};
        { const LAS unsigned char* kb = lds + slot * SLOT + hi * 1024 + r32 * 16;
#pragma unroll
          for (int d0 = 0; d0 < 6; ++d0) { const bf16x8 k0 = *(const LAS bf16x8*)(kb + d0 * 2048), k1 = *(const LAS bf16x8*)(kb + d0 * 2048 + 512);
              p0 = __builtin_amdgcn_mfma_f32_32x32x16_bf16(k0, qr[d0], p0, 0, 0, 0); p1 = __builtin_amdgcn_mfma_f32_32x32x16_bf16(k1, qr[d0], p1, 0, 0, 0); } }
        const float rm = rowmax32(p0, p1);
        if (__any(rm > mref + 8.0f)) {
            const float mn = fmaxf(mref, rm), al = __builtin_amdgcn_exp2f(mref - mn); mref = mn; lsum *= al;
            if (hi == 0) wsf[r32] = al;
            LDS_WAIT(); asm volatile("" ::: "memory");
#pragma unroll
            for (int r = 0; r < 16; ++r) { const float f = wsf[crow(r, hi)]; o[0][r] *= f; o[1][r] *= f; }
            LDS_WAIT(); asm volatile("" ::: "memory");
        }
        float sacc = 0.f;
#pragma unroll
        for (int r = 0; r < 16; ++r) { p0[r] = __builtin_amdgcn_exp2f(p0[r] - mref); p1[r] = __builtin_amdgcn_exp2f(p1[r] - mref); sacc += p0[r] + p1[r]; }
        lsum += sacc;
        v4u pw[4];
#pragma unroll
        for (int k = 0; k < 2; ++k) { pw[k] = (v4u){cvtpk(p0[8 * k], p0[8 * k + 1]), cvtpk(p0[8 * k + 2], p0[8 * k + 3]), cvtpk(p0[8 * k + 4], p0[8 * k + 5]), cvtpk(p0[8 * k + 6], p0[8 * k + 7])};
            pw[2 + k] = (v4u){cvtpk(p1[8 * k], p1[8 * k + 1]), cvtpk(p1[8 * k + 2], p1[8 * k + 3]), cvtpk(p1[8 * k + 4], p1[8 * k + 5]), cvtpk(p1[8 * k + 6], p1[8 * k + 7])}; }
        { const int vb = (int)(lds0 + slot * SLOT + KT_BYTES) + ((lane >> 4) & 1) * 32 + (lane & 3) * 8 + (4 * hi + ((lane & 15) >> 2)) * 64;
#pragma unroll
          for (int d0 = 0; d0 < 2; ++d0) { s16x4 lo[4], hh[4];
#pragma unroll
              for (int ks = 0; ks < 4; ++ks) {
                  asm volatile("ds_read_b64_tr_b16 %0,%1 offset:%c2" : "=&v"(lo[ks]) : "v"(vb), "i"(d0 * 4096 + ks * 1024) : "memory");
                  asm volatile("ds_read_b64_tr_b16 %0,%1 offset:%c2" : "=&v"(hh[ks]) : "v"(vb), "i"(d0 * 4096 + ks * 1024 + 512) : "memory"); }
              asm volatile("s_waitcnt lgkmcnt(0)" ::: "memory"); __builtin_amdgcn_sched_barrier(0);
#pragma unroll
              for (int ks = 0; ks < 4; ++ks) { const bf16x8 vf = (bf16x8){lo[ks][0], lo[ks][1], lo[ks][2], lo[ks][3], hh[ks][0], hh[ks][1], hh[ks][2], hh[ks][3]};
                  o[d0] = __builtin_amdgcn_mfma_f32_32x32x16_bf16(__builtin_bit_cast(bf16x8, pw[ks]), vf, o[d0], 0, 0, 0); } } }
        ATT_WAIT_BAR();
    }
    lsum = add_xor32(lsum);
    if (hi == 0) wsf[32 + r32] = lsum;
    LDS_WAIT(); asm volatile("" ::: "memory");
#pragma unroll
    for (int r = 0; r < 16; ++r) { const int q = crow(r, hi); const float inv = 1.0f / wsf[32 + q];
        bf16* op = Z + (size_t)(row0 + q) * ZLD + ZC_CQ + h * 64 + r32;
        op[0] = (bf16)f2bf(o[0][r] * inv); op[32] = (bf16)f2bf(o[1][r] * inv); }
    ATT_WAIT_BAR();
}
}

constexpr int NCHUNK = MT / 64;
__device__ __forceinline__ void gdn_halo_copy(CArgs& a, int gw, int NGW, int lane) {
    const bf16* Z = (const bf16*)(a.ws + WS_Z); bf16* HL = (bf16*)(a.ws + WS_HALO);
    for (int it = gw; it < NCHUNK * 4; it += NGW) {
        const int cg = it >> 2, slot = it & 3, b = cg / 68, c = cg - b * 68;
        const int lo = c < 4 ? 0 : CTXL, hi = c < 4 ? CTXL : TPB;
        const int t = 64 * c + (slot < 2 ? slot - 2 : 62 + slot);
        const bool ok = t >= lo && t < hi;
        const GAS v4u* src = (const GAS v4u*)(Z + ((size_t)b * TPB + (ok ? t : 64 * c)) * ZLD);
        GAS v4u* dst = (GAS v4u*)(HL + (size_t)it * 1536);
#pragma unroll
        for (int j = 0; j < 3; ++j) { v4u v = src[lane + 64 * j]; if (!ok) v = (v4u){0u, 0u, 0u, 0u}; dst[lane + 64 * j] = v; }
    }
}
__device__ __forceinline__ void gdn_conv_pass(CArgs& a, LAS unsigned char* lds, int layer, int vcu, int G) {
    int tid_ = threadIdx.x; asm volatile("" : "+v"(tid_)); const int tid = tid_, lane = tid & 63, wave = tid >> 6;
    bf16* Z = (bf16*)(a.ws + WS_Z); const bf16* HL = (const bf16*)(a.ws + WS_HALO); float* BG = (float*)(a.ws + WS_BG);
    LAS bf16* RAW = (LAS bf16*)lds;
    const int h = vcu & 3;
    float cw[5][3][2];
#pragma unroll
    for (int j = 0; j < 5; ++j)
#pragma unroll
        for (int sg = 0; sg < 3; ++sg) { const float* p = a.in[I_GCONV] + (size_t)layer * 5 * 1536 + j * 1536 + sg * 512 + h * 128 + 2 * lane; cw[j][sg][0] = p[0]; cw[j][sg][1] = p[1]; }
    float A_[2], dtb[2];
#pragma unroll
    for (int d = 0; d < 2; ++d) { A_[d] = __expf(a.in[I_GALOG][layer * 8 + d * 4 + h]); dtb[d] = a.in[I_GDT][layer * 8 + d * 4 + h]; }
    for (int u = vcu; u < NCHUNK * 4; u += G) {
        const int cg = u >> 2; const size_t row0 = (size_t)cg * 64;
        __syncthreads();
        for (int idx = tid; idx < 68 * 48; idx += 512) { const int rr = idx / 48, ch = idx - rr * 48; const int colz = (ch >> 4) * 512 + h * 128 + (ch & 15) * 8;
            const bf16* src = (rr >= 2 && rr < 66) ? Z + (row0 + rr - 2) * ZLD + colz : HL + ((size_t)cg * 4 + (rr < 2 ? rr : rr - 64)) * 1536 + colz;
            *(LAS v4u*)(RAW + rr * 384 + ch * 8) = *(const GAS v4u*)src; }
        if (tid < 128) { const int i = tid & 63, dir = tid >> 6; const bf16* zr = Z + (row0 + i) * ZLD;
            const float zb = bf2f(zr[ZC_GB + dir * 4 + h]), za = bf2f(zr[ZC_GA + dir * 4 + h]);
            float* o = BG + ((row0 + i) * 4 + h) * 4 + dir * 2; o[0] = sigmoidf_(zb); o[1] = -(dir ? A_[1] : A_[0]) * softplusf_(za + (dir ? dtb[1] : dtb[0])); }
        __syncthreads();
        float win[5][3][2];
#pragma unroll
        for (int j = 0; j < 4; ++j)
#pragma unroll
            for (int sg = 0; sg < 3; ++sg) { const unsigned wv = *(const LAS unsigned*)(RAW + (8 * wave + j) * 384 + sg * 128 + 2 * lane); win[j + 1][sg][0] = bflo(wv); win[j + 1][sg][1] = bfhi(wv); }
#pragma unroll
        for (int tt = 0; tt < 8; ++tt) { const int i = 8 * wave + tt;
#pragma unroll
            for (int j = 0; j < 4; ++j)
#pragma unroll
                for (int sg = 0; sg < 3; ++sg) { win[j][sg][0] = win[j + 1][sg][0]; win[j][sg][1] = win[j + 1][sg][1]; }
#pragma unroll
            for (int sg = 0; sg < 3; ++sg) { const unsigned wv = *(const LAS unsigned*)(RAW + (i + 4) * 384 + sg * 128 + 2 * lane); win[4][sg][0] = bflo(wv); win[4][sg][1] = bfhi(wv); }
            float y[3][2];
#pragma unroll
            for (int sg = 0; sg < 3; ++sg)
#pragma unroll
                for (int e = 0; e < 2; ++e) { float acc = 0.f;
#pragma unroll
                    for (int j = 0; j < 5; ++j) acc += cw[j][sg][e] * win[j][sg][e];
                    y[sg][e] = siluf_(acc); }
            const float sq = rsqrtf(wave_sum(y[0][0] * y[0][0] + y[0][1] * y[0][1]) + 1e-6f) * 0.08838834764831845f, sk = rsqrtf(wave_sum(y[1][0] * y[1][0] + y[1][1] * y[1][1]) + 1e-6f);
            bf16* zr = Z + (row0 + i) * ZLD + h * 128 + 2 * lane;
            *(unsigned*)(zr + ZC_GQ) = pk2(y[0][0] * sq, y[0][1] * sq); *(unsigned*)(zr + ZC_GK) = pk2(y[1][0] * sk, y[1][1] * sk); *(unsigned*)(zr + ZC_GV) = pk2(y[2][0], y[2][1]); }
    }
}

namespace gdn1 {
typedef short v4i16 __attribute__((ext_vector_type(4)));
constexpr int LD = 136, LDT = 72;
constexpr int KB_OFF = 0, QB_OFF = 17408, VB_OFF = 34816, SB_OFF = 52224, WB_OFF = 87040, TB_OFF = 104448, AQ_OFF = 113664, LB_OFF = 122880, LDG_OFF = 132096  ,
              XS_OFF = 136448  , YS_OFF = 137984  , SC_OFF = 140544  , SS_OFF = 141888  , END_OFF = 142912;
__device__ __forceinline__ int crow(int r, int hi) { return (r & 3) + 8 * (r >> 2) + 4 * hi; }
__device__ __forceinline__ s16x4 trr(const LAS bf16* p) { return __builtin_bit_cast(s16x4, __builtin_amdgcn_ds_read_tr16_b64_v4i16((LAS v4i16*)p)); }
__device__ __forceinline__ bf16x8 frag_rk(const LAS bf16* base, int ld, int row0, int k0, int lane) { return *(const LAS bf16x8*)(base + (row0 + (lane & 31)) * ld + k0 + 8 * (lane >> 5)); }
__device__ __forceinline__ bf16x8 frag_kr(const LAS bf16* base, int ld, int k0, int x0, int lane) {
    const LAS bf16* p = base + (k0 + 8 * (lane >> 5) + ((lane & 15) >> 2)) * ld + x0 + 16 * ((lane >> 4) & 1) + 4 * (lane & 3);
    const s16x4 lo = trr(p), hi = trr(p + 4 * ld);
    return (bf16x8){lo[0], lo[1], lo[2], lo[3], hi[0], hi[1], hi[2], hi[3]}; }
__device__ __forceinline__ void cstore(const f32x16& acc, LAS bf16* base, int ld, int row0, int col0, int lane, float sgn) {
    const int hi = lane >> 5, l31 = lane & 31;
#pragma unroll
    for (int r = 0; r < 16; ++r) base[(row0 + crow(r, hi)) * ld + col0 + l31] = (bf16)f2bf(sgn * acc[r]); }
#define MFMA32(a, b, c) __builtin_amdgcn_mfma_f32_32x32x16_bf16(a, b, c, 0, 0, 0)
#define SB() __builtin_amdgcn_sched_barrier(0)

__device__ __forceinline__ void chain(CArgs& a, LAS unsigned char* lds, int layer, int b, int h, int dir) {
    int tid0_ = threadIdx.x; asm volatile("" : "+v"(tid0_)); const int w = __builtin_amdgcn_readfirstlane(tid0_ >> 6);
    bf16* Z = (bf16*)(a.ws + WS_Z); bf16* OS = (bf16*)(a.ws + WS_OSG);
    unsigned* hcnt = (unsigned*)(a.ws + WS_CTL) + CW_HOFF_G + (layer * 32 + b * 4 + h) * 68; unsigned* hrdy = hcnt + 8192;  const float* BG = (const float*)(a.ws + WS_BG);
    LAS bf16* Kb = (LAS bf16*)(lds + KB_OFF); LAS bf16* Qb = (LAS bf16*)(lds + QB_OFF); LAS bf16* Vb = (LAS bf16*)(lds + VB_OFF); LAS bf16* Sb = (LAS bf16*)(lds + SB_OFF);
    LAS bf16* Wb = (LAS bf16*)(lds + WB_OFF); LAS bf16* Tb = (LAS bf16*)(lds + TB_OFF); LAS bf16* Aq = (LAS bf16*)(lds + AQ_OFF); LAS bf16* Lb = (LAS bf16*)(lds + LB_OFF);
    LAS float* Ldg = (LAS float*)(lds + LDG_OFF); LAS bf16* XS = (LAS bf16*)(lds + XS_OFF); LAS bf16* YS = (LAS bf16*)(lds + YS_OFF);
    LAS float* bet = (LAS float*)(lds + SC_OFF); LAS float* gc = bet + 64; LAS float* eg = bet + 128; LAS float* ekl = bet + 192; LAS float* bes = bet + 256; LAS float* egl = bet + 320;
    LAS float* SS = (LAS float*)(lds + SS_OFF); LAS float* DUM = (LAS float*)(lds + END_OFF);
    const size_t rowb = (size_t)b * TPB;
    const int tr = w >> 2, tc = w & 3;
    const int sr = w >> 1, sc0 = 2 * (w & 1);
    const float gnv = a.in[I_GNORM][layer * 128 + 32 * tc + (tid0_ & 31)];
    {
        f32x16 accS[2]; accS[0] = f32x16{}; accS[1] = f32x16{};
        __syncthreads();
        { int tid_ = threadIdx.x; asm volatile("" : "+v"(tid_)); const int tid = tid_;
        for (int i = tid; i < 128 * LD / 2; i += 512) ((LAS unsigned*)Sb)[i] = 0u;
        for (int i = tid; i < 64 * LDT / 2; i += 512) ((LAS unsigned*)Tb)[i] = 0u; }
        v4u pf[6]; float pbg0 = 0.f, pbg1 = 0.f; int plo = 0, phi = -1; bool drain = false;
#define GDN_T0(step) (64 * ((step) < 4 ? (dir ? 3 - (step) : (step)) : 4 + (dir ? 63 - ((step) - 4) : (step) - 4)))
#define GDN_PREFETCH(step) do { const int t0n = GDN_T0(step); const bf16* zb_ = Z + (rowb + t0n) * ZLD + h * 128; \
            _Pragma("unroll") for (int m = 0; m < 6; ++m) { const int idx = tid + 512 * m, mat = idx >> 10, rem = idx & 1023, i = rem >> 4, ch = rem & 15; \
                pf[m] = *(const GAS v4u*)(zb_ + (unsigned)((dir ? 63 - i : i) * ZLD + mat * 512 + ch * 8)); } \
            if (w == 7) { const float* p = BG + (rowb + t0n) * 16 + h * 4 + dir * 2 + (unsigned)((dir ? 63 - lane : lane) * 16); pbg0 = p[0]; pbg1 = p[1]; } } while (0)
#define GDN_COMMIT() do { \
            _Pragma("unroll") for (int m = 0; m < 6; ++m) { const int idx = tid + 512 * m, mat = idx >> 10, rem = idx & 1023, i = rem >> 4, ch = rem & 15; \
                *(LAS v4u*)((mat == 0 ? Qb : (mat == 1 ? Kb : Vb)) + i * LD + ch * 8) = pf[m]; } \
            if (w == 7) { const float v = wave_incl_scan(pbg1); \
                const float gl = __builtin_bit_cast(float, __builtin_amdgcn_readlane(__builtin_bit_cast(int, v), 63)); const float e = __expf(v); \
                bet[lane] = pbg0; gc[lane] = v; eg[lane] = e; ekl[lane] = __expf(gl - v); bes[lane] = pbg0 * e; if (lane == 0) egl[0] = __expf(gl); } } while (0)
        { int tid_ = threadIdx.x; asm volatile("" : "+v"(tid_)); const int tid = tid_, lane = tid & 63;
          GDN_PREFETCH(0);
          GDN_COMMIT(); }
        __syncthreads();
        for (int step = 0; step < 68; ++step) {
            int tid_ = threadIdx.x; asm volatile("" : "+v"(tid_)); const int tid = tid_, lane = tid & 63, l31 = lane & 31, hi = lane >> 5;
            const int t0 = GDN_T0(step);
            const bool want = !(layer == DEPTH - 1 && step < 4);
            const int cix = t0 >> 6;
            const bool second = (step < 4) ? (step >= 2) : (step >= 36);
            if (w == 5 && lane == 0) {
                if (phi >= plo) { __builtin_amdgcn_fence(__ATOMIC_RELEASE, "agent"); asm volatile("s_waitcnt vmcnt(0)" ::: "memory");
                    for (int st = plo; st <= phi; ++st) { const bool fst = (st < 4) ? (st < 2) : (st < 36); if (fst && !(layer == DEPTH - 1 && st < 4)) __hip_atomic_store(hrdy + (GDN_T0(st) >> 6), 1u, RLX_AGENT); } }
                if (want && second) { unsigned sp = 0; while (__hip_atomic_load(hrdy + cix, RLX_AGENT) == 0u && ++sp < (1u << 22)) __builtin_amdgcn_s_sleep(2);
                    __builtin_amdgcn_fence(__ATOMIC_ACQUIRE, "agent"); asm volatile("s_waitcnt vmcnt(0)" ::: "memory"); }
            }
            if (phi >= plo) plo = phi + 1;
            if (step + 1 < 68) GDN_PREFETCH(step + 1);
            {   const int ti = (w >> 1) & 1, tj = w & 1; const LAS bf16* src = w < 4 ? Kb : Qb;
                f32x16 acc = f32x16{};
                if (!(ti == 0 && tj == 1)) {
#pragma unroll
                    for (int hf = 0; hf < 2; ++hf) { bf16x8 fa[4], fb[4];
#pragma unroll
                        for (int s = 0; s < 4; ++s) { fa[s] = frag_rk(src, LD, 32 * ti, 64 * hf + 16 * s, lane); fb[s] = frag_rk(Kb, LD, 32 * tj, 64 * hf + 16 * s, lane); }
                        SB();
#pragma unroll
                        for (int s = 0; s < 4; ++s) acc = MFMA32(fa[s], fb[s], acc);
                        SB(); } }
                const int j = 32 * tj + l31; const float gcj = gc[j];
                if (w < 4) {
                    const bool dg = ti == tj;
#pragma unroll
                    for (int r = 0; r < 16; ++r) { const int i = 32 * ti + crow(r, hi); const float e = __expf(gc[i] - gcj);
                        const float val = i > j ? bet[i] * acc[r] * e : 0.f; Lb[i * LDT + j] = (bf16)f2bf(val);
                        const bool d16 = dg && ((r >> 3) == (l31 >> 4));
                        (d16 ? Ldg + ((i >> 4) * 16 + (i & 15)) * 17 + (j & 15) : DUM + lane)[0] = val; }
                } else {
#pragma unroll
                    for (int r = 0; r < 16; ++r) { const int i = 32 * ti + crow(r, hi); const float e = __expf(gc[i] - gcj);
                        const float val = i >= j ? acc[r] * e : 0.f; Aq[i * LDT + j] = (bf16)f2bf(val); } }
            }
            LBAR();
            if (w < 4) {
                const int c = lane & 15; float t[16];
#pragma unroll
                for (int i = 0; i < 16; ++i) { float s = (i == c) ? 1.f : 0.f;
#pragma unroll
                    for (int j = 0; j < i; ++j) s -= Ldg[(w * 16 + i) * 17 + j] * t[j];
                    t[i] = s; }
                if (lane < 16) {
#pragma unroll
                    for (int i = 0; i < 16; ++i) Tb[(16 * w + i) * LDT + 16 * w + c] = (bf16)f2bf(t[i]); }
            } else {
                const int t2 = tid - 256, row = t2 >> 2, c0 = (t2 & 3) * 32; const float bv = bet[row];
#pragma unroll
                for (int q = 0; q < 4; ++q) { LAS v4u* p = (LAS v4u*)(Vb + row * LD + c0 + 8 * q); v4u v = *p;
                    v.x = pk2(bflo(v.x) * bv, bfhi(v.x) * bv); v.y = pk2(bflo(v.y) * bv, bfhi(v.y) * bv); v.z = pk2(bflo(v.z) * bv, bfhi(v.z) * bv); v.w = pk2(bflo(v.w) * bv, bfhi(v.w) * bv); *p = v; }
            }
            LBAR();
            if (w < 2) {
                const int p = w, r16 = lane & 15, g = lane >> 4, g1 = g & 1; const bool act = g < 2;
                typedef float f32x4_ __attribute__((ext_vector_type(4)));
                bf16x8 af = *(const LAS bf16x8*)(Lb + (32 * p + 16 + r16) * LDT + 32 * p + 8 * g1), bfr;
#pragma unroll
                for (int j = 0; j < 8; ++j) bfr[j] = (short)Tb[(32 * p + 8 * g1 + j) * LDT + 32 * p + r16];
                if (!act) { af = bf16x8{}; bfr = bf16x8{}; }
                f32x4_ x = __builtin_amdgcn_mfma_f32_16x16x32_bf16(af, bfr, (f32x4_){0.f, 0.f, 0.f, 0.f}, 0, 0, 0);
                LAS bf16* xs = XS + p * 16 * 24;
#pragma unroll
                for (int q = 0; q < 4; ++q) xs[(4 * g + q) * 24 + r16] = (bf16)f2bf(x[q]);
                LDS_WAIT(); asm volatile("" ::: "memory");
                af = *(const LAS bf16x8*)(Tb + (32 * p + 16 + r16) * LDT + 32 * p + 16 + 8 * g1);
#pragma unroll
                for (int j = 0; j < 8; ++j) bfr[j] = (short)xs[(8 * g1 + j) * 24 + r16];
                if (!act) { af = bf16x8{}; bfr = bf16x8{}; }
                const f32x4_ tt = __builtin_amdgcn_mfma_f32_16x16x32_bf16(af, bfr, (f32x4_){0.f, 0.f, 0.f, 0.f}, 0, 0, 0);
#pragma unroll
                for (int q = 0; q < 4; ++q) Tb[(32 * p + 16 + 4 * g + q) * LDT + 32 * p + r16] = (bf16)f2bf(-tt[q]);
            }
            LBAR();
            if (w == 0) {
                f32x16 y = f32x16{};
#pragma unroll
                for (int s = 0; s < 2; ++s) y = MFMA32(frag_rk(Lb, LDT, 32, 16 * s, lane), frag_kr(Tb, LDT, 16 * s, 0, lane), y);
                cstore(y, YS, 40, 0, 0, lane, 1.f);
                LDS_WAIT(); asm volatile("" ::: "memory");
                f32x16 z = f32x16{};
#pragma unroll
                for (int s = 0; s < 2; ++s) z = MFMA32(frag_rk(Tb, LDT, 32, 32 + 16 * s, lane), frag_kr(YS, 40, 16 * s, 0, lane), z);
                cstore(z, Tb, LDT, 32, 0, lane, -1.f);
            }
            LBAR();
            f32x16 accU = f32x16{};
            {   f32x16 accW = f32x16{};
                const int ns = tr == 0 ? 2 : 4;
                bf16x8 ta[4], tw[4], fv[4], fk[4];
#pragma unroll
                for (int s = 0; s < 4; ++s) if (s < ns) { ta[s] = frag_rk(Tb, LDT, 32 * tr, 16 * s, lane); fv[s] = frag_kr(Vb, LD, 16 * s, 32 * tc, lane); fk[s] = frag_kr(Kb, LD, 16 * s, 32 * tc, lane); }
                SB();
#pragma unroll
                for (int s = 0; s < 4; ++s) if (s < ns) { const LAS float* bs = bes + 16 * s + 8 * hi;
#pragma unroll
                    for (int j = 0; j < 8; ++j) tw[s][j] = (short)f2bf(bf2f((unsigned short)ta[s][j]) * bs[j]); }
#pragma unroll
                for (int s = 0; s < 4; ++s) if (s < ns) { accU = MFMA32(ta[s], fv[s], accU); accW = MFMA32(tw[s], fk[s], accW); }
                SB();
                cstore(accW, Wb, LD, 32 * tr, 32 * tc, lane, 1.f);
            }
            LBAR();
            unsigned short osv[16];
            if (want && second) {
                const bf16* ob_ = OS + (rowb + t0) * 512 + h * 128 + 32 * tc;
#pragma unroll
                for (int r = 0; r < 16; ++r) { const int i = 32 * tr + crow(r, hi), tk = dir ? 63 - i : i; osv[r] = ob_[(unsigned)(tk * 512 + l31)]; }
            }
            {   f32x16 ws = f32x16{};
#pragma unroll
                for (int hf = 0; hf < 2; ++hf) { bf16x8 fa[4], fb[4];
#pragma unroll
                  for (int s = 0; s < 4; ++s) { fa[s] = frag_rk(Wb, LD, 32 * tr, 64 * hf + 16 * s, lane); fb[s] = frag_kr(Sb, LD, 64 * hf + 16 * s, 32 * tc, lane); }
                  SB();
#pragma unroll
                  for (int s = 0; s < 4; ++s) ws = MFMA32(fa[s], fb[s], ws);
                  SB(); }
#pragma unroll
                for (int r = 0; r < 16; ++r) accU[r] -= ws[r];
                cstore(accU, Vb, LD, 32 * tr, 32 * tc, lane, 1.f);
                const int row = tid >> 3, c0 = (tid & 7) * 16; const float kv = ekl[row];
#pragma unroll
                for (int q = 0; q < 2; ++q) { LAS v4u* p = (LAS v4u*)(Kb + row * LD + c0 + 8 * q); v4u v = *p;
                    v.x = pk2(bflo(v.x) * kv, bfhi(v.x) * kv); v.y = pk2(bflo(v.y) * kv, bfhi(v.y) * kv); v.z = pk2(bflo(v.z) * kv, bfhi(v.z) * kv); v.w = pk2(bflo(v.w) * kv, bfhi(v.w) * kv); *p = v; }
            }
            LBAR();
            unsigned short gtv[16];
            if (want && second) {
                const bf16* gb_ = Z + (rowb + t0) * ZLD + ZC_GG + h * 128 + 32 * tc;
#pragma unroll
                for (int r = 0; r < 16; ++r) { const int i = 32 * tr + crow(r, hi), tk = dir ? 63 - i : i; gtv[r] = gb_[(unsigned)(tk * ZLD + l31)]; }
            }
            if (drain) VM_WAIT();
            f32x16 o = f32x16{};
            {
#pragma unroll
                for (int hf = 0; hf < 2; ++hf) { bf16x8 fa[4], fb[4];
#pragma unroll
                  for (int s = 0; s < 4; ++s) { fa[s] = frag_rk(Qb, LD, 32 * tr, 64 * hf + 16 * s, lane); fb[s] = frag_kr(Sb, LD, 64 * hf + 16 * s, 32 * tc, lane); }
                  SB();
#pragma unroll
                  for (int s = 0; s < 4; ++s) o = MFMA32(fa[s], fb[s], o);
                  SB(); }
#pragma unroll
                for (int r = 0; r < 16; ++r) o[r] *= eg[32 * tr + crow(r, hi)];
                const int ns = tr == 0 ? 2 : 4;
                const float el = egl[0];
                { bf16x8 fq[4], fv[4];
#pragma unroll
                  for (int s = 0; s < 4; ++s) if (s < ns) { fq[s] = frag_rk(Aq, LDT, 32 * tr, 16 * s, lane); fv[s] = frag_kr(Vb, LD, 16 * s, 32 * tc, lane); }
                  SB();
#pragma unroll
                  for (int s = 0; s < 4; ++s) if (s < ns) o = MFMA32(fq[s], fv[s], o);
                  SB(); }
#pragma unroll
                for (int r = 0; r < 16; ++r) { accS[0][r] *= el; accS[1][r] *= el; }
#pragma unroll
                for (int hf = 0; hf < 2; ++hf) { bf16x8 fk[2], fv0[2], fv1[2];
#pragma unroll
                  for (int s = 0; s < 2; ++s) { const int k0 = 32 * hf + 16 * s; fk[s] = frag_kr(Kb, LD, k0, 32 * sr, lane); fv0[s] = frag_kr(Vb, LD, k0, 32 * sc0, lane); fv1[s] = frag_kr(Vb, LD, k0, 32 * (sc0 + 1), lane); }
                  SB();
#pragma unroll
                  for (int s = 0; s < 2; ++s) { accS[0] = MFMA32(fk[s], fv0[s], accS[0]); accS[1] = MFMA32(fk[s], fv1[s], accS[1]); }
                  SB(); }
            }
            if (want) {
                if (!second) { bf16* ob_ = OS + (rowb + t0) * 512 + h * 128 + 32 * tc;
#pragma unroll
                    for (int r = 0; r < 16; ++r) { const int i = 32 * tr + crow(r, hi), tk = dir ? 63 - i : i; ob_[(unsigned)(tk * 512 + l31)] = (bf16)f2bf(o[r]); }
                } else {
                    float q[16], t[16];
#pragma unroll
                    for (int r = 0; r < 16; ++r) { o[r] += bf2f(osv[r]); q[r] = row_sum16(o[r] * o[r]); }
#pragma unroll
                    for (int r = 0; r < 16; ++r) t[r] = swz_xor<16>(q[r]);
#pragma unroll
                    for (int r = 0; r < 16; ++r) SS[(32 * tr + crow(r, hi)) * 4 + tc] = q[r] + t[r];
                }
            }
            LBAR();
            cstore(accS[0], Sb, LD, 32 * sr, 32 * sc0, lane, 1.f); cstore(accS[1], Sb, LD, 32 * sr, 32 * (sc0 + 1), lane, 1.f);
            if (want && second) { bf16* gb_ = Z + (rowb + t0) * ZLD + ZC_GG + h * 128 + 32 * tc;
#pragma unroll
                for (int r = 0; r < 16; ++r) { const int i = 32 * tr + crow(r, hi), tk = dir ? 63 - i : i; const f32x4 p4 = *(const LAS f32x4*)(SS + i * 4);
                    const float rs = rsqrtf(((p4.x + p4.y) + (p4.z + p4.w)) * (1.f / 128.f) + EPS);
                    gb_[(unsigned)(tk * ZLD + l31)] = (bf16)f2bf(o[r] * rs * gnv * siluf_(bf2f(gtv[r]))); }
            }
            if (step + 1 < 68) GDN_COMMIT();
            {   const bool mine = want && !second, urgent = mine && (step == 1 || step == 35);
                if (urgent) VM_WAIT();
                if (urgent) phi = step; else if (drain) phi = step - 1;
                drain = mine && !urgent; }
            LBAR();
        }
    }
#undef GDN_T0
#undef GDN_PREFETCH
#undef GDN_COMMIT
}
}

namespace hg1 {
using gdn1::crow; using gdn1::frag_rk; using gdn1::frag_kr; using gdn1::cstore;
constexpr int LD = 136, LDV = 72;
constexpr int A_OFF = 0  , B_OFF = 43520, K_OFF = 60928, V_OFF = 78336, S_OFF = 87552  , AT_OFF = 105984, TOT_OFF = 115200  , EBL_OFF = 117248  , SS_OFF = 117760  ;
__device__ __forceinline__ int arow(int J) { return J == 0 ? 0 : (J == 1 ? 64 : (J == 2 ? 112 : 144)); }
__device__ __forceinline__ void chain(CArgs& a, LAS unsigned char* lds, int layer, int b, int h, int dir) {
    int tid0_ = threadIdx.x; asm volatile("" : "+v"(tid0_)); const int w = __builtin_amdgcn_readfirstlane(tid0_ >> 6);
    bf16* Z = (bf16*)(a.ws + WS_Z); bf16* OS = (bf16*)(a.ws + WS_OSH);
    unsigned* hcnt = (unsigned*)(a.ws + WS_CTL) + CW_HOFF_H + (layer * 32 + b * 4 + h) * 68; unsigned* hrdy = hcnt + 8192; const float* LB = (const float*)(a.ws + WS_LB);
    LAS bf16* Ab = (LAS bf16*)(lds + A_OFF); LAS bf16* Bm = (LAS bf16*)(lds + B_OFF); LAS bf16* Kt = (LAS bf16*)(lds + K_OFF); LAS bf16* Vb = (LAS bf16*)(lds + V_OFF);
    LAS bf16* Sb = (LAS bf16*)(lds + S_OFF); LAS bf16* At = (LAS bf16*)(lds + AT_OFF); LAS float* tot = (LAS float*)(lds + TOT_OFF); LAS float* ebl = (LAS float*)(lds + EBL_OFF); LAS float* SS = (LAS float*)(lds + SS_OFF);
    const size_t rowb = (size_t)b * TPB;
    const int mblk = w >> 1;
    const int sr = w >> 1, sc = w & 1;
    const int tr = (w >> 1) & 1, tc = w & 1;
    const float hnv = a.in[I_HNORM][layer * 64 + 32 * tc + (tid0_ & 31)];
    {
        f32x16 accS = f32x16{};
        const int zf = dir ? ZC_HFB : ZC_HFF;
        __syncthreads();
        { int tid_ = threadIdx.x; asm volatile("" : "+v"(tid_)); const int tid = tid_;
          for (int i = tid; i < 128 * LDV / 2; i += 512) ((LAS unsigned*)Sb)[i] = 0u;
          for (int i = tid; i < 64 * LDV / 2; i += 512) ((LAS unsigned*)At)[i] = 0u; }
        unsigned short pxq[16], pxf[16]; v4u pv; int plo = 0, phi = -1; bool drain = false;
#define HG_T0(step) (64 * ((step) < 4 ? (dir ? 3 - (step) : (step)) : 4 + (dir ? 63 - ((step) - 4) : (step) - 4)))
#define HG_PREFETCH(step) do { const int t0n = HG_T0(step); const bf16* zb_ = Z + (rowb + t0n) * ZLD + h * 128 + (tid & 127); \
            _Pragma("unroll") for (int ii = 0; ii < 16; ++ii) { const int i = 16 * mblk + ii; const unsigned off_ = (unsigned)((dir ? 63 - i : i) * ZLD); pxq[ii] = zb_[off_ + ZC_HQ]; pxf[ii] = zb_[off_ + zf]; } \
            { const int i = tid >> 3, ch = tid & 7; pv = *(const GAS v4u*)(Z + (rowb + t0n) * ZLD + ZC_HI + h * 64 + (unsigned)((dir ? 63 - i : i) * ZLD + ch * 8)); } } while (0)
        { int tid_ = threadIdx.x; asm volatile("" : "+v"(tid_)); const int tid = tid_; HG_PREFETCH(0); }
        __syncthreads();
        for (int step = 0; step < 68; ++step) {
            int tid_ = threadIdx.x; asm volatile("" : "+v"(tid_)); const int tid = tid_, lane = tid & 63, l31 = lane & 31, hi = lane >> 5;
            const int t0 = HG_T0(step);
            const bool want = !(layer == DEPTH - 1 && step < 4);
            const int cix = t0 >> 6;
            const bool second = (step < 4) ? (step >= 2) : (step >= 36);
            const int d = tid & 127;
            float lc[16], qv[16], kv[16];
            {   const float lbv = LB[layer * 1024 + dir * 512 + h * 128 + d], olb = 1.0f - lbv; float run = 0.f;
#pragma unroll
                for (int ii = 0; ii < 16; ++ii) { const float x = fmaxf(bf2f(pxf[ii]), -80.f); const float ex = __expf(-x);
                    const float sg = __builtin_amdgcn_rcpf(1.0f + ex); run += __logf(lbv + olb * sg); lc[ii] = run;
                    kv[ii] = olb * (ex * sg);
                    qv[ii] = bf2f(pxq[ii]) * 0.08838834764831845f; }
                tot[mblk * 128 + d] = run;
#pragma unroll
                for (int ii = 0; ii < 16; ++ii) Bm[(16 * mblk + ii) * LD + d] = (bf16)f2bf(kv[ii] * __expf(fminf(-lc[ii], 80.f)));
                *(LAS v4u*)(Vb + (tid >> 3) * LDV + (tid & 7) * 8) = pv;
            }
            if (step + 1 < 68) HG_PREFETCH(step + 1);
            LBAR();
            if (drain) VM_WAIT();
            {   const float r1 = tot[d], r2 = r1 + tot[128 + d], r3 = r2 + tot[256 + d], bl = r3 + tot[384 + d];
                const float rm = mblk == 0 ? 0.f : (mblk == 1 ? r1 : (mblk == 2 ? r2 : r3));
                if (mblk == 0) ebl[d] = __expf(bl);
#pragma unroll
                for (int ii = 0; ii < 16; ++ii) Kt[(16 * mblk + ii) * LD + d] = (bf16)f2bf(kv[ii] * __expf((bl - rm) - lc[ii]));
#pragma unroll
                for (int J = 0; J < 4; ++J) if (J <= mblk) { const float off = rm - (J == 0 ? 0.f : (J == 1 ? r1 : (J == 2 ? r2 : r3)));
#pragma unroll
                    for (int ii = 0; ii < 16; ++ii) Ab[(arow(J) + 16 * (mblk - J) + ii) * LD + d] = (bf16)f2bf(qv[ii] * __expf(off + lc[ii])); }
            }
            LBAR();
            if (drain) { phi = step - 1; drain = false; }
            if (w == 7 && lane == 0) {
                if (phi >= plo) { __builtin_amdgcn_fence(__ATOMIC_RELEASE, "agent"); asm volatile("s_waitcnt vmcnt(0)" ::: "memory");
                    for (int st = plo; st <= phi; ++st) { const bool fst = (st < 4) ? (st < 2) : (st < 36); if (fst && !(layer == DEPTH - 1 && st < 4)) __hip_atomic_store(hrdy + (HG_T0(st) >> 6), 1u, RLX_AGENT); } }
                if (want && second) { unsigned sp = 0; while (__hip_atomic_load(hrdy + cix, RLX_AGENT) == 0u && ++sp < (1u << 22)) __builtin_amdgcn_s_sleep(2);
                    __builtin_amdgcn_fence(__ATOMIC_ACQUIRE, "agent"); asm volatile("s_waitcnt vmcnt(0)" ::: "memory"); }
            }
            if (phi >= plo) plo = phi + 1;
            for (int idx = w; idx < 10; idx += 8) {
                const int I = idx >= 6 ? 3 : (idx >= 3 ? 2 : (idx >= 1 ? 1 : 0)), J = idx - (I * (I + 1)) / 2;
                const int r16 = lane & 15, g = lane >> 4;
                f32x4 acc = (f32x4){0.f, 0.f, 0.f, 0.f};
                const LAS bf16* ap = Ab + (arow(J) + 16 * (I - J) + r16) * LD + 8 * g; const LAS bf16* bp = Bm + (16 * J + r16) * LD + 8 * g;
                { bf16x8 fa[4], fb[4];
#pragma unroll
                  for (int s = 0; s < 4; ++s) { fa[s] = *(const LAS bf16x8*)(ap + 32 * s); fb[s] = *(const LAS bf16x8*)(bp + 32 * s); }
                  SB();
#pragma unroll
                  for (int s = 0; s < 4; ++s) acc = __builtin_amdgcn_mfma_f32_16x16x32_bf16(fa[s], fb[s], acc, 0, 0, 0);
                  SB(); }
#pragma unroll
                for (int q = 0; q < 4; ++q) { const int ri = 4 * g + q; const float v = (I != J || ri >= r16) ? acc[q] : 0.f; At[(16 * I + ri) * LDV + 16 * J + r16] = (bf16)f2bf(v); }
            }
            LBAR();
            unsigned short osv[16], gtv[16];
            if (want && second && w < 4) {
                const bf16* ob_ = OS + (rowb + t0) * 256 + h * 64 + 32 * tc; const bf16* gb_ = Z + (rowb + t0) * ZLD + ZC_HG + h * 64 + 32 * tc;
#pragma unroll
                for (int r = 0; r < 16; ++r) { const int i = 32 * tr + crow(r, hi), tk = dir ? 63 - i : i; osv[r] = ob_[(unsigned)(tk * 256 + l31)]; gtv[r] = gb_[(unsigned)(tk * ZLD + l31)]; }
            }
            f32x16 o = f32x16{};
            if (w < 4) {
                { bf16x8 fa[8], fb[8];
#pragma unroll
                  for (int s = 0; s < 8; ++s) { fa[s] = frag_rk(Ab, LD, 32 * tr, 16 * s, lane); fb[s] = frag_kr(Sb, LDV, 16 * s, 32 * tc, lane); }
                  SB();
#pragma unroll
                  for (int s = 0; s < 8; ++s) o = MFMA32(fa[s], fb[s], o);
                  SB(); }
                const int ns = tr == 0 ? 2 : 4;
                { bf16x8 fa[4], fb[4];
#pragma unroll
                  for (int s = 0; s < 4; ++s) if (s < ns) { fa[s] = frag_rk(At, LDV, 32 * tr, 16 * s, lane); fb[s] = frag_kr(Vb, LDV, 16 * s, 32 * tc, lane); }
                  SB();
#pragma unroll
                  for (int s = 0; s < 4; ++s) if (s < ns) o = MFMA32(fa[s], fb[s], o);
                  SB(); }
            }
            {   bf16x8 fa[4], fb[4];
#pragma unroll
                for (int s = 0; s < 4; ++s) { fa[s] = frag_kr(Kt, LD, 16 * s, 32 * sr, lane); fb[s] = frag_kr(Vb, LDV, 16 * s, 32 * sc, lane); }
                SB();
#pragma unroll
                for (int r = 0; r < 16; ++r) accS[r] *= ebl[32 * sr + crow(r, hi)];
#pragma unroll
                for (int s = 0; s < 4; ++s) accS = MFMA32(fa[s], fb[s], accS);
                SB();
            }
            if (want && w < 4) {
                if (!second) { bf16* ob_ = OS + (rowb + t0) * 256 + h * 64 + 32 * tc;
#pragma unroll
                    for (int r = 0; r < 16; ++r) { const int i = 32 * tr + crow(r, hi), tk = dir ? 63 - i : i; ob_[(unsigned)(tk * 256 + l31)] = (bf16)f2bf(o[r]); }
                } else {
                    float q[16], t[16];
#pragma unroll
                    for (int r = 0; r < 16; ++r) { o[r] += bf2f(osv[r]); q[r] = row_sum16(o[r] * o[r]); }
#pragma unroll
                    for (int r = 0; r < 16; ++r) t[r] = swz_xor<16>(q[r]);
#pragma unroll
                    for (int r = 0; r < 16; ++r) SS[(32 * tr + crow(r, hi)) * 2 + tc] = q[r] + t[r];
                }
            }
            LBAR();
            cstore(accS, Sb, LDV, 32 * sr, 32 * sc, lane, 1.f);
            if (want && second && w < 4) { bf16* gb_ = Z + (rowb + t0) * ZLD + ZC_HG + h * 64 + 32 * tc;
#pragma unroll
                for (int r = 0; r < 16; ++r) { const int i = 32 * tr + crow(r, hi), tk = dir ? 63 - i : i;
                    const float rs = rsqrtf((SS[i * 2] + SS[i * 2 + 1]) * (1.f / 64.f) + EPS);
                    gb_[(unsigned)(tk * ZLD + l31)] = (bf16)f2bf(o[r] * rs * hnv * siluf_(bf2f(gtv[r]))); }
            }
            {   const bool mine = want && !second, urgent = mine && (step == 1 || step == 35);
                if (urgent) { VM_WAIT(); phi = step; }
                drain = mine && !urgent; }
            LBAR();
        }
    }
#undef HG_T0
#undef HG_PREFETCH
}
}

#ifndef PH_MASK
#define PH_MASK 0xFFFFF
#endif
#define PH_ON(i) (((PH_MASK) >> (i)) & 1)
constexpr int PH_PER_LAYER = 9, N_PHASES = 2 + DEPTH * PH_PER_LAYER;
enum PhaseKind { PK_GEMM_IN = 0, PK_MLA_UP, PK_MLA_ROPE, PK_MIX, PK_GEMM_OUT, PK_POST1, PK_MLP1, PK_MLP2, PK_POST2 };
constexpr int ATT_UNITS_LAT = NB * 4 * 16, ATT_UNITS_CTX = NB * 4;
__device__ __forceinline__ CArgs& kargs() { CArgs* p = (CArgs*)__builtin_amdgcn_kernarg_segment_ptr(); asm volatile("" : "+s"(p)); return *p; }

__global__ void __launch_bounds__(NWAVES * 64, 2) fwd_kernel(Args args_unused) {
    extern __shared__ __attribute__((aligned(16))) unsigned char lds_[];
    LAS unsigned char* lds = (LAS unsigned char*)lds_;
    {   const int tid = threadIdx.x;
        for (int u = tid; u < (LDS_BYTES - LDSCTL_OFF) / 4; u += NWAVES * 64) ((LAS unsigned*)(lds + LDSCTL_OFF))[u] = 0u; }
    __syncthreads();
    if (MK_ONE_LAUNCH) (void)xcd_barrier_post((unsigned*)(kargs().ws + WS_CTL) + CW_BAR, (volatile LAS unsigned*)(lds + MISC_OFF) + 8);
    const int ph_lo = kargs().ph_lo, ph_hi = kargs().ph_hi;
    int ph_start = ph_lo;
    if (ph_lo == 0) {
        CArgs& a = kargs();
        int tid_ = threadIdx.x; asm volatile("" : "+v"(tid_));
        const int tid = tid_, lane = tid & 63, wave = __builtin_amdgcn_readfirstlane(tid >> 6);
        const int G = gridDim.x, bx = blockIdx.x, vcu = (G % 8 == 0) ? (bx % 8) * (G / 8) + bx / 8 : bx;
        if constexpr (PH_ON(0)) p0a_prologue(a, lds, vcu, G, wave, lane, tid);
        if (1 < ph_hi) { XcdBarrier bar; bar.bar = (unsigned*)(kargs().ws + WS_CTL) + CW_BAR; bar.x = xb_xcc_id(); bar.st = (volatile LAS unsigned*)(lds + MISC_OFF) + 8; xcd_barrier(bar); }
        ph_start = 1;
    }
    for (int ph = ph_start; ph < ph_hi; ++ph) {
        CArgs& a = kargs();
        int tid_ = threadIdx.x; asm volatile("" : "+v"(tid_));
        const int tid = tid_, lane = tid & 63, wave = __builtin_amdgcn_readfirstlane(tid >> 6);
        const int G = gridDim.x, bx = blockIdx.x, vcu = (G % 8 == 0) ? (bx % 8) * (G / 8) + bx / 8 : bx;
        const int gw = vcu * NWAVES + wave, NGW = G * NWAVES;
        if (ph == 1) { if constexpr (PH_ON(1)) p0b_prenorm(a, gw, NGW, lane); }
        else {
            const int layer = (ph - 2) / PH_PER_LAYER, kind = (ph - 2) % PH_PER_LAYER;
            if (kind == PK_GEMM_IN || kind == PK_MLA_UP || kind == PK_GEMM_OUT || kind == PK_MLP1 || kind == PK_MLP2) {
                {
                    bf16* HB = (bf16*)(a.ws + WS_HB); bf16* Z = (bf16*)(a.ws + WS_Z);
                    const unsigned char* wb = a.ws + WS_W + (size_t)layer * W_LAYER;
                    pg8::StaticOrder S; const bool lastl = layer == DEPTH - 1;
#define RUN_GEMM(Aop, Bop, N_, K_, LDA_, Out, LDC_, ACT_) do { int kk_ = K_; asm volatile("" : "+s"(kk_)); const pg8::Gemm g{Aop, (const bf16*)(Bop), MT, N_, kk_, LDA_}; const pg8::EpiBf16 E{Out, LDC_, ACT_}; \
                        if (lastl && (ACT_ == 2 || (N_) == DM)) S.init(NB * SEQ, N_, G, bx, 1); else S.init(MT, N_, G, bx);   \
                        pg8::gemm_phase<pg8::EpiBf16, pg8::StaticOrder, true, true>(lds, g, S, E); } while (0)
                    if (kind == PK_GEMM_IN)     { if constexpr (PH_ON(2)) RUN_GEMM(HB, wb + W_IN, ZLD, DM, DM, Z, ZLD, 0); }
                    else if (kind == PK_MLA_UP) { if constexpr (PH_ON(3)) RUN_GEMM(Z + ZC_CQ, wb + W_UQ, 512, 256, ZLD, HB, DM, 0);
                                                  if constexpr (PH_ON(11)) RUN_GEMM(Z + ZC_CKV, wb + W_UKV, 512, 128, ZLD, HB + 512, DM, 0); }
                    else if (kind == PK_GEMM_OUT) { if constexpr (PH_ON(6)) RUN_GEMM(Z + ZC_GG, wb + W_OUT, DM, DM, ZLD, HB, DM, 0); }
                    else if (kind == PK_MLP1)   { if constexpr (PH_ON(8)) RUN_GEMM(HB, wb + W_1, DFF, DM, DM, Z, DFF, 2); }
                    else                        { if constexpr (PH_ON(9)) RUN_GEMM(Z, wb + W_2, DM, DFF, DFF, HB, DM, 0); }
#undef RUN_GEMM
                    if (kind == PK_MLA_UP) { if constexpr (PH_ON(3)) gdn_halo_copy(a, gw, NGW, lane); }
                }
            } else if (kind == PK_MLA_ROPE) { if constexpr (PH_ON(4)) { gdn_conv_pass(a, lds, layer, vcu, G); __syncthreads(); mla_rope_pass(a, lds, wave, gw, NGW, lane); } }
            else if (kind == PK_MIX) {
                if constexpr (PH_ON(5)) {
#ifndef MIX_PARTS
#define MIX_PARTS 7
#endif
                    if (bx < 64) { if constexpr (MIX_PARTS & 1) gdn1::chain(a, lds, layer, bx >> 3, (bx >> 1) & 3, bx & 1); }
                    else if (bx < 128) { if constexpr (MIX_PARTS & 2) hg1::chain(a, lds, layer, (bx - 64) >> 3, ((bx - 64) >> 1) & 3, bx & 1); }
                    __syncthreads();
                    CArgs& a2 = kargs(); int tq_ = threadIdx.x; asm volatile("" : "+v"(tq_));
                    volatile LAS unsigned* MISC = (volatile LAS unsigned*)(lds + MISC_OFF);
                    const bf16* HB = (const bf16*)(a2.ws + WS_HB); bf16* Z = (bf16*)(a2.ws + WS_Z); unsigned* qhead = (unsigned*)(a2.ws + WS_CTL) + CW_ATTQ + 64 * layer;
                    const int nunits = ATT_UNITS_LAT + (layer == DEPTH - 1 ? 0 : ATT_UNITS_CTX);
                    for (;;) {
                        if (tq_ == 0) MISC[0] = __hip_atomic_fetch_add(qhead, 1u, __ATOMIC_RELAXED, __HIP_MEMORY_SCOPE_AGENT);
                        __syncthreads();
                        const int u = (int)MISC[0];
                        __syncthreads();
                        if (u >= nunits) break;
                        int b, h, qb;
                        if (u < ATT_UNITS_LAT) { b = u >> 6; h = (u >> 4) & 3; qb = 1 + (u & 15); } else { const int uu = u - ATT_UNITS_LAT; b = uu >> 2; h = uu & 3; qb = 0; }
                        if constexpr (MIX_PARTS & 4) att::attn_unit(b, h, qb, HB, Z, lds);
                    }
                }
            }
            else if (kind == PK_POST1) { if constexpr (PH_ON(7)) post_pass(a, layer, 0, gw, NGW, lane); }
            else { if constexpr (PH_ON(10)) post_pass(a, layer, 1, gw, NGW, lane); }
        }
        if (ph + 1 < ph_hi) { XcdBarrier bar; bar.bar = (unsigned*)(kargs().ws + WS_CTL) + CW_BAR; bar.x = xb_xcc_id(); bar.st = (volatile LAS unsigned*)(lds + MISC_OFF) + 8; xcd_barrier(bar); }
    }
}

extern "C" void kernel_launch(void* const* d_in, const int* in_sizes, int n_in, void* d_out, int out_size, void* d_ws, size_t ws_size, hipStream_t stream) {
    static int grid = 0;
    if (grid == 0) {
        if (n_in != 24 || in_sizes[0] != NB * SEQ * DM || out_size != NB * SEQ * DM || ws_size < WS_END) {
            fprintf(stderr, "kernel_launch: unexpected shapes (n_in %d, in0 %d, out %d, ws %zu, need %zu); nothing launched\n", n_in, n_in > 0 ? in_sizes[0] : -1, out_size, ws_size, (size_t)WS_END); grid = -1; return; }
        int dev = 0, cus = 0, per_cu = 0;
        if (hipGetDevice(&dev) != hipSuccess || hipDeviceGetAttribute(&cus, hipDeviceAttributeMultiprocessorCount, dev) != hipSuccess) { fprintf(stderr, "kernel_launch: device query failed\n"); grid = -1; return; }
        if (hipFuncSetAttribute((const void*)fwd_kernel, hipFuncAttributeMaxDynamicSharedMemorySize, LDS_BYTES) != hipSuccess) { fprintf(stderr, "kernel_launch: hipFuncSetAttribute failed\n"); grid = -1; return; }
        if (hipOccupancyMaxActiveBlocksPerMultiprocessor(&per_cu, (const void*)fwd_kernel, NWAVES * 64, LDS_BYTES) != hipSuccess || per_cu < 1)
            fprintf(stderr, "kernel_launch: note: occupancy query reports %d workgroups per CU\n", per_cu);
        (void)hipGetLastError();
        grid = cus;
        if (grid < 192) { fprintf(stderr, "kernel_launch: %d CUs < 192: unsupported\n", grid); grid = -1; return; }
    }
    if (grid < 0) return;
    if (hipMemsetAsync((char*)d_ws + WS_CTL, 0, CTL_ZERO_BYTES, stream) != hipSuccess) { fprintf(stderr, "kernel_launch: memset failed\n"); return; }
    Args a{};
    for (int i = 0; i < 24; ++i) a.in[i] = (const float*)d_in[i];
    a.out = (float*)d_out; a.ws = (unsigned char*)d_ws;
#if MK_ONE_LAUNCH
    a.ph_lo = 0; a.ph_hi = N_PHASES;
    hipLaunchKernelGGL(fwd_kernel, dim3(grid), dim3(NWAVES * 64), LDS_BYTES, stream, a);
#else
    for (int ph = 0; ph < N_PHASES; ++ph) { a.ph_lo = ph; a.ph_hi = ph + 1; hipLaunchKernelGGL(fwd_kernel, dim3(grid), dim3(NWAVES * 64), LDS_BYTES, stream, a); }
#endif
    const hipError_t le = hipPeekAtLastError();
    if (le != hipSuccess) fprintf(stderr, "kernel_launch: launch failed: %s\n", hipGetErrorName(le));
}
```

```cpp
#include <hip/hip_runtime.h>
#include <hip/hip_bf16.h>
#include <cstdio>
#include <cstdint>
#include <cmath>

#ifndef MK_ONE_LAUNCH
#define MK_ONE_LAUNCH 1
#endif

constexpr int NB = 8, SEQ = 4096, CTXL = 256, TPB = SEQ + CTXL  , MT = NB * TPB  ;
constexpr int DM = 1024, DFF = 4096, DEPTH = 2, DIN = 4528, ZLD = 4608;
constexpr float EPS = 1e-6f;
constexpr int ZC_GQ = 0, ZC_GK = 512, ZC_GV = 1024, ZC_GG = 1536, ZC_CQ = 2048, ZC_HG = 2304, ZC_CKV = 2560, ZC_KR = 2688,
              ZC_GB = 2720, ZC_GA = 2728, ZC_HQ = 2752, ZC_HFF = 3264, ZC_HFB = 3776, ZC_HI = 4288, ZC_END = 4544;
__host__ __device__ __forceinline__ int zcol_src(int n) {
    if (n < 2048) return n;
    if (n < 2304) return 2064 + (n - 2048);
    if (n < 2560) return 4272 + (n - 2304);
    if (n < 2688) return 2320 + (n - 2560);
    if (n < 2720) return 2448 + (n - 2688);
    if (n < 2728) return 2048 + (n - 2720);
    if (n < 2736) return 2056 + (n - 2728);
    if (n < 2752) return -1;
    if (n < 3264) return 2480 + (n - 2752);
    if (n < 3776) return 2992 + (n - 3264);
    if (n < 4288) return 3504 + (n - 3776);
    if (n < 4544) return 4016 + (n - 4288);
    return -1;
}
constexpr int HB_Q = 0, HB_K = 384, HB_V = 768;
constexpr float ATT_C2 = 0.10206207261596577f * 1.4426950408889634f;

constexpr size_t MiB = 1u << 20;
constexpr size_t WS_CTL = 0, CTL_ZERO_BYTES = 1 * MiB;
constexpr size_t WS_MODS = 1 * MiB;
constexpr size_t WS_ROPE = WS_MODS + 512 * 1024;
constexpr size_t WS_LB = WS_ROPE + 512 * 1024 + 0;
constexpr size_t WS_W = 3 * MiB;
constexpr size_t W_IN = 0, W_OUT = W_IN + (size_t)ZLD * DM * 2, W_1 = W_OUT + (size_t)DM * DM * 2, W_2 = W_1 + (size_t)DFF * DM * 2,
                 W_UQ = W_2 + (size_t)DM * DFF * 2, W_UKV = W_UQ + 512 * 256 * 2, W_LAYER = W_UKV + 512 * 128 * 2;
constexpr size_t WS_XC = 58 * MiB;
constexpr size_t WS_HB = 66 * MiB;
constexpr size_t WS_OSG = 134 * MiB;
constexpr size_t WS_OSH = 168 * MiB;
constexpr size_t WS_Z = 185 * MiB;
constexpr size_t WS_HALO = 492 * MiB;
constexpr size_t WS_BG = 499 * MiB;
constexpr size_t WS_END = 502 * MiB;
static_assert(WS_LB + 8192 <= WS_W && WS_W + 2 * W_LAYER <= WS_XC && WS_XC + (size_t)NB * CTXL * DM * 4 <= WS_HB && WS_HB + (size_t)MT * DM * 2 <= WS_OSG &&
              WS_OSG + (size_t)MT * 512 * 2 <= WS_OSH && WS_OSH + (size_t)MT * 256 * 2 <= WS_Z && WS_Z + (size_t)MT * ZLD * 2 <= WS_HALO && WS_HALO + (size_t)(MT / 64) * 4 * 1536 * 2 <= WS_BG && WS_BG + (size_t)MT * 16 * 4 <= WS_END && WS_END <= 512 * MiB, "d_ws map");
constexpr int CW_BAR = 4096;
constexpr int CW_HOFF_G = 65536, CW_HOFF_H = 81920;
constexpr int CW_ATTQ = 16384;

constexpr int RING_BYTES = 131072, LDSCTL_OFF = 162816, MISC_OFF = LDSCTL_OFF + 320, LDS_BYTES = 163840;
constexpr int NWAVES = 8;

#define GAS __attribute__((address_space(1)))
#define LAS __attribute__((address_space(3)))
typedef unsigned short bf16;
typedef unsigned v4u __attribute__((ext_vector_type(4)));
typedef unsigned v2u __attribute__((ext_vector_type(2)));
typedef float f32x4 __attribute__((ext_vector_type(4)));
typedef float f32x16 __attribute__((ext_vector_type(16)));
typedef short bf16x8 __attribute__((ext_vector_type(8)));
typedef short s16x4 __attribute__((ext_vector_type(4)));
typedef GAS unsigned gu32;
#define RLX_AGENT __ATOMIC_RELAXED, __HIP_MEMORY_SCOPE_AGENT
#define LDS_WAIT() asm volatile("s_waitcnt lgkmcnt(0)" ::: "memory")
#define VM_WAIT() asm volatile("s_waitcnt vmcnt(0)" ::: "memory")
#define LBAR() asm volatile("s_waitcnt lgkmcnt(0)\n\ts_barrier" ::: "memory")
typedef float f32x2_t __attribute__((ext_vector_type(2))); typedef __bf16 bf16x2_t __attribute__((ext_vector_type(2)));
__device__ __forceinline__ unsigned f2bf(float f) { return (unsigned)__builtin_bit_cast(unsigned short, (__bf16)f); }
__device__ __forceinline__ unsigned pk2(float lo, float hi) { f32x2_t v = {lo, hi}; bf16x2_t b = __builtin_convertvector(v, bf16x2_t); return __builtin_bit_cast(unsigned, b); }
__device__ __forceinline__ float bf2f(unsigned b) { return __builtin_bit_cast(float, b << 16); }
__device__ __forceinline__ float bflo(unsigned w) { return __builtin_bit_cast(float, w << 16); }
__device__ __forceinline__ float bfhi(unsigned w) { return __builtin_bit_cast(float, w & 0xffff0000u); }
template <int K> __device__ __forceinline__ float swz_xor(float v) { return __builtin_bit_cast(float, __builtin_amdgcn_ds_swizzle(__builtin_bit_cast(int, v), (K << 10) | 0x1F)); }
__device__ __forceinline__ float add_xor32(float v) { const unsigned u = __builtin_bit_cast(unsigned, v); auto r = __builtin_amdgcn_permlane32_swap(u, u, false, false); return __builtin_bit_cast(float, (unsigned)r[0]) + __builtin_bit_cast(float, (unsigned)r[1]); }
__device__ __forceinline__ float max_xor32(float v) { const unsigned u = __builtin_bit_cast(unsigned, v); auto r = __builtin_amdgcn_permlane32_swap(u, u, false, false); return fmaxf(__builtin_bit_cast(float, (unsigned)r[0]), __builtin_bit_cast(float, (unsigned)r[1])); }
template <int CTRL, int ROWMASK, bool BC> __device__ __forceinline__ float dpp_f(float v) { return __builtin_bit_cast(float, __builtin_amdgcn_update_dpp(0, __builtin_bit_cast(int, v), CTRL, ROWMASK, 0xF, BC)); }
__device__ __forceinline__ float row_sum16(float v) { v += dpp_f<0xB1, 0xF, true>(v); v += dpp_f<0x4E, 0xF, true>(v); v += dpp_f<0x141, 0xF, true>(v); v += dpp_f<0x140, 0xF, true>(v); return v; }
__device__ __forceinline__ float half_sum32(float v) { v = row_sum16(v); return v + swz_xor<16>(v); }
__device__ __forceinline__ float wave_sum(float v) { return add_xor32(half_sum32(v)); }
__device__ __forceinline__ float wave_incl_scan(float v) {
    v += dpp_f<0x111, 0xF, true>(v); v += dpp_f<0x112, 0xF, true>(v); v += dpp_f<0x114, 0xF, true>(v); v += dpp_f<0x118, 0xF, true>(v);
    v += dpp_f<0x142, 0xA, false>(v); v += dpp_f<0x143, 0xC, false>(v); return v; }
__device__ __forceinline__ float sigmoidf_(float x) { return __builtin_amdgcn_rcpf(1.0f + __expf(-x)); }
__device__ __forceinline__ float softplusf_(float x) { return x > 20.f ? x : __logf(1.0f + __expf(x)); }
__device__ __forceinline__ float siluf_(float x) { return x * __builtin_amdgcn_rcpf(1.0f + __expf(-x)); }

namespace pg8 {
#define PG8_LAS __attribute__((address_space(3)))
typedef unsigned short bf16_t;
typedef short bf16x8 __attribute__((ext_vector_type(8)));
typedef float f32x4 __attribute__((ext_vector_type(4)));
typedef unsigned u32x4 __attribute__((ext_vector_type(4)));
constexpr int BM = 256, BK = 64, HALF = 128, HTB = HALF * BK * 2  , STAGE_BYTES = 8 * HTB, NXCD = 8, WGM = 8;

__host__ __device__ __forceinline__ int lds_byte(int r, int c) { const int st = (r >> 4) * 2 + (c >> 5), rr = r & 15, cc = c & 31, ob = rr * 64 + cc * 2; return st * 1024 + (ob ^ (((ob >> 9) & 1) << 5)); }
__host__ __device__ __forceinline__ void stage_rc(int b, int& R, int& C) { const int st = b / 1024, sb = b % 1024, swz = sb ^ (((sb >> 9) & 1) << 5); R = (st >> 1) * 16 + swz / 64; C = (st & 1) * 32 + (swz % 64) / 2; }
__host__ __device__ __forceinline__ int perm32(int rho) { const int n = rho >> 4, i = rho & 15; return 8 * (i >> 2) + 4 * n + (i & 3); }

struct Unit { int pm, pn; };
struct Gemm { const bf16_t* A; const bf16_t* Bt; int M, N, K, lda; };

struct StaticOrder {
    int nM, nN, nwg, G, c, skip;
    __host__ __device__ void init(int M, int N, int G_, int c_, int skip_ = 0) { nM = M / BM; nN = N / BM; nwg = nM * nN; G = G_; c = c_; skip = skip_; }
    __host__ __device__ bool next(int i, Unit& u) const {
        const long L = (long)i * G + c; if (L >= nwg) return false;
        int wgid = (int)L; { const int q = nwg / NXCD, r = nwg % NXCD, xcd = wgid % NXCD, off = wgid / NXCD; wgid = (xcd < r ? xcd * (q + 1) : r * (q + 1) + (xcd - r) * q) + off; }
        const int nig = WGM * nN, gid = wgid / nig, fm = gid * WGM, gsz = (nM - fm) < WGM ? (nM - fm) : WGM;
        u.pm = fm + ((wgid % nig) % gsz); u.pn = (wgid % nig) / gsz; if (skip) u.pm += u.pm / 16 + 1; return true;
    }
    __device__ __forceinline__ void a_ready(const Unit&) const {}
    __device__ __forceinline__ void done(const Unit&) const {}
};

__device__ __forceinline__ unsigned cvt_pk_bf16(float lo, float hi) { unsigned r; asm volatile("v_cvt_pk_bf16_f32 %0, %1, %2" : "=v"(r) : "v"(lo), "v"(hi)); return r; }
typedef float f32x2 __attribute__((ext_vector_type(2)));
struct EpiBf16 {
    static constexpr bool PERM = true, AFTER_DRAIN = false;
    bf16_t* O; int ldc; int act;
    __device__ __forceinline__ void operator()(const f32x4 (&acc)[2][2][4][2], const Unit& u, int wr, int wc, int fr, int fq) const {
        const int row0 = u.pm * BM + wr * 64 + fr; const int col0 = u.pn * BM + wc * 32 + 8 * fq;
        const bool sq = act == 2;
#pragma unroll
        for (int ai = 0; ai < 2; ++ai)
#pragma unroll
            for (int m = 0; m < 4; ++m) { bf16_t* rowp = O + (size_t)(row0 + ai * HALF + m * 16) * ldc + col0;
#pragma unroll
                for (int bj = 0; bj < 2; ++bj) { f32x4 v0 = acc[ai][bj][m][0], v1 = acc[ai][bj][m][1];
                    if (sq) {
#pragma unroll
                        for (int q = 0; q < 4; ++q) { const float a = v0[q] > 0.f ? v0[q] : 0.f, b = v1[q] > 0.f ? v1[q] : 0.f; v0[q] = a * a; v1[q] = b * b; } }
                    u32x4 w; w.x = cvt_pk_bf16(v0[0], v0[1]); w.y = cvt_pk_bf16(v0[2], v0[3]); w.z = cvt_pk_bf16(v1[0], v1[1]); w.w = cvt_pk_bf16(v1[2], v1[3]);
                    *(u32x4*)(rowp + bj * HALF) = w; } }
    }
};

template <class Epi, class Sched, bool ALIGN_EPI = false, bool SP2 = false>
__device__ __forceinline__ void gemm_phase(PG8_LAS unsigned char* lds, const Gemm g, const Sched& S, const Epi& E) {
    int tid_ = threadIdx.x; asm volatile("" : "+v"(tid_));
    const int tid = tid_, wid = __builtin_amdgcn_readfirstlane(tid >> 6), lane = tid & 63, wr = wid >> 2, wc = wid & 3, fr = lane & 15, fq = lane >> 4;
    const int K = g.K, nt = K / BK;
    unsigned voffA[2], voffB[2];
#pragma unroll
    for (int i = 0; i < 2; ++i) { int R, C; stage_rc(tid * 16 + i * 8192, R, C); const int Rb = Epi::PERM ? ((R & ~31) + perm32(R & 31)) : R;
        voffA[i] = (unsigned)(R * g.lda + C) * 2u; voffB[i] = (unsigned)(Rb * K + C) * 2u; }
    const size_t kstep = (size_t)(BK * 2);
    const size_t hstepA = (size_t)HALF * g.lda * 2, hstepB = (size_t)HALF * K * 2;
    const size_t tstepA = 2 * hstepA, tstepB = 2 * hstepB;
    const unsigned ldsw = (unsigned)wid * 1024u;
    const int aoff = lds_byte(wr * 64 + fr, fq * 8), boff = lds_byte(wc * 32 + fr, fq * 8);
#define PG8_SA(b, h) (((b) * 2 + (h)) * HTB)
#define PG8_SB(b, h) ((4 + (b) * 2 + (h)) * HTB)
#define PG8_STAGE(bufoff, gbase, voff) do { _Pragma("unroll") for (int _i = 0; _i < 2; ++_i) \
        __builtin_amdgcn_global_load_lds((const unsigned*)((const char*)(gbase) + (voff)[_i]), (PG8_LAS unsigned*)(lds + (bufoff) + ldsw + _i * 8192), 16, 0, 0); } while (0)
#define PG8_LDA(dst, b, h) do { _Pragma("unroll") for (int m = 0; m < 4; ++m) _Pragma("unroll") for (int k = 0; k < 2; ++k) dst[m][k] = *(const PG8_LAS bf16x8*)(lds + PG8_SA(b, h) + aoff + m * 2048 + k * 1024); } while (0)
#define PG8_LDB(dst, b, h) do { _Pragma("unroll") for (int n = 0; n < 2; ++n) _Pragma("unroll") for (int k = 0; k < 2; ++k) dst[n][k] = *(const PG8_LAS bf16x8*)(lds + PG8_SB(b, h) + boff + n * 2048 + k * 1024); } while (0)
#define PG8_MMA(ai, bj, At, Bt) do { __builtin_amdgcn_s_setprio(1); _Pragma("unroll") for (int m = 0; m < 4; ++m) _Pragma("unroll") for (int n = 0; n < 2; ++n) _Pragma("unroll") for (int k = 0; k < 2; ++k) \
        acc[ai][bj][m][n] = __builtin_amdgcn_mfma_f32_16x16x32_bf16(Bt[n][k], At[m][k], acc[ai][bj][m][n], 0, 0, 0); __builtin_amdgcn_s_setprio(0); } while (0)
#define PG8_WAIT_V(n) asm volatile("s_waitcnt vmcnt(" #n ")" ::: "memory")
#define PG8_WAIT_L(n) asm volatile("s_waitcnt lgkmcnt(" #n ")" ::: "memory")
#define PG8_BAR __builtin_amdgcn_s_barrier()
#define PG8_SCHED __builtin_amdgcn_sched_barrier(0)
    Unit cur, nxt; int ui = 0;
    if (!S.next(0, cur)) return;
    f32x4 acc[2][2][4][2];
#pragma unroll
    for (int a = 0; a < 2; ++a)
#pragma unroll
        for (int b = 0; b < 2; ++b)
#pragma unroll
            for (int m = 0; m < 4; ++m)
#pragma unroll
                for (int n = 0; n < 2; ++n) acc[a][b][m][n] = (f32x4){0.f, 0.f, 0.f, 0.f};
    bf16x8 At[4][2], B0[2][2], B1[2][2];
    const char* cA = (const char*)g.A + (size_t)cur.pm * tstepA; const char* cB = (const char*)g.Bt + (size_t)cur.pn * tstepB;
    S.a_ready(cur);
    if constexpr (SP2) {
        PG8_STAGE(PG8_SB(0, 0), cB, voffB); PG8_STAGE(PG8_SB(0, 1), cB + hstepB, voffB); PG8_STAGE(PG8_SA(0, 0), cA, voffA); PG8_STAGE(PG8_SA(0, 1), cA + hstepA, voffA);
        if (wr == 1) PG8_BAR;
        PG8_WAIT_V(2); PG8_BAR;
        PG8_STAGE(PG8_SB(1, 0), cB + kstep, voffB); PG8_STAGE(PG8_SA(1, 0), cA + kstep, voffA); PG8_STAGE(PG8_SB(1, 1), cB + hstepB + kstep, voffB);
        PG8_WAIT_V(6); PG8_BAR;
    } else {
        PG8_STAGE(PG8_SB(0, 0), cB, voffB); PG8_STAGE(PG8_SA(0, 0), cA, voffA); PG8_STAGE(PG8_SB(0, 1), cB + hstepB, voffB); PG8_STAGE(PG8_SA(0, 1), cA + hstepA, voffA);
        if (wr == 1) PG8_BAR;
        PG8_WAIT_V(4); PG8_BAR;
        PG8_STAGE(PG8_SB(1, 0), cB + kstep, voffB); PG8_STAGE(PG8_SA(1, 0), cA + kstep, voffA); PG8_STAGE(PG8_SB(1, 1), cB + hstepB + kstep, voffB);
        PG8_WAIT_V(6); PG8_BAR;
    }
    for (;;) {
        const bool has_next = S.next(ui + 1, nxt);
        const char* nA = has_next ? (const char*)g.A + (size_t)nxt.pm * tstepA : cA; const char* nB = has_next ? (const char*)g.Bt + (size_t)nxt.pn * tstepB : cB;

#pragma nounroll
        for (int t = 0; t < nt; t += 2) {
            const bool last = (t == nt - 2);
            const char* a1 = cA + (size_t)(t + 1) * kstep;
            const char* a2 = last ? nA : cA + (size_t)(t + 2) * kstep; const char* b2 = last ? nB : cB + (size_t)(t + 2) * kstep;
            const char* a3 = a2 + kstep; const char* b3 = b2 + kstep;
            if (last && has_next) S.a_ready(nxt);
            if constexpr (SP2) {
            PG8_LDB(B0, 0, 0); PG8_LDB(B1, 0, 1); PG8_SCHED; PG8_LDA(At, 0, 0); PG8_STAGE(PG8_SA(1, 1), a1 + hstepA, voffA);
            PG8_WAIT_V(8); PG8_WAIT_L(0); PG8_BAR; PG8_MMA(0, 0, At, B0); PG8_MMA(0, 1, At, B1); PG8_BAR; PG8_SCHED;
            PG8_LDA(At, 0, 1); PG8_STAGE(PG8_SB(0, 0), b2, voffB); PG8_STAGE(PG8_SB(0, 1), b2 + hstepB, voffB); PG8_STAGE(PG8_SA(0, 0), a2, voffA);
            PG8_WAIT_V(8); PG8_WAIT_L(0); PG8_BAR; PG8_MMA(1, 0, At, B0); PG8_MMA(1, 1, At, B1); PG8_BAR; PG8_SCHED;
            PG8_LDB(B0, 1, 0); PG8_LDB(B1, 1, 1); PG8_SCHED; PG8_LDA(At, 1, 0); PG8_STAGE(PG8_SA(0, 1), a2 + hstepA, voffA);
            PG8_WAIT_V(8); PG8_WAIT_L(0); PG8_BAR; PG8_MMA(0, 0, At, B0); PG8_MMA(0, 1, At, B1); PG8_BAR; PG8_SCHED;
            PG8_LDA(At, 1, 1); PG8_STAGE(PG8_SB(1, 0), b3, voffB); PG8_STAGE(PG8_SB(1, 1), b3 + hstepB, voffB); PG8_STAGE(PG8_SA(1, 0), a3, voffA);
            PG8_WAIT_V(8); PG8_WAIT_L(0); PG8_BAR; PG8_MMA(1, 0, At, B0); PG8_MMA(1, 1, At, B1); PG8_BAR; PG8_SCHED;
            } else {
            PG8_LDB(B0, 0, 0); PG8_SCHED; PG8_LDA(At, 0, 0); PG8_STAGE(PG8_SA(1, 1), a1 + hstepA, voffA);
            PG8_WAIT_L(8); PG8_BAR; PG8_WAIT_L(0); PG8_MMA(0, 0, At, B0); PG8_BAR; PG8_SCHED;
            PG8_LDB(B1, 0, 1); PG8_STAGE(PG8_SB(0, 0), b2, voffB);
            PG8_BAR; PG8_WAIT_L(0); PG8_MMA(0, 1, At, B1); PG8_BAR;
            PG8_LDA(At, 0, 1); PG8_STAGE(PG8_SA(0, 0), a2, voffA);
            PG8_BAR; PG8_WAIT_L(0); PG8_MMA(1, 0, At, B0); PG8_BAR; PG8_SCHED;
            PG8_STAGE(PG8_SB(0, 1), b2 + hstepB, voffB);
            PG8_WAIT_V(6); PG8_BAR; PG8_MMA(1, 1, At, B1); PG8_BAR;
            PG8_LDB(B0, 1, 0); PG8_SCHED; PG8_LDA(At, 1, 0); PG8_STAGE(PG8_SA(0, 1), a2 + hstepA, voffA);
            PG8_WAIT_L(8); PG8_BAR; PG8_WAIT_L(0); PG8_MMA(0, 0, At, B0); PG8_BAR; PG8_SCHED;
            PG8_LDB(B1, 1, 1); PG8_STAGE(PG8_SB(1, 0), b3, voffB);
            PG8_BAR; PG8_WAIT_L(0); PG8_MMA(0, 1, At, B1); PG8_BAR;
            PG8_LDA(At, 1, 1); PG8_STAGE(PG8_SA(1, 0), a3, voffA);
            PG8_BAR; PG8_WAIT_L(0); PG8_MMA(1, 0, At, B0); PG8_BAR; PG8_SCHED;
            PG8_STAGE(PG8_SB(1, 1), b3 + hstepB, voffB);
            PG8_WAIT_V(6); PG8_BAR; PG8_MMA(1, 1, At, B1); PG8_BAR;
            }
        }
        if constexpr (ALIGN_EPI) { if (wr == 0) PG8_BAR; }
        if constexpr (!Epi::AFTER_DRAIN) { E(acc, cur, wr, wc, fr, fq); S.done(cur); }
        if (!has_next) break;
#pragma unroll
        for (int a = 0; a < 2; ++a)
#pragma unroll
            for (int b = 0; b < 2; ++b)
#pragma unroll
                for (int m = 0; m < 4; ++m)
#pragma unroll
                    for (int n = 0; n < 2; ++n) acc[a][b][m][n] = (f32x4){0.f, 0.f, 0.f, 0.f};
        cur = nxt; cA = nA; cB = nB; ++ui;
        if constexpr (ALIGN_EPI) { if (wr == 1) PG8_BAR; }
    }
    PG8_WAIT_V(0);
    if constexpr (!ALIGN_EPI) { if (wr == 0) PG8_BAR; }
    PG8_BAR;
    if constexpr (Epi::AFTER_DRAIN) { E.fused(acc, cur, wr, wc, fr, fq, lds, wid, lane); S.done(cur); }
#undef PG8_SA
#undef PG8_SB
#undef PG8_STAGE
#undef PG8_LDA
#undef PG8_LDB
#undef PG8_MMA
#undef PG8_WAIT_V
#undef PG8_WAIT_L
#undef PG8_BAR
#undef PG8_SCHED
}
}
__device__ __forceinline__ unsigned long long rt() { return __builtin_amdgcn_s_memrealtime(); }
#define XB_TMO      128
#define XB_XCNT(j)  (256  + 64 * (j))
#define XB_XSUB(j)  (1280 + 64 * (j))
#define XB_XGEN(j)  (2304 + 64 * (j))
#define XB_TOP      3328
#define XB_TOPGEN   3392
#define XCD_BAR_WORDS 3456
#define XB_SPIN_CAP (1u << 22)

__device__ __forceinline__ unsigned xb_ld(unsigned* p)              { return __hip_atomic_load(p, __ATOMIC_RELAXED, __HIP_MEMORY_SCOPE_AGENT); }
__device__ __forceinline__ unsigned xb_add(unsigned* p, unsigned v) { return __hip_atomic_fetch_add(p, v, __ATOMIC_RELAXED, __HIP_MEMORY_SCOPE_AGENT); }
__device__ __forceinline__ unsigned xb_xcc_id() { return (unsigned)__builtin_amdgcn_s_getreg((3 << 11) | 20) & 0xFu; }
#define XB_SPIN(cond, bar) do { unsigned _sp = 0; while (cond) { __builtin_amdgcn_s_sleep(1); \
    if ((++_sp & 255u) == 0u) { if (xb_ld(&(bar)[XB_TMO])) break; if (_sp > XB_SPIN_CAP) { atomicAdd(&(bar)[XB_TMO], 1u); break; } } } } while (0)

struct XcdBarrier {
    unsigned* bar; unsigned x;
    volatile LAS unsigned* st;
};

__device__ __forceinline__ XcdBarrier xcd_barrier_post(unsigned* bar, volatile LAS unsigned* st) {
    XcdBarrier b; b.bar = bar; b.x = xb_xcc_id(); b.st = st;
    if (threadIdx.x == 0) (void)xb_add(&bar[XB_XCNT(b.x)], 1u);
    return b;
}
__device__ __forceinline__ void xcd_barrier_complete(unsigned* bar, unsigned x, unsigned& nloc, unsigned& nx) {
    const unsigned G = gridDim.x * gridDim.y * gridDim.z;
    unsigned sum, cnt, mine, sp = 0u;
    for (;;) {
        sum = 0u; cnt = 0u; mine = 0u;
#pragma unroll
        for (unsigned j = 0; j < 16; ++j) { const unsigned c = xb_ld(&bar[XB_XCNT(j)]); sum += c; cnt += (c > 0u) ? 1u : 0u; mine = (j == x) ? c : mine; }
        if (sum == G) break;
        __builtin_amdgcn_s_sleep(1);
        if ((++sp & 255u) == 0u) { if (xb_ld(&bar[XB_TMO])) break; if (sp > XB_SPIN_CAP) { atomicAdd(&bar[XB_TMO], 1u); break; } }
    }
    nloc = mine > 0u ? mine : 1u; nx = cnt > 0u ? cnt : 1u;
}

__device__ __forceinline__ void xcd_barrier(const XcdBarrier& b) {
    asm volatile("s_waitcnt vmcnt(0)" ::: "memory");
    __syncthreads();
    if (threadIdx.x == 0) {
        unsigned* bar = b.bar;
        __builtin_amdgcn_s_waitcnt(0);
        unsigned nloc = b.st[0], nx = b.st[1];
        if (nloc == 0u) { xcd_barrier_complete(bar, b.x, nloc, nx); b.st[0] = nloc; b.st[1] = nx; }
        const unsigned old = xb_add(&bar[XB_XSUB(b.x)], 1u);
        const unsigned gen = old / nloc;
        if (old + 1u == (gen + 1u) * nloc) {
            __builtin_amdgcn_fence(__ATOMIC_RELEASE, "agent");
            asm volatile("s_waitcnt vmcnt(0)" ::: "memory");
            const unsigned og = xb_add(&bar[XB_TOP], 1u);
            const unsigned tg = og / nx;
            if (og + 1u == (tg + 1u) * nx) xb_add(&bar[XB_TOPGEN], 1u);
            else XB_SPIN(xb_ld(&bar[XB_TOPGEN]) == tg, bar);
            __builtin_amdgcn_fence(__ATOMIC_ACQUIRE, "agent");
            xb_add(&bar[XB_XGEN(b.x)], 1u);
            asm volatile("s_waitcnt vmcnt(0)" ::: "memory");
        } else {
            XB_SPIN(xb_ld(&bar[XB_XGEN(b.x)]) == gen, bar);
            __builtin_amdgcn_fence(__ATOMIC_ACQUIRE, "agent");
            asm volatile("s_waitcnt vmcnt(0)" ::: "memory");
        }
    }
    __syncthreads();
}

struct Args {
    const float* in[24];
    float* out; unsigned char* ws;
    int ph_lo, ph_hi;
};
typedef const __attribute__((address_space(4))) Args CArgs;
enum InIdx { I_X = 0, I_C, I_CTX, I_CCTX, I_WADA, I_BADA, I_NMIXPRE, I_NMIXPOST, I_NMLPPRE, I_NMLPPOST, I_WIN, I_WOUT, I_GCONV, I_GALOG, I_GDT, I_GNORM,
             I_QNORM, I_KVNORM, I_WUQ, I_WUKV, I_LBLOG, I_HNORM, I_W1, I_W2 };

__device__ __forceinline__ const float* resid_in0(const float* x, const float* ctx, int row) {
    const int b = row / TPB, t = row - b * TPB;
    return t < CTXL ? ctx + ((size_t)b * CTXL + t) * DM : x + ((size_t)b * SEQ + (t - CTXL)) * DM;
}
__device__ __forceinline__ float* resid_ptr(float* out, float* xc, int row) {
    const int b = row / TPB, t = row - b * TPB;
    return t < CTXL ? xc + ((size_t)b * CTXL + t) * DM : out + ((size_t)b * SEQ + (t - CTXL)) * DM;
}
__device__ __forceinline__ int mod_row(int row) { const int b = row / TPB, t = row - b * TPB; return t < CTXL ? 8 : b; }

__device__ __forceinline__ void transpose_item(const float* W, int K, int ldsrc, int nsrc, bool zmap, const float* gain, bf16* WT, LAS float* scr, int item, int nblk, int lane) {
    const int kb = item / nblk, nb = item % nblk, k0 = 32 * kb, n0 = 64 * nb;
    const int np = n0 + lane; int src = zmap ? zcol_src(np) : np; if (src >= nsrc) src = -1;
#pragma unroll 8
    for (int kk = 0; kk < 32; ++kk) { float v = 0.f; if (src >= 0) { v = W[(size_t)(k0 + kk) * ldsrc + src]; if (gain) v *= gain[k0 + kk]; } scr[kk * 65 + lane] = v; }
    LDS_WAIT(); asm volatile("" ::: "memory");
    const int c = lane & 3;
#pragma unroll
    for (int j = 0; j < 4; ++j) { const int n = (lane >> 2) + 16 * j; const LAS float* s = scr + (8 * c) * 65 + n;
        v4u o; o.x = pk2(s[0 * 65], s[1 * 65]); o.y = pk2(s[2 * 65], s[3 * 65]); o.z = pk2(s[4 * 65], s[5 * 65]); o.w = pk2(s[6 * 65], s[7 * 65]);
        *(GAS v4u*)(WT + (size_t)(n0 + n) * K + k0 + 8 * c) = o; }
    LDS_WAIT(); asm volatile("" ::: "memory");
}
__device__ __forceinline__ void p0a_prologue(CArgs& a, LAS unsigned char* lds, int vcu, int G, int wave, int lane, int tid) {
    LAS float* scr = (LAS float*)(lds + wave * 8320);
    const int gw = vcu * NWAVES + wave, NGW = G * NWAVES;
    constexpr int I_IN = (DM / 32) * (ZLD / 64), I_OUT = (DM / 32) * (DM / 64), I_1 = (DM / 32) * (DFF / 64), I_2 = (DFF / 32) * (DM / 64), I_UQ = (256 / 32) * (512 / 64), I_UKV = (128 / 32) * (512 / 64);
    constexpr int PER_LAYER = I_IN + I_OUT + I_1 + I_2 + I_UQ + I_UKV;
    for (int it = gw; it < DEPTH * PER_LAYER; it += NGW) {
        const int l = it / PER_LAYER; int r = it - l * PER_LAYER;
        unsigned char* wb = a.ws + WS_W + (size_t)l * W_LAYER;
        if (r < I_IN) { transpose_item(a.in[I_WIN] + (size_t)l * DM * DIN, DM, DIN, DIN, true, nullptr, (bf16*)(wb + W_IN), scr, r, ZLD / 64, lane); continue; } r -= I_IN;
        if (r < I_OUT) { transpose_item(a.in[I_WOUT] + (size_t)l * DM * DM, DM, DM, DM, false, nullptr, (bf16*)(wb + W_OUT), scr, r, DM / 64, lane); continue; } r -= I_OUT;
        if (r < I_1) { transpose_item(a.in[I_W1] + (size_t)l * DM * DFF, DM, DFF, DFF, false, nullptr, (bf16*)(wb + W_1), scr, r, DFF / 64, lane); continue; } r -= I_1;
        if (r < I_2) { transpose_item(a.in[I_W2] + (size_t)l * DFF * DM, DFF, DM, DM, false, nullptr, (bf16*)(wb + W_2), scr, r, DM / 64, lane); continue; } r -= I_2;
        if (r < I_UQ) { transpose_item(a.in[I_WUQ] + (size_t)l * 256 * 384, 256, 384, 384, false, a.in[I_QNORM] + l * 256, (bf16*)(wb + W_UQ), scr, r, 512 / 64, lane); continue; } r -= I_UQ;
        transpose_item(a.in[I_WUKV] + (size_t)l * 128 * 512, 128, 512, 512, false, a.in[I_KVNORM] + l * 128, (bf16*)(wb + W_UKV), scr, r, 512 / 64, lane);
    }
    {
        const int gt = vcu * (NWAVES * 64) + tid, NGT = G * NWAVES * 64;
        float* rc = (float*)(a.ws + WS_ROPE); float* rs = rc + SEQ * 16;
        for (int i = gt; i < SEQ * 16; i += NGT) { const int t = i >> 4, j = i & 15, f = j & 7;
            const float inv = exp2f(-(float)f * 0.125f * 13.287712379549449f);
            const float pos = (float)(j < 8 ? (t >> 6) : (t & 63)); const float ang = pos * inv;
            rc[i] = cosf(ang); rs[i] = sinf(ang); }
        float* lb = (float*)(a.ws + WS_LB);
        for (int i = gt; i < 2 * 1024; i += NGT) { const int l = i >> 10, j = i & 1023;
            const float l0 = a.in[I_LBLOG][j], l1 = a.in[I_LBLOG][1024 + j];
            lb[i] = l == 0 ? 0.f : 1.0f / (1.0f + expf(l0 - l1)); }
    }
    if (vcu < 192) {
        LAS float* sc = (LAS float*)(lds + 69632);
        LAS float* red = (LAS float*)(lds + 106496);
        __syncthreads();
        for (int i = tid; i < 9 * 1024; i += 512) { const int r = i >> 10, k = i & 1023; const float v = r < 8 ? a.in[I_C][r * 1024 + k] : a.in[I_CCTX][k]; sc[i] = siluf_(v); }
        __syncthreads();
        const int l = vcu / 96, n = (vcu % 96) * 64 + lane;
        const float* w = a.in[I_WADA] + (size_t)l * DM * 6 * DM + n + (size_t)(wave * 128) * 6 * DM;
        float acc[9];
#pragma unroll
        for (int r = 0; r < 9; ++r) acc[r] = 0.f;
#pragma unroll 16
        for (int k = 0; k < 128; ++k) { const float wv = w[(size_t)k * 6 * DM];
#pragma unroll
            for (int r = 0; r < 9; ++r) acc[r] += sc[r * 1024 + wave * 128 + k] * wv; }
#pragma unroll
        for (int r = 0; r < 9; ++r) red[(wave * 9 + r) * 64 + lane] = acc[r];
        __syncthreads();
        if (wave == 0) {
            const float bv = a.in[I_BADA][l * 6 * DM + n];
            float* mods = (float*)(a.ws + WS_MODS) + (size_t)l * 9 * 6 * DM;
#pragma unroll
            for (int r = 0; r < 9; ++r) { float t = bv;
#pragma unroll
                for (int q = 0; q < 8; ++q) t += red[(q * 9 + r) * 64 + lane];
                mods[(size_t)r * 6 * DM + n] = t; }
        }
    }
}

__device__ __forceinline__ void norm_mod_store(const f32x4 (&v)[4], const float* gain, const float* sh, const float* sc, bf16* orow, int lane) {
    float ss = 0.f;
#pragma unroll
    for (int j = 0; j < 4; ++j) ss += (v[j].x * v[j].x + v[j].y * v[j].y) + (v[j].z * v[j].z + v[j].w * v[j].w);
    const float rstd = rsqrtf(wave_sum(ss) * (1.f / DM) + EPS);
    GAS v2u* o8 = (GAS v2u*)orow + lane;
#pragma unroll
    for (int j = 0; j < 4; ++j) { const int c = 4 * lane + 256 * j;
        const f32x4 g = *(const f32x4*)(gain + c), s1 = *(const f32x4*)(sh + c), s2 = *(const f32x4*)(sc + c);
        f32x4 h; h.x = v[j].x * rstd * g.x * (1.f + s2.x) + s1.x; h.y = v[j].y * rstd * g.y * (1.f + s2.y) + s1.y; h.z = v[j].z * rstd * g.z * (1.f + s2.z) + s1.z; h.w = v[j].w * rstd * g.w * (1.f + s2.w) + s1.w;
        v2u w; w.x = pk2(h.x, h.y); w.y = pk2(h.z, h.w); o8[64 * j] = w; }
}
__device__ __forceinline__ void p0b_prenorm(CArgs& a, int gw, int NGW, int lane) {
    const float* mods = (const float*)(a.ws + WS_MODS);
    bf16* HB = (bf16*)(a.ws + WS_HB);
    for (int row0 = gw; row0 < MT; row0 += 2 * NGW) {
        f32x4 v[2][4]; int rw[2]; bool ok[2];
#pragma unroll
        for (int u = 0; u < 2; ++u) { rw[u] = row0 + u * NGW; ok[u] = rw[u] < MT; if (!ok[u]) rw[u] = row0;
            const GAS f32x4* xr = (const GAS f32x4*)resid_in0(a.in[I_X], a.in[I_CTX], rw[u]) + lane;
#pragma unroll
            for (int j = 0; j < 4; ++j) v[u][j] = xr[64 * j]; }
#pragma unroll
        for (int u = 0; u < 2; ++u) if (ok[u]) { const float* m = mods + (size_t)mod_row(rw[u]) * 6 * DM;
            norm_mod_store(v[u], a.in[I_NMIXPRE], m, m + DM, HB + (size_t)rw[u] * DM, lane); }
    }
}
__device__ __forceinline__ void post_pass(CArgs& a, int layer, int which, int gw, int NGW, int lane) {
    const float* mods = (const float*)(a.ws + WS_MODS) + (size_t)layer * 9 * 6 * DM;
    bf16* HB = (bf16*)(a.ws + WS_HB); float* xc = (float*)(a.ws + WS_XC);
    const float* gpost = (which == 0 ? a.in[I_NMIXPOST] : a.in[I_NMLPPOST]) + layer * DM;
    const bool has_next = (which == 0) || (layer + 1 < DEPTH);
    const float* gnext = which == 0 ? a.in[I_NMLPPRE] + layer * DM : a.in[I_NMIXPRE] + (layer + 1) * DM;
    for (int row0 = gw; row0 < MT; row0 += 2 * NGW) {
        int rw[2], mr[2]; bool ok[2]; const float* m[2]; f32x4 y[2][4], x[2][4]; float ss[2];
#pragma unroll
        for (int u = 0; u < 2; ++u) { rw[u] = row0 + u * NGW; ok[u] = rw[u] < MT; if (!ok[u]) rw[u] = row0; mr[u] = mod_row(rw[u]);
            if (layer == DEPTH - 1 && mr[u] == 8) ok[u] = false;
            m[u] = mods + (size_t)mr[u] * 6 * DM; }
#pragma unroll
        for (int u = 0; u < 2; ++u) if (ok[u]) {
            const GAS v2u* yr = (const GAS v2u*)(HB + (size_t)rw[u] * DM) + lane;
            const float* xin = (layer == 0 && which == 0) ? resid_in0(a.in[I_X], a.in[I_CTX], rw[u]) : resid_ptr(a.out, xc, rw[u]);
            ss[u] = 0.f;
#pragma unroll
            for (int j = 0; j < 4; ++j) { const v2u w = yr[64 * j]; y[u][j] = (f32x4){bflo(w.x), bfhi(w.x), bflo(w.y), bfhi(w.y)}; x[u][j] = *((const GAS f32x4*)xin + lane + 64 * j); } }
#pragma unroll
        for (int u = 0; u < 2; ++u) if (ok[u]) {
#pragma unroll
            for (int j = 0; j < 4; ++j) ss[u] += (y[u][j].x * y[u][j].x + y[u][j].y * y[u][j].y) + (y[u][j].z * y[u][j].z + y[u][j].w * y[u][j].w);
            const float rstd = rsqrtf(wave_sum(ss[u]) * (1.f / DM) + EPS);
            const float* gate = m[u] + (which == 0 ? 2 : 5) * DM; float* xout = resid_ptr(a.out, xc, rw[u]);
#pragma unroll
            for (int j = 0; j < 4; ++j) { const int c = 4 * lane + 256 * j; const f32x4 gp = *(const f32x4*)(gpost + c), gt = *(const f32x4*)(gate + c);
                x[u][j].x += gt.x * (y[u][j].x * rstd * gp.x); x[u][j].y += gt.y * (y[u][j].y * rstd * gp.y); x[u][j].z += gt.z * (y[u][j].z * rstd * gp.z); x[u][j].w += gt.w * (y[u][j].w * rstd * gp.w);
                *((GAS f32x4*)xout + lane + 64 * j) = x[u][j]; }
            if (has_next) {
                const float* mn = which == 0 ? m[u] : (const float*)(a.ws + WS_MODS) + ((size_t)(layer + 1) * 9 + mr[u]) * 6 * DM;
                const float* sh = mn + (which == 0 ? 3 : 0) * DM; const float* sc = mn + (which == 0 ? 4 : 1) * DM;
                norm_mod_store(x[u], gnext, sh, sc, HB + (size_t)rw[u] * DM, lane);
            }
        }
    }
}
__device__ __forceinline__ void mla_rope_pass(CArgs& a, LAS unsigned char* lds, int wave, int gw, int NGW, int lane) {
    bf16* HB = (bf16*)(a.ws + WS_HB); const bf16* Z = (const bf16*)(a.ws + WS_Z);
    const float* rc = (const float*)(a.ws + WS_ROPE); const float* rs = rc + SEQ * 16;
    LAS bf16* raw = (LAS bf16*)(lds + wave * 2432);
    LAS float* cs = (LAS float*)(raw + 1056);
    int role, src, hf = 0;
    if (lane < 24) { const int h = lane / 6, blk = lane - 6 * h; if (blk < 4) { role = 0; src = h * 96 + blk * 16; } else { role = 1; src = h * 96 + 64; hf = blk - 4; } }
    else if (lane < 48) { const int l2 = lane - 24, h = l2 / 6, blk = l2 - 6 * h; if (blk < 4) { role = 2; src = 512 + h * 128 + blk * 16; } else { role = 3; src = 1024; hf = blk - 4; } }
    else { const int l3 = lane - 48, h = l3 >> 2, blk = l3 & 3; role = 4; src = 512 + h * 128 + 64 + blk * 16; }
    for (int row = gw; row < MT; row += NGW) {
        const int b = row / TPB, t = row - b * TPB; const bool lat = t >= CTXL; const int tp = lat ? t - CTXL : 0;
        const GAS v4u* hr = (const GAS v4u*)(HB + (size_t)row * DM);
        const v4u r0 = hr[lane], r1 = hr[64 + lane];
        const bf16* zr = Z + (size_t)row * ZLD;
        const v2u cq = *((const GAS v2u*)(zr + ZC_CQ) + lane); const unsigned ckv = *((const GAS unsigned*)(zr + ZC_CKV) + lane);
        unsigned krw = 0u; float csv = 0.f;
        if (lane < 16) krw = *((const GAS unsigned*)(zr + ZC_KR) + lane);
        if (lane < 32) csv = (lane < 16 ? rc : rs)[tp * 16 + (lane & 15)];
        const float s1 = bflo(cq.x) * bflo(cq.x) + bfhi(cq.x) * bfhi(cq.x) + bflo(cq.y) * bflo(cq.y) + bfhi(cq.y) * bfhi(cq.y);
        const float s2 = bflo(ckv) * bflo(ckv) + bfhi(ckv) * bfhi(ckv);
        const float sq = rsqrtf(wave_sum(s1) * (1.f / 256.f) + EPS) * ATT_C2, skv = rsqrtf(wave_sum(s2) * (1.f / 128.f) + EPS);
        *((LAS v4u*)raw + lane) = r0; *((LAS v4u*)raw + 64 + lane) = r1;
        if (lane < 16) *((LAS unsigned*)(raw + 1024) + lane) = krw;
        if (lane < 32) cs[lane] = csv;
        VM_WAIT(); LDS_WAIT(); asm volatile("" ::: "memory");
        float v[16];
        { const v4u a0 = *(const LAS v4u*)(raw + src), a1 = *(const LAS v4u*)(raw + src + 8);
          const unsigned aw[8] = {a0.x, a0.y, a0.z, a0.w, a1.x, a1.y, a1.z, a1.w};
#pragma unroll
          for (int e = 0; e < 8; ++e) { v[2 * e] = bflo(aw[e]); v[2 * e + 1] = bfhi(aw[e]); } }
        if ((role == 1 || role == 3) && lat) {
            const v4u b0 = *(const LAS v4u*)(raw + src + 16), b1 = *(const LAS v4u*)(raw + src + 24);
            const unsigned bw[8] = {b0.x, b0.y, b0.z, b0.w, b1.x, b1.y, b1.z, b1.w};
#pragma unroll
            for (int e = 0; e < 16; ++e) { const float t1 = v[e], t2 = (e & 1) ? bfhi(bw[e >> 1]) : bflo(bw[e >> 1]), c = cs[e], sn = cs[16 + e];
                v[e] = hf == 0 ? t1 * c - t2 * sn : t1 * sn + t2 * c; }
        } else if ((role == 1 || role == 3) && hf == 1) {
            const v4u b0 = *(const LAS v4u*)(raw + src + 16), b1 = *(const LAS v4u*)(raw + src + 24);
            const unsigned bw[8] = {b0.x, b0.y, b0.z, b0.w, b1.x, b1.y, b1.z, b1.w};
#pragma unroll
            for (int e = 0; e < 8; ++e) { v[2 * e] = bflo(bw[e]); v[2 * e + 1] = bfhi(bw[e]); }
        }
        const float scl = role < 2 ? sq : (role == 3 ? 1.0f : skv);
        unsigned ow[8];
#pragma unroll
        for (int e = 0; e < 8; ++e) ow[e] = pk2(v[2 * e] * scl, v[2 * e + 1] * scl);
        GAS v4u* orow = (GAS v4u*)(HB + (size_t)row * DM) + 2 * lane;
        orow[0] = (v4u){ow[0], ow[1], ow[2], ow[3]}; orow[1] = (v4u){ow[4], ow[5], ow[6], ow[7]};
        LDS_WAIT(); asm volatile("" ::: "memory");
    }
}

namespace att {
constexpr int KT_BYTES = 12288, VT_BYTES = 8192, SLOT = KT_BYTES + VT_BYTES, WS_OFF = 2 * SLOT;
__device__ __forceinline__ int crow(int r, int hi) { return (r & 3) + 8 * (r >> 2) + 4 * hi; }
#define ATT_WAIT_BAR() asm volatile("s_waitcnt vmcnt(0) lgkmcnt(0)\n\ts_barrier" ::: "memory")
__device__ __forceinline__ float rowmax32(const f32x16& p0, const f32x16& p1) {
    float m = fmaxf(p0[0], p1[0]);
#pragma unroll
    for (int r = 1; r < 16; ++r) m = fmaxf(m, fmaxf(p0[r], p1[r]));
    return max_xor32(m);
}
__device__ __forceinline__ unsigned cvtpk(float lo, float hi) { unsigned r; asm volatile("v_cvt_pk_bf16_f32 %0, %1, %2" : "=v"(r) : "v"(lo), "v"(hi)); return r; }
__device__ __forceinline__ void att_dma(const bf16* HB, LAS unsigned char* lds, int rowb, int h, int t, int slot, int wid, int lane) {
    const bf16* kv = HB + (size_t)(rowb + 64 * t) * DM;
#pragma unroll
    for (int i = 0; i < 3; ++i) { const int p = wid + 8 * i;
        if (p < 12) __builtin_amdgcn_global_load_lds((const unsigned*)(kv + (size_t)lane * DM + HB_K + h * 96 + p * 8), (LAS unsigned*)(lds + slot * SLOT + p * 1024), 16, 0, 0);
        else if (p < 20) { const int pv_ = p - 12, dh = pv_ >> 2, rg = pv_ & 3;
            __builtin_amdgcn_global_load_lds((const unsigned*)(kv + (size_t)(16 * rg + (lane >> 2)) * DM + HB_V + h * 64 + dh * 32 + (lane & 3) * 8), (LAS unsigned*)(lds + slot * SLOT + KT_BYTES + pv_ * 1024), 16, 0, 0); } }
}
__device__ __forceinline__ void attn_unit(int b, int h, int qb, const bf16* HB, bf16* Z, LAS unsigned char* lds) {
    int tid_ = threadIdx.x; asm volatile("" : "+v"(tid_)); const int tid = tid_, lane = tid & 63, r32 = lane & 31, hi = lane >> 5; const int wid = __builtin_amdgcn_readfirstlane(tid >> 6);
    const int rowb = b * TPB; const int row0 = rowb + 256 * qb + 32 * wid;
    const int NT = qb == 0 ? CTXL / 64 : TPB / 64;
    LAS float* wsf = (LAS float*)(lds + WS_OFF + wid * 256);
    const unsigned lds0 = (unsigned)(uintptr_t)lds;
    att_dma(HB, lds, rowb, h, 0, 0, wid, lane);
    bf16x8 qr[6];
#pragma unroll
    for (int d0 = 0; d0 < 6; ++d0) qr[d0] = *(const bf16x8*)(HB + (size_t)(row0 + r32) * DM + HB_Q + h * 96 + d0 * 16 + hi * 8);
    float mref = -1e30f, lsum = 0.f; f32x16 o[2]; o[0] = f32x16{}; o[1] = f32x16{};
    ATT_WAIT_BAR();
    for (int t = 0; t < NT; ++t) {
        const int slot = t & 1;
        if (t + 1 < NT) att_dma(HB, lds, rowb, h, t + 1, slot ^ 1, wid, lane);
        f32x16 p0 = f32x16{}, p1 = f32x16{};
        { const LAS unsigned char* kb = lds + slot * SLOT + hi * 1024 + r32 * 16;
#pragma unroll
          for (int d0 = 0; d0 < 6; ++d0) { const bf16x8 k0 = *(const LAS bf16x8*)(kb + d0 * 2048), k1 = *(const LAS bf16x8*)(kb + d0 * 2048 + 512);
              p0 = __builtin_amdgcn_mfma_f32_32x32x16_bf16(k0, qr[d0], p0, 0, 0, 0); p1 = __builtin_amdgcn_mfma_f32_32x32x16_bf16(k1, qr[d0], p1, 0, 0, 0); } }
        const float rm = rowmax32(p0, p1);
        if (__any(rm > mref + 8.0f)) {
            const float mn = fmaxf(mref, rm), al = __builtin_amdgcn_exp2f(mref - mn); mref = mn; lsum *= al;
            if (hi == 0) wsf[r32] = al;
            LDS_WAIT(); asm volatile("" ::: "memory");
#pragma unroll
            for (int r = 0; r < 16; ++r) { const float f = wsf[crow(r, hi)]; o[0][r] *= f; o[1][r] *= f; }
            LDS_WAIT(); asm volatile("" ::: "memory");
        }
        float sacc = 0.f;
#pragma unroll
        for (int r = 0; r < 16; ++r) { p0[r] = __builtin_amdgcn_exp2f(p0[r] - mref); p1[r] = __builtin_amdgcn_exp2f(p1[r] - mref); sacc += p0[r] + p1[r]; }
        lsum += sacc;
        v4u pw[4];
#pragma unroll
        for (int k = 0; k < 2; ++k) { pw[k] = (v4u){cvtpk(p0[8 * k], p0[8 * k + 1]), cvtpk(p0[8 * k + 2], p0[8 * k + 3]), cvtpk(p0[8 * k + 4], p0[8 * k + 5]), cvtpk(p0[8 * k + 6], p0[8 * k + 7])};
            pw[2 + k] = (v4u){cvtpk(p1[8 * k], p1[8 * k + 1]), cvtpk(p1[8 * k + 2], p1[8 * k + 3]), cvtpk(p1[8 * k + 4], p1[8 * k + 5]), cvtpk(p1[8 * k + 6], p1[8 * k + 7])}; }
        { const int vb = (int)(lds0 + slot * SLOT + KT_BYTES) + ((lane >> 4) & 1) * 32 + (lane & 3) * 8 + (4 * hi + ((lane & 15) >> 2)) * 64;
#pragma unroll
          for (int d0 = 0; d0 < 2; ++d0) { s16x4 lo[4], hh[4];
#pragma unroll
              for (int ks = 0; ks < 4; ++ks) {
                  asm volatile("ds_read_b64_tr_b16 %0,%1 offset:%c2" : "=&v"(lo[ks]) : "v"(vb), "i"(d0 * 4096 + ks * 1024) : "memory");
                  asm volatile("ds_read_b64_tr_b16 %0,%1 offset:%c2" : "=&v"(hh[ks]) : "v"(vb), "i"(d0 * 4096 + ks * 1024 + 512) : "memory"); }
              asm volatile("s_waitcnt lgkmcnt(0)" ::: "memory"); __builtin_amdgcn_sched_barrier(0);
#pragma unroll
              for (int ks = 0; ks < 4; ++ks) { const bf16x8 vf = (bf16x8){lo[ks][0], lo[ks][1], lo[ks][2], lo[ks][3], hh[ks][0], hh[ks][1], hh[ks][2], hh[ks][3]};
                  o[d0] = __builtin_amdgcn_mfma_f32_32x32x16_bf16(__builtin_bit_cast(bf16x8, pw[ks]), vf, o[d0], 0, 0, 0); } } }
        ATT_WAIT_BAR();
    }
    lsum = add_xor32(lsum);
    if (hi == 0) wsf[32 + r32] = lsum;
    LDS_WAIT(); asm volatile("" ::: "memory");
#pragma unroll
    for (int r = 0; r < 16; ++r) { const int q = crow(r, hi); const float inv = 1.0f / wsf[32 + q];
        bf16* op = Z + (size_t)(row0 + q) * ZLD + ZC_CQ + h * 64 + r32;
        op[0] = (bf16)f2bf(o[0][r] * inv); op[32] = (bf16)f2bf(o[1][r] * inv); }
    ATT_WAIT_BAR();
}
}

constexpr int NCHUNK = MT / 64;
__device__ __forceinline__ void gdn_halo_copy(CArgs& a, int gw, int NGW, int lane) {
    const bf16* Z = (const bf16*)(a.ws + WS_Z); bf16* HL = (bf16*)(a.ws + WS_HALO);
    for (int it = gw; it < NCHUNK * 4; it += NGW) {
        const int cg = it >> 2, slot = it & 3, b = cg / 68, c = cg - b * 68;
        const int lo = c < 4 ? 0 : CTXL, hi = c < 4 ? CTXL : TPB;
        const int t = 64 * c + (slot < 2 ? slot - 2 : 62 + slot);
        const bool ok = t >= lo && t < hi;
        const GAS v4u* src = (const GAS v4u*)(Z + ((size_t)b * TPB + (ok ? t : 64 * c)) * ZLD);
        GAS v4u* dst = (GAS v4u*)(HL + (size_t)it * 1536);
#pragma unroll
        for (int j = 0; j < 3; ++j) { v4u v = src[lane + 64 * j]; if (!ok) v = (v4u){0u, 0u, 0u, 0u}; dst[lane + 64 * j] = v; }
    }
}
__device__ __forceinline__ void gdn_conv_pass(CArgs& a, LAS unsigned char* lds, int layer, int vcu, int G) {
    int tid_ = threadIdx.x; asm volatile("" : "+v"(tid_)); const int tid = tid_, lane = tid & 63, wave = tid >> 6;
    bf16* Z = (bf16*)(a.ws + WS_Z); const bf16* HL = (const bf16*)(a.ws + WS_HALO); float* BG = (float*)(a.ws + WS_BG);
    LAS bf16* RAW = (LAS bf16*)lds;
    const int h = vcu & 3;
    float cw[5][3][2];
#pragma unroll
    for (int j = 0; j < 5; ++j)
#pragma unroll
        for (int sg = 0; sg < 3; ++sg) { const float* p = a.in[I_GCONV] + (size_t)layer * 5 * 1536 + j * 1536 + sg * 512 + h * 128 + 2 * lane; cw[j][sg][0] = p[0]; cw[j][sg][1] = p[1]; }
    float A_[2], dtb[2];
#pragma unroll
    for (int d = 0; d < 2; ++d) { A_[d] = __expf(a.in[I_GALOG][layer * 8 + d * 4 + h]); dtb[d] = a.in[I_GDT][layer * 8 + d * 4 + h]; }
    for (int u = vcu; u < NCHUNK * 4; u += G) {
        const int cg = u >> 2; const size_t row0 = (size_t)cg * 64;
        __syncthreads();
        for (int idx = tid; idx < 68 * 48; idx += 512) { const int rr = idx / 48, ch = idx - rr * 48; const int colz = (ch >> 4) * 512 + h * 128 + (ch & 15) * 8;
            const bf16* src = (rr >= 2 && rr < 66) ? Z + (row0 + rr - 2) * ZLD + colz : HL + ((size_t)cg * 4 + (rr < 2 ? rr : rr - 64)) * 1536 + colz;
            *(LAS v4u*)(RAW + rr * 384 + ch * 8) = *(const GAS v4u*)src; }
        if (tid < 128) { const int i = tid & 63, dir = tid >> 6; const bf16* zr = Z + (row0 + i) * ZLD;
            const float zb = bf2f(zr[ZC_GB + dir * 4 + h]), za = bf2f(zr[ZC_GA + dir * 4 + h]);
            float* o = BG + ((row0 + i) * 4 + h) * 4 + dir * 2; o[0] = sigmoidf_(zb); o[1] = -(dir ? A_[1] : A_[0]) * softplusf_(za + (dir ? dtb[1] : dtb[0])); }
        __syncthreads();
        float win[5][3][2];
#pragma unroll
        for (int j = 0; j < 4; ++j)
#pragma unroll
            for (int sg = 0; sg < 3; ++sg) { const unsigned wv = *(const LAS unsigned*)(RAW + (8 * wave + j) * 384 + sg * 128 + 2 * lane); win[j + 1][sg][0] = bflo(wv); win[j + 1][sg][1] = bfhi(wv); }
#pragma unroll
        for (int tt = 0; tt < 8; ++tt) { const int i = 8 * wave + tt;
#pragma unroll
            for (int j = 0; j < 4; ++j)
#pragma unroll
                for (int sg = 0; sg < 3; ++sg) { win[j][sg][0] = win[j + 1][sg][0]; win[j][sg][1] = win[j + 1][sg][1]; }
#pragma unroll
            for (int sg = 0; sg < 3; ++sg) { const unsigned wv = *(const LAS unsigned*)(RAW + (i + 4) * 384 + sg * 128 + 2 * lane); win[4][sg][0] = bflo(wv); win[4][sg][1] = bfhi(wv); }
            float y[3][2];
#pragma unroll
            for (int sg = 0; sg < 3; ++sg)
#pragma unroll
                for (int e = 0; e < 2; ++e) { float acc = 0.f;
#pragma unroll
                    for (int j = 0; j < 5; ++j) acc += cw[j][sg][e] * win[j][sg][e];
                    y[sg][e] = siluf_(acc); }
            const float sq = rsqrtf(wave_sum(y[0][0] * y[0][0] + y[0][1] * y[0][1]) + 1e-6f) * 0.08838834764831845f, sk = rsqrtf(wave_sum(y[1][0] * y[1][0] + y[1][1] * y[1][1]) + 1e-6f);
            bf16* zr = Z + (row0 + i) * ZLD + h * 128 + 2 * lane;
            *(unsigned*)(zr + ZC_GQ) = pk2(y[0][0] * sq, y[0][1] * sq); *(unsigned*)(zr + ZC_GK) = pk2(y[1][0] * sk, y[1][1] * sk); *(unsigned*)(zr + ZC_GV) = pk2(y[2][0], y[2][1]); }
    }
}

namespace gdn1 {
typedef short v4i16 __attribute__((ext_vector_type(4)));
constexpr int LD = 136, LDT = 72, LDS_ = 160;
constexpr int KB_OFF = 0, QB_OFF = 17408, VB_OFF = 34816  , SB_OFF = 55296  , WB_OFF = 96256, TB_OFF = 113664, AQ_OFF = 122880, LB_OFF = 132096, LDG_OFF = 141312  ,
              XS_OFF = 145664  , YS_OFF = 147200  , SC_OFF = 149760  , SS_OFF = 151104  , END_OFF = 152128;
static_assert(END_OFF + 256 <= LDSCTL_OFF, "gdn1 LDS map");
__device__ __forceinline__ int crow(int r, int hi) { return (r & 3) + 8 * (r >> 2) + 4 * hi; }
__device__ __forceinline__ s16x4 trr(const LAS bf16* p) { return __builtin_bit_cast(s16x4, __builtin_amdgcn_ds_read_tr16_b64_v4i16((LAS v4i16*)p)); }
__device__ __forceinline__ bf16x8 frag_rk(const LAS bf16* base, int ld, int row0, int k0, int lane) { return *(const LAS bf16x8*)(base + (row0 + (lane & 31)) * ld + k0 + 8 * (lane >> 5)); }
__device__ __forceinline__ bf16x8 frag_kr(const LAS bf16* base, int ld, int k0, int x0, int lane) {
    const LAS bf16* p = base + (k0 + 8 * (lane >> 5) + ((lane & 15) >> 2)) * ld + x0 + 16 * ((lane >> 4) & 1) + 4 * (lane & 3);
    const s16x4 lo = trr(p), hi = trr(p + 4 * ld);
    return (bf16x8){lo[0], lo[1], lo[2], lo[3], hi[0], hi[1], hi[2], hi[3]}; }
__device__ __forceinline__ void cstore(const f32x16& acc, LAS bf16* base, int ld, int row0, int col0, int lane, float sgn) {
    const int hi = lane >> 5, l31 = lane & 31;
#pragma unroll
    for (int r = 0; r < 16; ++r) base[(row0 + crow(r, hi)) * ld + col0 + l31] = (bf16)f2bf(sgn * acc[r]); }
__device__ __forceinline__ void cstore_t(const f32x16& acc, LAS bf16* base, int ld, int R0, int C0, int lane) {
    const int hi = lane >> 5, l31 = lane & 31;
#pragma unroll
    for (int g = 0; g < 4; ++g) { v2u w; w.x = pk2(acc[4 * g], acc[4 * g + 1]); w.y = pk2(acc[4 * g + 2], acc[4 * g + 3]); *(LAS v2u*)(base + (C0 + l31) * ld + R0 + 8 * g + 4 * hi) = w; } }
#define MFMA32(a, b, c) __builtin_amdgcn_mfma_f32_32x32x16_bf16(a, b, c, 0, 0, 0)
#define SB() __builtin_amdgcn_sched_barrier(0)

__device__ __forceinline__ void chain(CArgs& a, LAS unsigned char* lds, int layer, int b, int h, int dir) {
    int tid0_ = threadIdx.x; asm volatile("" : "+v"(tid0_)); const int w = __builtin_amdgcn_readfirstlane(tid0_ >> 6);
    bf16* Z = (bf16*)(a.ws + WS_Z); bf16* OS = (bf16*)(a.ws + WS_OSG);
    unsigned* hcnt = (unsigned*)(a.ws + WS_CTL) + CW_HOFF_G + (layer * 32 + b * 4 + h) * 68; unsigned* hrdy = hcnt + 8192;  const float* BG = (const float*)(a.ws + WS_BG);
    LAS bf16* Kb = (LAS bf16*)(lds + KB_OFF); LAS bf16* Qb = (LAS bf16*)(lds + QB_OFF); LAS bf16* Vb = (LAS bf16*)(lds + VB_OFF); LAS bf16* Sb = (LAS bf16*)(lds + SB_OFF);
    LAS bf16* Wb = (LAS bf16*)(lds + WB_OFF); LAS bf16* Tb = (LAS bf16*)(lds + TB_OFF); LAS bf16* Aq = (LAS bf16*)(lds + AQ_OFF); LAS bf16* Lb = (LAS bf16*)(lds + LB_OFF);
    LAS float* Ldg = (LAS float*)(lds + LDG_OFF); LAS bf16* XS = (LAS bf16*)(lds + XS_OFF); LAS bf16* YS = (LAS bf16*)(lds + YS_OFF);
    LAS float* bet = (LAS float*)(lds + SC_OFF); LAS float* gc = bet + 64; LAS float* eg = bet + 128; LAS float* ekl = bet + 192; LAS float* bes = bet + 256; LAS float* egl = bet + 320;
    LAS float* SS = (LAS float*)(lds + SS_OFF); LAS float* DUM = (LAS float*)(lds + END_OFF);
    const size_t rowb = (size_t)b * TPB;
    const int tr = w >> 2, tc = w & 3;
    const int sr = w >> 1, sc0 = 2 * (w & 1);
    const float gnv = a.in[I_GNORM][layer * 128 + 32 * tc + (tid0_ & 31)];
    {
        f32x16 accS[2]; accS[0] = f32x16{}; accS[1] = f32x16{};
        __syncthreads();
        { int tid_ = threadIdx.x; asm volatile("" : "+v"(tid_)); const int tid = tid_;
        for (int i = tid; i < 128 * LD / 2; i += 512) ((LAS unsigned*)Sb)[i] = 0u;
        for (int i = tid; i < 64 * LDT / 2; i += 512) ((LAS unsigned*)Tb)[i] = 0u; }
        v4u pf[6]; float pbg0 = 0.f, pbg1 = 0.f; int plo = 0, phi = -1; bool drain = false;
#define GDN_T0(step) (64 * ((step) < 4 ? (dir ? 3 - (step) : (step)) : 4 + (dir ? 63 - ((step) - 4) : (step) - 4)))
#define GDN_PREFETCH(step) do { const int t0n = GDN_T0(step); const bf16* zb_ = Z + (rowb + t0n) * ZLD + h * 128; \
            _Pragma("unroll") for (int m = 0; m < 6; ++m) { const int idx = tid + 512 * m, mat = idx >> 10, rem = idx & 1023, i = rem >> 4, ch = rem & 15; \
                pf[m] = *(const GAS v4u*)(zb_ + (unsigned)((dir ? 63 - i : i) * ZLD + mat * 512 + ch * 8)); } \
            if (w == 7) { const float* p = BG + (rowb + t0n) * 16 + h * 4 + dir * 2 + (unsigned)((dir ? 63 - lane : lane) * 16); pbg0 = p[0]; pbg1 = p[1]; } } while (0)
#define GDN_COMMIT() do { \
            _Pragma("unroll") for (int m = 0; m < 6; ++m) { const int idx = tid + 512 * m, mat = idx >> 10, rem = idx & 1023, i = rem >> 4, ch = rem & 15; \
                *(LAS v4u*)((mat == 0 ? Qb + i * LD : (mat == 1 ? Kb + i * LD : Vb + i * LDS_)) + ch * 8) = pf[m]; } \
            if (w == 7) { const float v = wave_incl_scan(pbg1); \
                const float gl = __builtin_bit_cast(float, __builtin_amdgcn_readlane(__builtin_bit_cast(int, v), 63)); const float e = __expf(v); \
                bet[lane] = pbg0; gc[lane] = v; eg[lane] = e; ekl[lane] = __expf(gl - v); bes[lane] = pbg0 * e; if (lane == 0) egl[0] = __expf(gl); } } while (0)
        { int tid_ = threadIdx.x; asm volatile("" : "+v"(tid_)); const int tid = tid_, lane = tid & 63;
          GDN_PREFETCH(0);
          GDN_COMMIT(); }
        __syncthreads();
        for (int step = 0; step < 68; ++step) {
            int tid_ = threadIdx.x; asm volatile("" : "+v"(tid_)); const int tid = tid_, lane = tid & 63, l31 = lane & 31, hi = lane >> 5;
            const int t0 = GDN_T0(step);
            const bool want = !(layer == DEPTH - 1 && step < 4);
            const int cix = t0 >> 6;
            const bool second = (step < 4) ? (step >= 2) : (step >= 36);
            if (w == 5 && lane == 0) {
                if (phi >= plo) { __builtin_amdgcn_fence(__ATOMIC_RELEASE, "agent"); asm volatile("s_waitcnt vmcnt(0)" ::: "memory");
                    for (int st = plo; st <= phi; ++st) { const bool fst = (st < 4) ? (st < 2) : (st < 36); if (fst && !(layer == DEPTH - 1 && st < 4)) __hip_atomic_store(hrdy + (GDN_T0(st) >> 6), 1u, RLX_AGENT); } }
                if (want && second) { unsigned sp = 0; while (__hip_atomic_load(hrdy + cix, RLX_AGENT) == 0u && ++sp < (1u << 22)) __builtin_amdgcn_s_sleep(2);
                    __builtin_amdgcn_fence(__ATOMIC_ACQUIRE, "agent"); asm volatile("s_waitcnt vmcnt(0)" ::: "memory"); }
            }
            if (phi >= plo) plo = phi + 1;
            if (step + 1 < 68) GDN_PREFETCH(step + 1);
            {   const int ti = (w >> 1) & 1, tj = w & 1; const LAS bf16* src = w < 4 ? Kb : Qb;
                f32x16 acc = f32x16{};
                if (!(ti == 0 && tj == 1)) {
#pragma unroll
                    for (int hf = 0; hf < 2; ++hf) { bf16x8 fa[4], fb[4];
#pragma unroll
                        for (int s = 0; s < 4; ++s) { fa[s] = frag_rk(src, LD, 32 * ti, 64 * hf + 16 * s, lane); fb[s] = frag_rk(Kb, LD, 32 * tj, 64 * hf + 16 * s, lane); }
                        SB();
#pragma unroll
                        for (int s = 0; s < 4; ++s) acc = MFMA32(fb[s], fa[s], acc);
                        SB(); } }
                const int i = 32 * ti + l31; const float gci = gc[i];
                if (w < 4) {
                    const bool dg = ti == tj; const float bi = bet[i];
#pragma unroll
                    for (int r = 0; r < 16; ++r) { const int j = 32 * tj + crow(r, hi); const float e = __expf(gci - gc[j]);
                        const float val = i > j ? bi * acc[r] * e : 0.f; acc[r] = val;
                        const bool d16 = dg && ((r >> 3) == (l31 >> 4));
                        (d16 ? Ldg + ((i >> 4) * 16 + (i & 15)) * 17 + (j & 15) : DUM + lane)[0] = val; }
                    cstore_t(acc, Lb, LDT, 32 * tj, 32 * ti, lane);
                } else {
#pragma unroll
                    for (int r = 0; r < 16; ++r) { const int j = 32 * tj + crow(r, hi); const float e = __expf(gci - gc[j]);
                        acc[r] = i >= j ? acc[r] * e : 0.f; }
                    cstore_t(acc, Aq, LDT, 32 * tj, 32 * ti, lane); }
            }
            LBAR();
            if (w < 4) {
                const int c = lane & 15; float t[16];
#pragma unroll
                for (int i = 0; i < 16; ++i) { float s = (i == c) ? 1.f : 0.f;
#pragma unroll
                    for (int j = 0; j < i; ++j) s -= Ldg[(w * 16 + i) * 17 + j] * t[j];
                    t[i] = s; }
                if (lane < 16) {
#pragma unroll
                    for (int i = 0; i < 16; ++i) Tb[(16 * w + i) * LDT + 16 * w + c] = (bf16)f2bf(t[i]); }
            } else {
                const int t2 = tid - 256, row = t2 >> 2, c0 = (t2 & 3) * 32; const float bv = bet[row];
#pragma unroll
                for (int q = 0; q < 4; ++q) { LAS v4u* p = (LAS v4u*)(Vb + row * LDS_ + c0 + 8 * q); v4u v = *p;
                    v.x = pk2(bflo(v.x) * bv, bfhi(v.x) * bv); v.y = pk2(bflo(v.y) * bv, bfhi(v.y) * bv); v.z = pk2(bflo(v.z) * bv, bfhi(v.z) * bv); v.w = pk2(bflo(v.w) * bv, bfhi(v.w) * bv); *p = v; }
            }
            LBAR();
            if (w < 2) {
                const int p = w, r16 = lane & 15, g = lane >> 4, g1 = g & 1; const bool act = g < 2;
                typedef float f32x4_ __attribute__((ext_vector_type(4)));
                bf16x8 af = *(const LAS bf16x8*)(Lb + (32 * p + 16 + r16) * LDT + 32 * p + 8 * g1), bfr;
#pragma unroll
                for (int j = 0; j < 8; ++j) bfr[j] = (short)Tb[(32 * p + 8 * g1 + j) * LDT + 32 * p + r16];
                if (!act) { af = bf16x8{}; bfr = bf16x8{}; }
                f32x4_ x = __builtin_amdgcn_mfma_f32_16x16x32_bf16(af, bfr, (f32x4_){0.f, 0.f, 0.f, 0.f}, 0, 0, 0);
                LAS bf16* xs = XS + p * 16 * 24;
#pragma unroll
                for (int q = 0; q < 4; ++q) xs[(4 * g + q) * 24 + r16] = (bf16)f2bf(x[q]);
                LDS_WAIT(); asm volatile("" ::: "memory");
                af = *(const LAS bf16x8*)(Tb + (32 * p + 16 + r16) * LDT + 32 * p + 16 + 8 * g1);
#pragma unroll
                for (int j = 0; j < 8; ++j) bfr[j] = (short)xs[(8 * g1 + j) * 24 + r16];
                if (!act) { af = bf16x8{}; bfr = bf16x8{}; }
                const f32x4_ tt = __builtin_amdgcn_mfma_f32_16x16x32_bf16(af, bfr, (f32x4_){0.f, 0.f, 0.f, 0.f}, 0, 0, 0);
#pragma unroll
                for (int q = 0; q < 4; ++q) Tb[(32 * p + 16 + 4 * g + q) * LDT + 32 * p + r16] = (bf16)f2bf(-tt[q]);
            }
            LBAR();
            if (w == 0) {
                f32x16 y = f32x16{};
#pragma unroll
                for (int s = 0; s < 2; ++s) y = MFMA32(frag_rk(Lb, LDT, 32, 16 * s, lane), frag_kr(Tb, LDT, 16 * s, 0, lane), y);
                cstore(y, YS, 40, 0, 0, lane, 1.f);
                LDS_WAIT(); asm volatile("" ::: "memory");
                f32x16 z = f32x16{};
#pragma unroll
                for (int s = 0; s < 2; ++s) z = MFMA32(frag_rk(Tb, LDT, 32, 32 + 16 * s, lane), frag_kr(YS, 40, 16 * s, 0, lane), z);
                cstore(z, Tb, LDT, 32, 0, lane, -1.f);
            }
            LBAR();
            f32x16 accU = f32x16{};
            {   f32x16 accW = f32x16{};
                const int ns = tr == 0 ? 2 : 4;
                bf16x8 ta[4], tw[4], fv[4], fk[4];
#pragma unroll
                for (int s = 0; s < 4; ++s) if (s < ns) { ta[s] = frag_rk(Tb, LDT, 32 * tr, 16 * s, lane); fv[s] = frag_kr(Vb, LDS_, 16 * s, 32 * tc, lane); fk[s] = frag_kr(Kb, LD, 16 * s, 32 * tc, lane); }
                SB();
#pragma unroll
                for (int s = 0; s < 4; ++s) if (s < ns) { const LAS float* bs = bes + 16 * s + 8 * hi;
#pragma unroll
                    for (int j = 0; j < 8; ++j) tw[s][j] = (short)f2bf(bf2f((unsigned short)ta[s][j]) * bs[j]); }
#pragma unroll
                for (int s = 0; s < 4; ++s) if (s < ns) { accU = MFMA32(ta[s], fv[s], accU); accW = MFMA32(fk[s], tw[s], accW); }
                SB();
                cstore_t(accW, Wb, LD, 32 * tc, 32 * tr, lane);
            }
            LBAR();
            unsigned short osv[16];
            if (want && second) {
                const bf16* ob_ = OS + (rowb + t0) * 512 + h * 128 + 32 * tc;
#pragma unroll
                for (int r = 0; r < 16; ++r) { const int i = 32 * tr + crow(r, hi), tk = dir ? 63 - i : i; osv[r] = ob_[(unsigned)(tk * 512 + l31)]; }
            }
            {   f32x16 ws = f32x16{};
#pragma unroll
                for (int hf = 0; hf < 2; ++hf) { bf16x8 fa[4], fb[4];
#pragma unroll
                  for (int s = 0; s < 4; ++s) { fa[s] = frag_rk(Wb, LD, 32 * tr, 64 * hf + 16 * s, lane); fb[s] = frag_rk(Sb, LD, 32 * tc, 64 * hf + 16 * s, lane); }
                  SB();
#pragma unroll
                  for (int s = 0; s < 4; ++s) ws = MFMA32(fa[s], fb[s], ws);
                  SB(); }
#pragma unroll
                for (int r = 0; r < 16; ++r) accU[r] -= ws[r];
                cstore_t(accU, Vb, LDT, 32 * tr, 32 * tc, lane);
                const int row = tid >> 3, c0 = (tid & 7) * 16; const float kv = ekl[row];
#pragma unroll
                for (int q = 0; q < 2; ++q) { LAS v4u* p = (LAS v4u*)(Kb + row * LD + c0 + 8 * q); v4u v = *p;
                    v.x = pk2(bflo(v.x) * kv, bfhi(v.x) * kv); v.y = pk2(bflo(v.y) * kv, bfhi(v.y) * kv); v.z = pk2(bflo(v.z) * kv, bfhi(v.z) * kv); v.w = pk2(bflo(v.w) * kv, bfhi(v.w) * kv); *p = v; }
            }
            LBAR();
            unsigned short gtv[16];
            if (want && second) {
                const bf16* gb_ = Z + (rowb + t0) * ZLD + ZC_GG + h * 128 + 32 * tc;
#pragma unroll
                for (int r = 0; r < 16; ++r) { const int i = 32 * tr + crow(r, hi), tk = dir ? 63 - i : i; gtv[r] = gb_[(unsigned)(tk * ZLD + l31)]; }
            }
            if (drain) VM_WAIT();
            f32x16 o = f32x16{};
            {
#pragma unroll
                for (int hf = 0; hf < 2; ++hf) { bf16x8 fa[4], fb[4];
#pragma unroll
                  for (int s = 0; s < 4; ++s) { fa[s] = frag_rk(Qb, LD, 32 * tr, 64 * hf + 16 * s, lane); fb[s] = frag_rk(Sb, LD, 32 * tc, 64 * hf + 16 * s, lane); }
                  SB();
#pragma unroll
                  for (int s = 0; s < 4; ++s) o = MFMA32(fa[s], fb[s], o);
                  SB(); }
#pragma unroll
                for (int r = 0; r < 16; ++r) o[r] *= eg[32 * tr + crow(r, hi)];
                const int ns = tr == 0 ? 2 : 4;
                const float el = egl[0];
                { bf16x8 fq[4], fv[4];
#pragma unroll
                  for (int s = 0; s < 4; ++s) if (s < ns) { fq[s] = frag_rk(Aq, LDT, 32 * tr, 16 * s, lane); fv[s] = frag_rk(Vb, LDT, 32 * tc, 16 * s, lane); }
                  SB();
#pragma unroll
                  for (int s = 0; s < 4; ++s) if (s < ns) o = MFMA32(fq[s], fv[s], o);
                  SB(); }
#pragma unroll
                for (int r = 0; r < 16; ++r) { accS[0][r] *= el; accS[1][r] *= el; }
#pragma unroll
                for (int hf = 0; hf < 2; ++hf) { bf16x8 fk[2], fv0[2], fv1[2];
#pragma unroll
                  for (int s = 0; s < 2; ++s) { const int k0 = 32 * hf + 16 * s; fk[s] = frag_kr(Kb, LD, k0, 32 * sr, lane); fv0[s] = frag_rk(Vb, LDT, 32 * sc0, k0, lane); fv1[s] = frag_rk(Vb, LDT, 32 * (sc0 + 1), k0, lane); }
                  SB();
#pragma unroll
                  for (int s = 0; s < 2; ++s) { accS[0] = MFMA32(fk[s], fv0[s], accS[0]); accS[1] = MFMA32(fk[s], fv1[s], accS[1]); }
                  SB(); }
            }
            if (want) {
                if (!second) { bf16* ob_ = OS + (rowb + t0) * 512 + h * 128 + 32 * tc;
#pragma unroll
                    for (int r = 0; r < 16; ++r) { const int i = 32 * tr + crow(r, hi), tk = dir ? 63 - i : i; ob_[(unsigned)(tk * 512 + l31)] = (bf16)f2bf(o[r]); }
                } else {
                    float q[16], t[16];
#pragma unroll
                    for (int r = 0; r < 16; ++r) { o[r] += bf2f(osv[r]); q[r] = row_sum16(o[r] * o[r]); }
#pragma unroll
                    for (int r = 0; r < 16; ++r) t[r] = swz_xor<16>(q[r]);
#pragma unroll
                    for (int r = 0; r < 16; ++r) SS[(32 * tr + crow(r, hi)) * 4 + tc] = q[r] + t[r];
                }
            }
            LBAR();
            cstore_t(accS[0], Sb, LD, 32 * sr, 32 * sc0, lane); cstore_t(accS[1], Sb, LD, 32 * sr, 32 * (sc0 + 1), lane);
            if (want && second) { bf16* gb_ = Z + (rowb + t0) * ZLD + ZC_GG + h * 128 + 32 * tc;
#pragma unroll
                for (int r = 0; r < 16; ++r) { const int i = 32 * tr + crow(r, hi), tk = dir ? 63 - i : i; const f32x4 p4 = *(const LAS f32x4*)(SS + i * 4);
                    const float rs = rsqrtf(((p4.x + p4.y) + (p4.z + p4.w)) * (1.f / 128.f) + EPS);
                    gb_[(unsigned)(tk * ZLD + l31)] = (bf16)f2bf(o[r] * rs * gnv * siluf_(bf2f(gtv[r]))); }
            }
            if (step + 1 < 68) GDN_COMMIT();
            {   const bool mine = want && !second, urgent = mine && (step == 1 || step == 35);
                if (urgent) VM_WAIT();
                if (urgent) phi = step; else if (drain) phi = step - 1;
                drain = mine && !urgent; }
            LBAR();
        }
    }
#undef GDN_T0
#undef GDN_PREFETCH
#undef GDN_COMMIT
}
}


namespace hg1 {
using gdn1::crow; using gdn1::frag_rk; using gdn1::frag_kr; using gdn1::cstore; using gdn1::cstore_t;
constexpr int LD = 136, LDV = 72, LDK = 160, LDW = 96;
constexpr int A_OFF = 0  , B_OFF = 43520, K_OFF = 60928  , V_OFF = 81408  , S_OFF = 93696  , AT_OFF = 118272, TOT_OFF = 127488  , EBL_OFF = 129536  , SS_OFF = 130048  ;
static_assert(SS_OFF + 512 <= LDSCTL_OFF, "hg1 LDS map");
__device__ __forceinline__ int arow(int J) { return J == 0 ? 0 : (J == 1 ? 64 : (J == 2 ? 112 : 144)); }
__device__ __forceinline__ void chain(CArgs& a, LAS unsigned char* lds, int layer, int b, int h, int dir) {
    int tid0_ = threadIdx.x; asm volatile("" : "+v"(tid0_)); const int w = __builtin_amdgcn_readfirstlane(tid0_ >> 6);
    bf16* Z = (bf16*)(a.ws + WS_Z); bf16* OS = (bf16*)(a.ws + WS_OSH);
    unsigned* hcnt = (unsigned*)(a.ws + WS_CTL) + CW_HOFF_H + (layer * 32 + b * 4 + h) * 68; unsigned* hrdy = hcnt + 8192; const float* LB = (const float*)(a.ws + WS_LB);
    LAS bf16* Ab = (LAS bf16*)(lds + A_OFF); LAS bf16* Bm = (LAS bf16*)(lds + B_OFF); LAS bf16* Kt = (LAS bf16*)(lds + K_OFF); LAS bf16* Vb = (LAS bf16*)(lds + V_OFF);
    LAS bf16* Sb = (LAS bf16*)(lds + S_OFF); LAS bf16* At = (LAS bf16*)(lds + AT_OFF); LAS float* tot = (LAS float*)(lds + TOT_OFF); LAS float* ebl = (LAS float*)(lds + EBL_OFF); LAS float* SS = (LAS float*)(lds + SS_OFF);
    const size_t rowb = (size_t)b * TPB;
    const int mblk = w >> 1;
    const int sr = w >> 1, sc = w & 1;
    const int tr = (w >> 1) & 1, tc = w & 1;
    const float hnv = a.in[I_HNORM][layer * 64 + 32 * tc + (tid0_ & 31)];
    {
        f32x16 accS = f32x16{};
        const int zf = dir ? ZC_HFB : ZC_HFF;
        __syncthreads();
        { int tid_ = threadIdx.x; asm volatile("" : "+v"(tid_)); const int tid = tid_;
          for (int i = tid; i < 64 * LD / 2; i += 512) ((LAS unsigned*)Sb)[i] = 0u;
          for (int i = tid; i < 64 * LDV / 2; i += 512) ((LAS unsigned*)At)[i] = 0u; }
        unsigned short pxq[16], pxf[16]; v4u pv; int plo = 0, phi = -1; bool drain = false;
#define HG_T0(step) (64 * ((step) < 4 ? (dir ? 3 - (step) : (step)) : 4 + (dir ? 63 - ((step) - 4) : (step) - 4)))
#define HG_PREFETCH(step) do { const int t0n = HG_T0(step); const bf16* zb_ = Z + (rowb + t0n) * ZLD + h * 128 + (tid & 127); \
            _Pragma("unroll") for (int ii = 0; ii < 16; ++ii) { const int i = 16 * mblk + ii; const unsigned off_ = (unsigned)((dir ? 63 - i : i) * ZLD); pxq[ii] = zb_[off_ + ZC_HQ]; pxf[ii] = zb_[off_ + zf]; } \
            { const int i = tid >> 3, ch = tid & 7; pv = *(const GAS v4u*)(Z + (rowb + t0n) * ZLD + ZC_HI + h * 64 + (unsigned)((dir ? 63 - i : i) * ZLD + ch * 8)); } } while (0)
        { int tid_ = threadIdx.x; asm volatile("" : "+v"(tid_)); const int tid = tid_; HG_PREFETCH(0); }
        __syncthreads();
        for (int step = 0; step < 68; ++step) {
            int tid_ = threadIdx.x; asm volatile("" : "+v"(tid_)); const int tid = tid_, lane = tid & 63, l31 = lane & 31, hi = lane >> 5;
            const int t0 = HG_T0(step);
            const bool want = !(layer == DEPTH - 1 && step < 4);
            const int cix = t0 >> 6;
            const bool second = (step < 4) ? (step >= 2) : (step >= 36);
            const int d = tid & 127;
            float P[16], qv[16], kv[16];
            {   const float lbv = LB[layer * 1024 + dir * 512 + h * 128 + d], olb = 1.0f - lbv; float run = 1.f;
#pragma unroll
                for (int ii = 0; ii < 16; ++ii) { const float x = fmaxf(bf2f(pxf[ii]), -80.f); const float ex = __expf(-x);
                    const float sg = __builtin_amdgcn_rcpf(1.0f + ex); run *= lbv + olb * sg; P[ii] = run;
                    kv[ii] = olb * (ex * sg);
                    qv[ii] = bf2f(pxq[ii]) * 0.08838834764831845f; }
                tot[mblk * 128 + d] = run;
#pragma unroll
                for (int ii = 0; ii < 16; ++ii) { kv[ii] *= __builtin_amdgcn_rcpf(fmaxf(P[ii], 1e-30f)); Bm[(16 * mblk + ii) * LD + d] = (bf16)f2bf(kv[ii]); }
                *(LAS v4u*)(Vb + (tid >> 3) * LDW + (tid & 7) * 8) = pv;
            }
            if (step + 1 < 68) HG_PREFETCH(step + 1);
            LBAR();
            if (drain) VM_WAIT();
            {   const float t0_ = tot[d], t1_ = tot[128 + d], t2_ = tot[256 + d], t3_ = tot[384 + d];
                const float t12 = t1_ * t2_, t23 = t2_ * t3_;
                const float kf = mblk == 0 ? t0_ * t1_ * t23 : (mblk == 1 ? t1_ * t23 : (mblk == 2 ? t23 : t3_));
                if (mblk == 0) ebl[d] = t0_ * t1_ * t23;
#pragma unroll
                for (int ii = 0; ii < 16; ++ii) Kt[(16 * mblk + ii) * LDK + d] = (bf16)f2bf(kv[ii] * kf);
#pragma unroll
                for (int J = 0; J < 4; ++J) if (J <= mblk) {
                    float ej;
                    if (J == mblk) ej = 1.f; else if (mblk == 1) ej = t0_; else if (mblk == 2) ej = J == 0 ? t0_ * t1_ : t1_; else ej = J == 0 ? t0_ * t12 : (J == 1 ? t12 : t2_);
#pragma unroll
                    for (int ii = 0; ii < 16; ++ii) Ab[(arow(J) + 16 * (mblk - J) + ii) * LD + d] = (bf16)f2bf(qv[ii] * (P[ii] * ej)); }
            }
            LBAR();
            if (drain) { phi = step - 1; drain = false; }
            if (w == 7 && lane == 0) {
                if (phi >= plo) { __builtin_amdgcn_fence(__ATOMIC_RELEASE, "agent"); asm volatile("s_waitcnt vmcnt(0)" ::: "memory");
                    for (int st = plo; st <= phi; ++st) { const bool fst = (st < 4) ? (st < 2) : (st < 36); if (fst && !(layer == DEPTH - 1 && st < 4)) __hip_atomic_store(hrdy + (HG_T0(st) >> 6), 1u, RLX_AGENT); } }
                if (want && second) { unsigned sp = 0; while (__hip_atomic_load(hrdy + cix, RLX_AGENT) == 0u && ++sp < (1u << 22)) __builtin_amdgcn_s_sleep(2);
                    __builtin_amdgcn_fence(__ATOMIC_ACQUIRE, "agent"); asm volatile("s_waitcnt vmcnt(0)" ::: "memory"); }
            }
            if (phi >= plo) plo = phi + 1;
            for (int idx = w; idx < 10; idx += 8) {
                const int I = idx >= 6 ? 3 : (idx >= 3 ? 2 : (idx >= 1 ? 1 : 0)), J = idx - (I * (I + 1)) / 2;
                const int r16 = lane & 15, g = lane >> 4;
                f32x4 acc = (f32x4){0.f, 0.f, 0.f, 0.f};
                const LAS bf16* ap = Ab + (arow(J) + 16 * (I - J) + r16) * LD + 8 * g; const LAS bf16* bp = Bm + (16 * J + r16) * LD + 8 * g;
                { bf16x8 fa[4], fb[4];
#pragma unroll
                  for (int s = 0; s < 4; ++s) { fa[s] = *(const LAS bf16x8*)(ap + 32 * s); fb[s] = *(const LAS bf16x8*)(bp + 32 * s); }
                  SB();
#pragma unroll
                  for (int s = 0; s < 4; ++s) acc = __builtin_amdgcn_mfma_f32_16x16x32_bf16(fa[s], fb[s], acc, 0, 0, 0);
                  SB(); }
#pragma unroll
                for (int q = 0; q < 4; ++q) { const int ri = 4 * g + q; const float v = (I != J || ri >= r16) ? acc[q] : 0.f; At[(16 * I + ri) * LDV + 16 * J + r16] = (bf16)f2bf(v); }
            }
            LBAR();
            unsigned short osv[16], gtv[16];
            if (want && second && w < 4) {
                const bf16* ob_ = OS + (rowb + t0) * 256 + h * 64 + 32 * tc; const bf16* gb_ = Z + (rowb + t0) * ZLD + ZC_HG + h * 64 + 32 * tc;
#pragma unroll
                for (int r = 0; r < 16; ++r) { const int i = 32 * tr + crow(r, hi), tk = dir ? 63 - i : i; osv[r] = ob_[(unsigned)(tk * 256 + l31)]; gtv[r] = gb_[(unsigned)(tk * ZLD + l31)]; }
            }
            f32x16 o = f32x16{};
            if (w < 4) {
                { bf16x8 fa[8], fb[8];
#pragma unroll
                  for (int s = 0; s < 8; ++s) { fa[s] = frag_rk(Ab, LD, 32 * tr, 16 * s, lane); fb[s] = frag_rk(Sb, LD, 32 * tc, 16 * s, lane); }
                  SB();
#pragma unroll
                  for (int s = 0; s < 8; ++s) o = MFMA32(fa[s], fb[s], o);
                  SB(); }
                const int ns = tr == 0 ? 2 : 4;
                { bf16x8 fa[4], fb[4];
#pragma unroll
                  for (int s = 0; s < 4; ++s) if (s < ns) { fa[s] = frag_rk(At, LDV, 32 * tr, 16 * s, lane); fb[s] = frag_kr(Vb, LDW, 16 * s, 32 * tc, lane); }
                  SB();
#pragma unroll
                  for (int s = 0; s < 4; ++s) if (s < ns) o = MFMA32(fa[s], fb[s], o);
                  SB(); }
            }
            {   bf16x8 fa[4], fb[4];
#pragma unroll
                for (int s = 0; s < 4; ++s) { fa[s] = frag_kr(Kt, LDK, 16 * s, 32 * sr, lane); fb[s] = frag_kr(Vb, LDW, 16 * s, 32 * sc, lane); }
                SB();
#pragma unroll
                for (int r = 0; r < 16; ++r) accS[r] *= ebl[32 * sr + crow(r, hi)];
#pragma unroll
                for (int s = 0; s < 4; ++s) accS = MFMA32(fa[s], fb[s], accS);
                SB();
            }
            if (want && w < 4) {
                if (!second) { bf16* ob_ = OS + (rowb + t0) * 256 + h * 64 + 32 * tc;
#pragma unroll
                    for (int r = 0; r < 16; ++r) { const int i = 32 * tr + crow(r, hi), tk = dir ? 63 - i : i; ob_[(unsigned)(tk * 256 + l31)] = (bf16)f2bf(o[r]); }
                } else {
                    float q[16], t[16];
#pragma unroll
                    for (int r = 0; r < 16; ++r) { o[r] += bf2f(osv[r]); q[r] = row_sum16(o[r] * o[r]); }
#pragma unroll
                    for (int r = 0; r < 16; ++r) t[r] = swz_xor<16>(q[r]);
#pragma unroll
                    for (int r = 0; r < 16; ++r) SS[(32 * tr + crow(r, hi)) * 2 + tc] = q[r] + t[r];
                }
            }
            LBAR();
            cstore_t(accS, Sb, LD, 32 * sr, 32 * sc, lane);
            if (want && second && w < 4) { bf16* gb_ = Z + (rowb + t0) * ZLD + ZC_HG + h * 64 + 32 * tc;
#pragma unroll
                for (int r = 0; r < 16; ++r) { const int i = 32 * tr + crow(r, hi), tk = dir ? 63 - i : i;
                    const float rs = rsqrtf((SS[i * 2] + SS[i * 2 + 1]) * (1.f / 64.f) + EPS);
                    gb_[(unsigned)(tk * ZLD + l31)] = (bf16)f2bf(o[r] * rs * hnv * siluf_(bf2f(gtv[r]))); }
            }
            {   const bool mine = want && !second, urgent = mine && (step == 1 || step == 35);
                if (urgent) { VM_WAIT(); phi = step; }
                drain = mine && !urgent; }
            LBAR();
        }
    }
#undef HG_T0
#undef HG_PREFETCH
}
}

#ifndef PH_MASK
#define PH_MASK 0xFFFFF
#endif
#define PH_ON(i) (((PH_MASK) >> (i)) & 1)
constexpr int PH_PER_LAYER = 9, N_PHASES = 2 + DEPTH * PH_PER_LAYER;
enum PhaseKind { PK_GEMM_IN = 0, PK_MLA_UP, PK_MLA_ROPE, PK_MIX, PK_GEMM_OUT, PK_POST1, PK_MLP1, PK_MLP2, PK_POST2 };
constexpr int ATT_UNITS_LAT = NB * 4 * 16, ATT_UNITS_CTX = NB * 4;
__device__ __forceinline__ CArgs& kargs() { CArgs* p = (CArgs*)__builtin_amdgcn_kernarg_segment_ptr(); asm volatile("" : "+s"(p)); return *p; }

__global__ void __launch_bounds__(NWAVES * 64, 2) fwd_kernel(Args args_unused) {
    extern __shared__ __attribute__((aligned(16))) unsigned char lds_[];
    LAS unsigned char* lds = (LAS unsigned char*)lds_;
    {   const int tid = threadIdx.x;
        for (int u = tid; u < (LDS_BYTES - LDSCTL_OFF) / 4; u += NWAVES * 64) ((LAS unsigned*)(lds + LDSCTL_OFF))[u] = 0u; }
    __syncthreads();
    if (MK_ONE_LAUNCH) (void)xcd_barrier_post((unsigned*)(kargs().ws + WS_CTL) + CW_BAR, (volatile LAS unsigned*)(lds + MISC_OFF) + 8);
    const int ph_lo = kargs().ph_lo, ph_hi = kargs().ph_hi;
    int ph_start = ph_lo;
    if (ph_lo == 0) {
        CArgs& a = kargs();
        int tid_ = threadIdx.x; asm volatile("" : "+v"(tid_));
        const int tid = tid_, lane = tid & 63, wave = __builtin_amdgcn_readfirstlane(tid >> 6);
        const int G = gridDim.x, bx = blockIdx.x, vcu = (G % 8 == 0) ? (bx % 8) * (G / 8) + bx / 8 : bx;
        if constexpr (PH_ON(0)) p0a_prologue(a, lds, vcu, G, wave, lane, tid);
        if (1 < ph_hi) { XcdBarrier bar; bar.bar = (unsigned*)(kargs().ws + WS_CTL) + CW_BAR; bar.x = xb_xcc_id(); bar.st = (volatile LAS unsigned*)(lds + MISC_OFF) + 8; xcd_barrier(bar); }
        ph_start = 1;
    }
    for (int ph = ph_start; ph < ph_hi; ++ph) {
        CArgs& a = kargs();
        int tid_ = threadIdx.x; asm volatile("" : "+v"(tid_));
        const int tid = tid_, lane = tid & 63, wave = __builtin_amdgcn_readfirstlane(tid >> 6);
        const int G = gridDim.x, bx = blockIdx.x, vcu = (G % 8 == 0) ? (bx % 8) * (G / 8) + bx / 8 : bx;
        const int gw = vcu * NWAVES + wave, NGW = G * NWAVES;
        if (ph == 1) { if constexpr (PH_ON(1)) p0b_prenorm(a, gw, NGW, lane); }
        else {
            const int layer = (ph - 2) / PH_PER_LAYER, kind = (ph - 2) % PH_PER_LAYER;
            if (kind == PK_GEMM_IN || kind == PK_MLA_UP || kind == PK_GEMM_OUT || kind == PK_MLP1 || kind == PK_MLP2) {
                {
                    bf16* HB = (bf16*)(a.ws + WS_HB); bf16* Z = (bf16*)(a.ws + WS_Z);
                    const unsigned char* wb = a.ws + WS_W + (size_t)layer * W_LAYER;
                    pg8::StaticOrder S; const bool lastl = layer == DEPTH - 1;
#define RUN_GEMM(Aop, Bop, N_, K_, LDA_, Out, LDC_, ACT_) do { int kk_ = K_; asm volatile("" : "+s"(kk_)); const pg8::Gemm g{Aop, (const bf16*)(Bop), MT, N_, kk_, LDA_}; const pg8::EpiBf16 E{Out, LDC_, ACT_}; \
                        if (lastl && (ACT_ == 2 || (N_) == DM)) S.init(NB * SEQ, N_, G, bx, 1); else S.init(MT, N_, G, bx);   \
                        pg8::gemm_phase<pg8::EpiBf16, pg8::StaticOrder, true, true>(lds, g, S, E); } while (0)
                    if (kind == PK_GEMM_IN)     { if constexpr (PH_ON(2)) RUN_GEMM(HB, wb + W_IN, ZLD, DM, DM, Z, ZLD, 0); }
                    else if (kind == PK_MLA_UP) { if constexpr (PH_ON(3)) RUN_GEMM(Z + ZC_CQ, wb + W_UQ, 512, 256, ZLD, HB, DM, 0);
                                                  if constexpr (PH_ON(11)) RUN_GEMM(Z + ZC_CKV, wb + W_UKV, 512, 128, ZLD, HB + 512, DM, 0); }
                    else if (kind == PK_GEMM_OUT) { if constexpr (PH_ON(6)) RUN_GEMM(Z + ZC_GG, wb + W_OUT, DM, DM, ZLD, HB, DM, 0); }
                    else if (kind == PK_MLP1)   { if constexpr (PH_ON(8)) RUN_GEMM(HB, wb + W_1, DFF, DM, DM, Z, DFF, 2); }
                    else                        { if constexpr (PH_ON(9)) RUN_GEMM(Z, wb + W_2, DM, DFF, DFF, HB, DM, 0); }
#undef RUN_GEMM
                    if (kind == PK_MLA_UP) { if constexpr (PH_ON(3)) gdn_halo_copy(a, gw, NGW, lane); }
                }
            } else if (kind == PK_MLA_ROPE) { if constexpr (PH_ON(4)) { gdn_conv_pass(a, lds, layer, vcu, G); __syncthreads(); mla_rope_pass(a, lds, wave, gw, NGW, lane); } }
            else if (kind == PK_MIX) {
                if constexpr (PH_ON(5)) {
#ifndef MIX_PARTS
#define MIX_PARTS 7
#endif
                    if (bx < 64) { if constexpr (MIX_PARTS & 1) gdn1::chain(a, lds, layer, bx >> 3, (bx >> 1) & 3, bx & 1); }
                    else if (bx < 128) { if constexpr (MIX_PARTS & 2) hg1::chain(a, lds, layer, (bx - 64) >> 3, ((bx - 64) >> 1) & 3, bx & 1); }
                    __syncthreads();
                    CArgs& a2 = kargs(); int tq_ = threadIdx.x; asm volatile("" : "+v"(tq_));
                    volatile LAS unsigned* MISC = (volatile LAS unsigned*)(lds + MISC_OFF);
                    const bf16* HB = (const bf16*)(a2.ws + WS_HB); bf16* Z = (bf16*)(a2.ws + WS_Z); unsigned* qhead = (unsigned*)(a2.ws + WS_CTL) + CW_ATTQ + 64 * layer;
                    const int nunits = ATT_UNITS_LAT + (layer == DEPTH - 1 ? 0 : ATT_UNITS_CTX);
                    for (;;) {
                        if (tq_ == 0) MISC[0] = __hip_atomic_fetch_add(qhead, 1u, __ATOMIC_RELAXED, __HIP_MEMORY_SCOPE_AGENT);
                        __syncthreads();
                        const int u = (int)MISC[0];
                        __syncthreads();
                        if (u >= nunits) break;
                        int b, h, qb;
                        if (u < ATT_UNITS_LAT) { b = u >> 6; h = (u >> 4) & 3; qb = 1 + (u & 15); } else { const int uu = u - ATT_UNITS_LAT; b = uu >> 2; h = uu & 3; qb = 0; }
                        if constexpr (MIX_PARTS & 4) att::attn_unit(b, h, qb, HB, Z, lds);
                    }
                }
            }
            else if (kind == PK_POST1) { if constexpr (PH_ON(7)) post_pass(a, layer, 0, gw, NGW, lane); }
            else { if constexpr (PH_ON(10)) post_pass(a, layer, 1, gw, NGW, lane); }
        }
        if (ph + 1 < ph_hi) { XcdBarrier bar; bar.bar = (unsigned*)(kargs().ws + WS_CTL) + CW_BAR; bar.x = xb_xcc_id(); bar.st = (volatile LAS unsigned*)(lds + MISC_OFF) + 8; xcd_barrier(bar); }
    }
}

extern "C" void kernel_launch(void* const* d_in, const int* in_sizes, int n_in, void* d_out, int out_size, void* d_ws, size_t ws_size, hipStream_t stream) {
    static int grid = 0;
    if (grid == 0) {
        if (n_in != 24 || in_sizes[0] != NB * SEQ * DM || out_size != NB * SEQ * DM || ws_size < WS_END) {
            fprintf(stderr, "kernel_launch: unexpected shapes (n_in %d, in0 %d, out %d, ws %zu, need %zu); nothing launched\n", n_in, n_in > 0 ? in_sizes[0] : -1, out_size, ws_size, (size_t)WS_END); grid = -1; return; }
        int dev = 0, cus = 0, per_cu = 0;
        if (hipGetDevice(&dev) != hipSuccess || hipDeviceGetAttribute(&cus, hipDeviceAttributeMultiprocessorCount, dev) != hipSuccess) { fprintf(stderr, "kernel_launch: device query failed\n"); grid = -1; return; }
        if (hipFuncSetAttribute((const void*)fwd_kernel, hipFuncAttributeMaxDynamicSharedMemorySize, LDS_BYTES) != hipSuccess) { fprintf(stderr, "kernel_launch: hipFuncSetAttribute failed\n"); grid = -1; return; }
        if (hipOccupancyMaxActiveBlocksPerMultiprocessor(&per_cu, (const void*)fwd_kernel, NWAVES * 64, LDS_BYTES) != hipSuccess || per_cu < 1)
            fprintf(stderr, "kernel_launch: note: occupancy query reports %d workgroups per CU\n", per_cu);
        (void)hipGetLastError();
        grid = cus;
        if (grid < 192) { fprintf(stderr, "kernel_launch: %d CUs < 192: unsupported\n", grid); grid = -1; return; }
    }
    if (grid < 0) return;
    if (hipMemsetAsync((char*)d_ws + WS_CTL, 0, CTL_ZERO_BYTES, stream) != hipSuccess) { fprintf(stderr, "kernel_launch: memset failed\n"); return; }
    Args a{};
    for (int i = 0; i < 24; ++i) a.in[i] = (const float*)d_in[i];
    a.out = (float*)d_out; a.ws = (unsigned char*)d_ws;
#if MK_ONE_LAUNCH
    a.ph_lo = 0; a.ph_hi = N_PHASES;
    hipLaunchKernelGGL(fwd_kernel, dim3(grid), dim3(NWAVES * 64), LDS_BYTES, stream, a);
#else
    for (int ph = 0; ph < N_PHASES; ++ph) { a.ph_lo = ph; a.ph_hi = ph + 1; hipLaunchKernelGGL(fwd_kernel, dim3(grid), dim3(NWAVES * 64), LDS_BYTES, stream, a); }
#endif
    const hipError_t le = hipPeekAtLastError();
    if (le != hipSuccess) fprintf(stderr, "kernel_launch: launch failed: %s\n", hipGetErrorName(le));
}
```
